# Optimizing an MI355X kernel written in HIP

```python
import math
import jax, jax.numpy as jnp
from jax import lax
import numpy as np

D_MODEL = 1024
BATCH = 16
SEQ = 2048
DEPTH = 1

D_MIX = D_MODEL
D_SSM = D_MIX // 2
D_POOL = D_MIX - D_SSM
SSM_HEAD_DIM = 64
SSM_HEADS = D_SSM // SSM_HEAD_DIM
SSM_GROUPS = 2
SSM_STATE = 128
SSM_CONV = 4
SSM_CHUNK = 128
D_XBC = D_SSM + 2 * SSM_GROUPS * SSM_STATE
DT_MIN = 1e-3
DT_MAX = 1e-1
POOL_WINDOWS = (2, 4, 8, 16)
N_POOL_GROUPS = len(POOL_WINDOWS)
POOL_GROUP = D_POOL // N_POOL_GROUPS
D_IN_PROJ = D_SSM + D_XBC + SSM_HEADS + D_POOL
N_EXPERT_GROUPS = 4
EXPERTS_PER_GROUP = 4
N_EXPERTS = N_EXPERT_GROUPS * EXPERTS_PER_GROUP
TOP_K_INNER = 2
D_FF_EXPERT = 512
LN_EPS = 1e-5
RMS_EPS = 1e-5
DEEPNORM_ALPHA = (2.0 * DEPTH) ** 0.25
DEEPNORM_BETA = (8.0 * DEPTH) ** -0.25

kernel_name = "hybrid_ssd_pool_hmoe_deepnorm"


def layer_norm(x, g, b):
    xf = x.astype(jnp.float32)
    mu = jnp.mean(xf, axis=-1, keepdims=True)
    var = jnp.mean(jnp.square(xf - mu), axis=-1, keepdims=True)
    y = (xf - mu) * lax.rsqrt(var + LN_EPS)
    return (y * g.astype(jnp.float32) + b.astype(jnp.float32)).astype(x.dtype)


def causal_depthwise_conv(u, w, b):
    k_width = w.shape[0]
    seq = u.shape[1]
    up = jnp.pad(u, ((0, 0), (k_width - 1, 0), (0, 0)))
    out = b
    for k in range(k_width):
        out = out + up[:, k:k + seq, :] * w[k]
    return out


def segsum_decay(a):
    t = a.shape[-1]
    ae = jnp.broadcast_to(a[..., :, None], a.shape + (t,))
    strict = jnp.tril(jnp.ones((t, t), dtype=bool), -1)
    cs = jnp.cumsum(jnp.where(strict, ae, 0.0), axis=-2)
    lower = jnp.tril(jnp.ones((t, t), dtype=bool), 0)
    return jnp.where(lower, jnp.exp(cs), 0.0)


def ssd_chunked(xh, dt, a_head, bm, cm):
    bsz, seq, nh, hp = xh.shape
    ng, ns = bm.shape[2], bm.shape[3]
    nj = nh // ng
    q = SSM_CHUNK
    nc = seq // q
    x = (xh * dt[..., None]).reshape(bsz, nc, q, ng, nj, hp)
    a = (dt * a_head).reshape(bsz, nc, q, ng, nj).transpose(0, 3, 4, 1, 2)
    bc = bm.reshape(bsz, nc, q, ng, ns)
    cc = cm.reshape(bsz, nc, q, ng, ns)
    a_cum = jnp.cumsum(a, axis=-1)
    decay = segsum_decay(a)
    scores = jnp.einsum("bclgn,bcsgn->bgcls", cc, bc)
    y_diag = jnp.einsum("bgcls,bgjcls,bcsgjp->bclgjp", scores, decay, x)
    decay_states = jnp.exp(a_cum[..., -1:] - a_cum)
    states = jnp.einsum("bclgn,bgjcl,bclgjp->bcgjpn", bc, decay_states, x)
    chunk_decay = jnp.exp(a_cum[..., -1])

    def step(h, inp):
        s, d = inp
        return h * d[..., None, None] + s, h

    h0 = jnp.zeros((bsz, ng, nj, hp, ns), dtype=states.dtype)
    _, prev = lax.scan(step, h0, (jnp.moveaxis(states, 1, 0), jnp.moveaxis(chunk_decay, -1, 0)))
    prev = jnp.moveaxis(prev, 0, 1)
    y_off = jnp.einsum("bclgn,bcgjpn,bgjcl->bclgjp", cc, prev, jnp.exp(a_cum))
    return (y_diag + y_off).reshape(bsz, seq, nh, hp)


def multiscale_pool(u, w_pool, b_pool, scale):
    bsz, seq, _ = u.shape
    uf = u.astype(jnp.float32)
    cs = jnp.cumsum(uf, axis=1)
    pos = jnp.arange(seq, dtype=jnp.float32) + 1.0
    outs = []
    for i, w in enumerate(POOL_WINDOWS):
        sl = slice(i * POOL_GROUP, (i + 1) * POOL_GROUP)
        csg = cs[..., sl]
        lag = jnp.pad(csg[:, :seq - w], ((0, 0), (w, 0), (0, 0)))
        cnt = jnp.minimum(pos, float(w))[:, None]
        outs.append((csg - lag) / cnt - uf[..., sl])
    p = jnp.stack(outs, axis=2)
    mixed = jnp.einsum("blgc,gcd->blgd", p, w_pool.astype(jnp.float32)) + b_pool.astype(jnp.float32)
    return (mixed.reshape(bsz, seq, D_POOL) * scale.astype(jnp.float32)).astype(u.dtype)


def token_mixer(x, w_in, conv_w, conv_b, dt_bias, a_log, d_skip, ssm_norm_g,
                w_pool, b_pool, pool_scale, w_out):
    bsz, seq, _ = x.shape
    proj = x @ w_in
    s1, s2, s3 = D_SSM, D_SSM + D_XBC, D_SSM + D_XBC + SSM_HEADS
    z, xbc, dt_raw, u = proj[..., :s1], proj[..., s1:s2], proj[..., s2:s3], proj[..., s3:]
    xbc = jax.nn.silu(causal_depthwise_conv(xbc, conv_w, conv_b)).astype(jnp.float32)
    nbc = SSM_GROUPS * SSM_STATE
    xs = xbc[..., :D_SSM].reshape(bsz, seq, SSM_HEADS, SSM_HEAD_DIM)
    bm = xbc[..., D_SSM:D_SSM + nbc].reshape(bsz, seq, SSM_GROUPS, SSM_STATE)
    cm = xbc[..., D_SSM + nbc:].reshape(bsz, seq, SSM_GROUPS, SSM_STATE)
    dt = jax.nn.softplus(dt_raw.astype(jnp.float32) + dt_bias.astype(jnp.float32))
    a_head = -jnp.exp(a_log.astype(jnp.float32))
    y = ssd_chunked(xs, dt, a_head, bm, cm) + xs * d_skip.astype(jnp.float32)[:, None]
    y = y.reshape(bsz, seq, D_SSM) * jax.nn.silu(z.astype(jnp.float32))
    yg = y.reshape(bsz, seq, SSM_GROUPS, D_SSM // SSM_GROUPS)
    yg = yg * lax.rsqrt(jnp.mean(jnp.square(yg), axis=-1, keepdims=True) + RMS_EPS)
    y_ssd = (yg.reshape(bsz, seq, D_SSM) * ssm_norm_g.astype(jnp.float32)).astype(x.dtype)
    y_pool = multiscale_pool(u, w_pool, b_pool, pool_scale)
    return jnp.concatenate([y_ssd, y_pool], axis=-1) @ w_out


def hierarchical_moe(x, w_router_group, b_router_group, w_router_expert, b_router_expert,
                     w_gate, w_up, w_down):
    bsz, seq, d = x.shape
    xt = x.reshape(-1, d)
    xf = xt.astype(jnp.float32)
    g_logits = xf @ w_router_group.astype(jnp.float32) + b_router_group.astype(jnp.float32)
    g_prob = jax.nn.softmax(g_logits, axis=-1)
    g_w, g_idx = lax.top_k(g_prob, 1)
    e_logits = (xf @ w_router_expert.astype(jnp.float32) + b_router_expert.astype(jnp.float32))
    e_logits = e_logits.reshape(-1, N_EXPERT_GROUPS, EXPERTS_PER_GROUP)
    e_sel = jnp.take_along_axis(e_logits, g_idx[:, :, None], axis=1)[:, 0]
    top_v, top_i = lax.top_k(e_sel, TOP_K_INNER)
    comb = g_w * jax.nn.softmax(top_v, axis=-1)
    eid = g_idx * EXPERTS_PER_GROUP + top_i
    dense_w = jnp.sum(jax.nn.one_hot(eid, N_EXPERTS, dtype=jnp.float32) * comb[..., None], axis=1)
    dense_w = dense_w.astype(xt.dtype)
    y = jnp.zeros_like(xt)
    for e in range(N_EXPERTS):
        h = jax.nn.silu(xt @ w_gate[e]) * (xt @ w_up[e])
        y = y + dense_w[:, e:e + 1] * (h @ w_down[e])
    return y.reshape(bsz, seq, d)


def setup_inputs(seed: int = 0) -> dict:
    key = jax.random.key(seed)
    ks = jax.random.split(key, 32)
    f32 = jnp.float32

    def nrm(k, shape, scale):
        return jax.random.normal(k, shape, f32) * scale

    x = nrm(ks[0], (BATCH, SEQ, D_MODEL), 1.0)
    ln0_g = 1.0 + nrm(ks[1], (D_MODEL,), 0.02)
    ln0_b = nrm(ks[2], (D_MODEL,), 0.02)
    w_in = nrm(ks[3], (DEPTH, D_MODEL, D_IN_PROJ), D_MODEL ** -0.5)
    conv_w = nrm(ks[4], (DEPTH, SSM_CONV, D_XBC), SSM_CONV ** -0.5)
    conv_b = nrm(ks[5], (DEPTH, D_XBC), 0.02)
    uu = jax.random.uniform(ks[6], (DEPTH, SSM_HEADS), f32)
    dt0 = jnp.exp(uu * (math.log(DT_MAX) - math.log(DT_MIN)) + math.log(DT_MIN))
    dt_bias = dt0 + jnp.log(-jnp.expm1(-dt0))
    a_log = jnp.log(jax.random.uniform(ks[7], (DEPTH, SSM_HEADS), f32, 1.0, 16.0))
    d_skip = 1.0 + nrm(ks[8], (DEPTH, SSM_HEADS), 0.02)
    ssm_norm_g = 1.0 + nrm(ks[9], (DEPTH, D_SSM), 0.02)
    w_pool = nrm(ks[10], (DEPTH, N_POOL_GROUPS, POOL_GROUP, POOL_GROUP), POOL_GROUP ** -0.5)
    b_pool = nrm(ks[11], (DEPTH, N_POOL_GROUPS, POOL_GROUP), 0.02)
    pool_scale = 1.0 + nrm(ks[12], (DEPTH, D_POOL), 0.02)
    w_out = nrm(ks[13], (DEPTH, D_MIX, D_MODEL), D_MIX ** -0.5 * DEEPNORM_BETA)
    ln1_g = 1.0 + nrm(ks[14], (DEPTH, D_MODEL), 0.02)
    ln1_b = nrm(ks[15], (DEPTH, D_MODEL), 0.02)
    w_router_group = nrm(ks[16], (DEPTH, D_MODEL, N_EXPERT_GROUPS), D_MODEL ** -0.5)
    b_router_group = nrm(ks[17], (DEPTH, N_EXPERT_GROUPS), 0.01)
    w_router_expert = nrm(ks[18], (DEPTH, D_MODEL, N_EXPERTS), D_MODEL ** -0.5)
    b_router_expert = nrm(ks[19], (DEPTH, N_EXPERTS), 0.01)
    w_gate = nrm(ks[20], (DEPTH, N_EXPERTS, D_MODEL, D_FF_EXPERT), D_MODEL ** -0.5)
    w_up = nrm(ks[21], (DEPTH, N_EXPERTS, D_MODEL, D_FF_EXPERT), D_MODEL ** -0.5)
    w_down = nrm(ks[22], (DEPTH, N_EXPERTS, D_FF_EXPERT, D_MODEL), D_FF_EXPERT ** -0.5 * DEEPNORM_BETA)
    ln2_g = 1.0 + nrm(ks[23], (DEPTH, D_MODEL), 0.02)
    ln2_b = nrm(ks[24], (DEPTH, D_MODEL), 0.02)
    return {"x": x, "ln0_g": ln0_g, "ln0_b": ln0_b, "w_in": w_in, "conv_w": conv_w,
            "conv_b": conv_b, "dt_bias": dt_bias, "a_log": a_log, "d_skip": d_skip,
            "ssm_norm_g": ssm_norm_g, "w_pool": w_pool, "b_pool": b_pool,
            "pool_scale": pool_scale, "w_out": w_out, "ln1_g": ln1_g, "ln1_b": ln1_b,
            "w_router_group": w_router_group, "b_router_group": b_router_group,
            "w_router_expert": w_router_expert, "b_router_expert": b_router_expert,
            "w_gate": w_gate, "w_up": w_up, "w_down": w_down, "ln2_g": ln2_g, "ln2_b": ln2_b}


def reference(x, ln0_g, ln0_b, w_in, conv_w, conv_b, dt_bias, a_log, d_skip, ssm_norm_g,
              w_pool, b_pool, pool_scale, w_out, ln1_g, ln1_b, w_router_group, b_router_group,
              w_router_expert, b_router_expert, w_gate, w_up, w_down, ln2_g, ln2_b):
    x = layer_norm(x, ln0_g, ln0_b)
    for layer in range(DEPTH):
        mix = token_mixer(x, w_in[layer], conv_w[layer], conv_b[layer], dt_bias[layer],
                          a_log[layer], d_skip[layer], ssm_norm_g[layer], w_pool[layer],
                          b_pool[layer], pool_scale[layer], w_out[layer])
        x = layer_norm(DEEPNORM_ALPHA * x + mix, ln1_g[layer], ln1_b[layer])
        ffn = hierarchical_moe(x, w_router_group[layer], b_router_group[layer],
                               w_router_expert[layer], b_router_expert[layer],
                               w_gate[layer], w_up[layer], w_down[layer])
        x = layer_norm(DEEPNORM_ALPHA * x + ffn, ln2_g[layer], ln2_b[layer])
    return x
```

```cpp
#include <hip/hip_runtime.h>
#include <cstdio>
#include <cstdint>

#define GAS __attribute__((address_space(1)))
#define LAS __attribute__((address_space(3)))
typedef unsigned short bf16;
typedef float f32x4 __attribute__((ext_vector_type(4)));
typedef float f32x2 __attribute__((ext_vector_type(2)));
typedef unsigned u32x4 __attribute__((ext_vector_type(4)));
typedef unsigned u32x2 __attribute__((ext_vector_type(2)));

constexpr int NTOK = 32768, DM = 1024, SEQ = 2048, NBATCH = 16, NPROJ = 2048, DINP = 2056;
constexpr int NCHUNK = 16, CHUNK = 128, NHEAD = 8, HP = 64, NST = 128;
constexpr int NCLS = 24, LISTCAP = 32768, MAXT256 = 160;
constexpr float LN_EPS = 1e-5f, RMS_EPS = 1e-5f;
constexpr float ALPHA = 1.189207115002721f;

constexpr int PC_Z = 0, PC_X = 512, PC_B = 1024, PC_C = 1280, PC_U = 1536;

constexpr size_t MiB = 1u << 20;
constexpr size_t WS_CTL = 0, CTL_ZERO_BYTES = 1 * MiB;
constexpr size_t WS_WIN = 2 * MiB;
constexpr size_t WS_WOUT = 6 * MiB;
constexpr size_t WS_WPOOL = 8 * MiB;
constexpr size_t WS_WGU = 10 * MiB;
constexpr size_t WS_WD = 42 * MiB;
constexpr size_t WS_DTRAW = 58 * MiB;
constexpr size_t WS_DTV = 59 * MiB;
constexpr size_t WS_ACL = 60 * MiB;
constexpr size_t WS_CHD = 61 * MiB;
constexpr size_t WS_LIST = 62 * MiB;
constexpr size_t WS_LW = 65 * MiB;
constexpr size_t WS_XN = 72 * MiB;
constexpr size_t WS_PROJ = 136 * MiB;
constexpr size_t WS_YMIX = 264 * MiB;
constexpr size_t WS_STATES = 328 * MiB;
constexpr size_t WS_PREV = 392 * MiB;
constexpr size_t WS_XBCC = 424 * MiB;
constexpr size_t WS_R1 = WS_PROJ;
constexpr size_t WS_H1 = WS_PROJ + 64 * MiB;
constexpr size_t WS_HB = WS_STATES;
constexpr size_t WS_R2 = WS_XN;
constexpr size_t WS_PWIN = WS_STATES;
constexpr size_t WS_YG = WS_STATES;
constexpr size_t WS_END = 488 * MiB;
constexpr int CW_CNT = 1024;

constexpr int LDS_BYTES = 147456;
constexpr int NTHREADS = 512, NWAVES = 8;

__device__ __forceinline__ unsigned f2bf(float f) { unsigned u = __builtin_bit_cast(unsigned, f); return (u + 0x7fffu + ((u >> 16) & 1u)) >> 16; }
__device__ __forceinline__ unsigned pk2(float lo, float hi) { return f2bf(lo) | (f2bf(hi) << 16); }
__device__ __forceinline__ float bf2f(bf16 h) { return __uint_as_float((unsigned)h << 16); }
__device__ __forceinline__ float bflo(unsigned w) { return __uint_as_float(w << 16); }
__device__ __forceinline__ float bfhi(unsigned w) { return __uint_as_float(w & 0xffff0000u); }
__device__ __forceinline__ float wave_sum(float v) {
#pragma unroll
    for (int o = 1; o < 64; o <<= 1) v += __shfl_xor(v, o);
    return v;
}
__device__ __forceinline__ float silu_f(float v) { return v / (1.0f + __expf(-v)); }
__device__ __forceinline__ void unpack8(const u32x4 v, float (&f)[8]) {
    f[0] = bflo(v.x); f[1] = bfhi(v.x); f[2] = bflo(v.y); f[3] = bfhi(v.y); f[4] = bflo(v.z); f[5] = bfhi(v.z); f[6] = bflo(v.w); f[7] = bfhi(v.w);
}

struct Args { const float* in[25]; float* out; unsigned char* ws; int ph_lo, ph_hi; };

struct Ctx {
    const float *x, *ln0_g, *ln0_b, *w_in, *conv_w, *conv_b, *dt_bias, *a_log, *d_skip, *ssm_norm_g, *w_pool, *b_pool, *pool_scale, *w_out, *ln1_g, *ln1_b,
        *w_rg, *b_rg, *w_re, *b_re, *w_gate, *w_up, *w_down, *ln2_g, *ln2_b;
    float* out; unsigned char* ws; unsigned* ctl;
    bf16 *WIN, *WOUT, *WPOOL, *WGU, *WD, *XN, *PROJ, *YMIX, *PREV, *XBCC, *R1, *H1, *HB, *R2, *PWIN;
    float *DTRAW, *DTV, *ACL, *CHD, *STATES, *LW, *YG; int* LIST;
    LAS unsigned char* lds;
    int tid, lane, wave, G, bid;
};

__device__ __forceinline__ void transpose_item(const float* src, int ld_src, bf16* dst, int ld_dst, LAS float* scr, int lane) {
#pragma unroll 8
    for (int i = 0; i < 32; ++i) { const int kk = 2 * i + (lane >> 5); scr[kk * 33 + (lane & 31)] = src[(size_t)kk * ld_src + (lane & 31)]; }
    asm volatile("s_waitcnt lgkmcnt(0)" ::: "memory");
    const int c = lane & 7;
#pragma unroll
    for (int j = 0; j < 4; ++j) { const int n = (lane >> 3) + 8 * j; const LAS float* s = scr + (8 * c) * 33 + n;
        u32x4 o; o.x = pk2(s[0 * 33], s[1 * 33]); o.y = pk2(s[2 * 33], s[3 * 33]); o.z = pk2(s[4 * 33], s[5 * 33]); o.w = pk2(s[6 * 33], s[7 * 33]);
        *(u32x4*)(dst + (size_t)n * ld_dst + 8 * c) = o; }
    asm volatile("s_waitcnt lgkmcnt(0)" ::: "memory");
}

__device__ __forceinline__ void phase_prep(const Ctx& C) {
    LAS float* scr = (LAS float*)(C.lds + C.wave * 8704);
    LAS float* wdt = (LAS float*)(C.lds + 8 * 8704);
    const int gw = C.bid * NWAVES + C.wave, NGW = C.G * NWAVES;
    for (int i = C.tid; i < 8 * 1024; i += NTHREADS) { const int k = i >> 3, n = i & 7; wdt[n * 1024 + k] = C.w_in[(size_t)k * DINP + 1536 + n]; }
    constexpr int I_WIN = 16 * 64, I_WOUT = 16 * 32, I_WPOOL = 4 * 2 * 4, I_WGU = 16 * 16 * 32, I_WD = 16 * 8 * 32;
    constexpr int NITEMS = I_WIN + I_WOUT + I_WPOOL + I_WGU + I_WD;
    for (int it = gw; it < NITEMS; it += NGW) {
        int r = it;
        if (r < I_WIN) { const int kb = r / 64, nb = r % 64, n0 = nb * 32, n0s = n0 + (n0 >= 1536 ? 8 : 0);
            transpose_item(C.w_in + (size_t)(kb * 64) * DINP + n0s, DINP, C.WIN + (size_t)n0 * 1024 + kb * 64, 1024, scr, C.lane); continue; }
        r -= I_WIN;
        if (r < I_WOUT) { const int kb = r / 32, nb = r % 32;
            transpose_item(C.w_out + (size_t)(kb * 64) * 1024 + nb * 32, 1024, C.WOUT + (size_t)(nb * 32) * 1024 + kb * 64, 1024, scr, C.lane); continue; }
        r -= I_WOUT;
        if (r < I_WPOOL) { const int g = r / 8, kb = (r % 8) / 4, nb = r % 4;
            transpose_item(C.w_pool + (size_t)g * 16384 + (size_t)(kb * 64) * 128 + nb * 32, 128, C.WPOOL + (size_t)g * 16384 + (size_t)(nb * 32) * 128 + kb * 64, 128, scr, C.lane); continue; }
        r -= I_WPOOL;
        if (r < I_WGU) { const int e = r / 512, q = r % 512, kb = q / 32, nb = q % 32;
            const int row0 = nb * 32, t = row0 >> 8, half = (row0 >> 7) & 1, i0 = row0 & 127;
            const float* src = (half ? C.w_up : C.w_gate) + (size_t)e * 1024 * 512 + (size_t)(kb * 64) * 512 + 128 * t + i0;
            transpose_item(src, 512, C.WGU + (size_t)e * 1048576 + (size_t)row0 * 1024 + kb * 64, 1024, scr, C.lane); continue; }
        r -= I_WGU;
        { const int e = r / 256, q = r % 256, kb = q / 32, nb = q % 32;
            transpose_item(C.w_down + (size_t)e * 524288 + (size_t)(kb * 64) * 1024 + nb * 32, 1024, C.WD + (size_t)e * 524288 + (size_t)(nb * 32) * 512 + kb * 64, 512, scr, C.lane); }
    }
    __syncthreads();
    f32x4 gg[4], bb[4];
#pragma unroll
    for (int j = 0; j < 4; ++j) { gg[j] = *(const f32x4*)(C.ln0_g + 4 * C.lane + 256 * j); bb[j] = *(const f32x4*)(C.ln0_b + 4 * C.lane + 256 * j); }
    for (int m = gw; m < NTOK; m += NGW) {
        const f32x4* xr = (const f32x4*)(C.x + (size_t)m * DM) + C.lane;
        f32x4 v[4]; float s = 0.f;
#pragma unroll
        for (int j = 0; j < 4; ++j) { v[j] = xr[64 * j]; s += (v[j].x + v[j].y) + (v[j].z + v[j].w); }
        const float mean = wave_sum(s) * (1.f / DM); float s2 = 0.f;
#pragma unroll
        for (int j = 0; j < 4; ++j) { v[j] = v[j] - mean; s2 += (v[j].x * v[j].x + v[j].y * v[j].y) + (v[j].z * v[j].z + v[j].w * v[j].w); }
        const float rstd = 1.f / sqrtf(wave_sum(s2) * (1.f / DM) + LN_EPS);
        unsigned long long* o8 = (unsigned long long*)(C.XN + (size_t)m * DM) + C.lane;
#pragma unroll
        for (int j = 0; j < 4; ++j) { v[j] = v[j] * rstd * gg[j] + bb[j];
            o8[64 * j] = (unsigned long long)pk2(v[j].x, v[j].y) | ((unsigned long long)pk2(v[j].z, v[j].w) << 32); }
        float d[8];
#pragma unroll
        for (int n = 0; n < 8; ++n) { float a = 0.f;
#pragma unroll
            for (int j = 0; j < 4; ++j) { const f32x4 w = *(const LAS f32x4*)(wdt + n * 1024 + 4 * C.lane + 256 * j); a += (v[j].x * w.x + v[j].y * w.y) + (v[j].z * w.z + v[j].w * w.w); }
            d[n] = wave_sum(a); }
        if (C.lane == 0) { *(f32x4*)(C.DTRAW + (size_t)m * 8) = (f32x4){d[0], d[1], d[2], d[3]}; *(f32x4*)(C.DTRAW + (size_t)m * 8 + 4) = (f32x4){d[4], d[5], d[6], d[7]}; }
    }
}

struct MoeTab { int ntiles; int cnt[NCLS]; int cls[MAXT256]; int row0[MAXT256]; };
constexpr int MOETAB_OFF = 140 * 1024;
__device__ __forceinline__ void class_experts(int c, int& elo, int& ehi) {
    const int g = c / 6, q = c % 6; const int il = q < 3 ? 0 : (q < 5 ? 1 : 2); const int ih = q < 3 ? q + 1 : (q < 5 ? q - 1 : 3);
    elo = g * 4 + il; ehi = g * 4 + ih;
}
__device__ __forceinline__ void build_moetab(const Ctx& C) {
    LAS MoeTab* tb = (LAS MoeTab*)(C.lds + MOETAB_OFF);
    if (C.tid == 0) {
        int nt = 0;
        for (int c = 0; c < NCLS; ++c) { int n = (int)__hip_atomic_load(C.ctl + CW_CNT + c, __ATOMIC_RELAXED, __HIP_MEMORY_SCOPE_AGENT); if (n > LISTCAP) n = LISTCAP; tb->cnt[c] = n;
            for (int r = 0; r < n; r += 256) { if (nt < MAXT256) { tb->cls[nt] = c; tb->row0[nt] = r; ++nt; } } }
        tb->ntiles = nt;
    }
    __syncthreads();
}

template <int NBOP, class Spec> __device__ __forceinline__ void simple_gemm(const Ctx& C, const Spec& sp) {
    LAS float* As = (LAS float*)C.lds;
    LAS float* Bs = As + 16 * 132;
    const int tid = C.tid, ty = tid >> 4, tx = tid & 15;
    const int nmt = sp.n_mtiles(), nnt = sp.n_ntiles(), K = sp.K();
    for (int tile = C.bid; tile < nmt * nnt; tile += C.G) {
        const int mt = tile / nnt, nt = tile % nnt;
        float acc[NBOP][4][4];
#pragma unroll
        for (int o = 0; o < NBOP; ++o)
#pragma unroll
            for (int i = 0; i < 4; ++i)
#pragma unroll
                for (int j = 0; j < 4; ++j) acc[o][i][j] = 0.f;
        const bf16* ap = nullptr; const bf16* bp = nullptr; int bop = 0, bc = 0, bhf = 0;
        if (tid < 256) ap = sp.a_row(mt, nt, tid >> 1);
        else { const int idx = tid - 256; bop = idx >> 7; bc = (idx & 127) >> 1; bhf = idx & 1; }
        for (int k0 = 0; k0 < K; k0 += 16) {
            if (tid < 256) { const int r = tid >> 1, hf = tid & 1; float f[8];
                if (ap) { unpack8(*(const u32x4*)(ap + k0 + hf * 8), f); } else {
#pragma unroll
                    for (int i = 0; i < 8; ++i) f[i] = 0.f; }
#pragma unroll
                for (int i = 0; i < 8; ++i) As[(hf * 8 + i) * 132 + r] = f[i];
            } else if (bop < NBOP) { float f[8]; bp = sp.b_row(mt, nt, bop, bc, k0); unpack8(*(const u32x4*)(bp + bhf * 8), f);
#pragma unroll
                for (int i = 0; i < 8; ++i) Bs[(bop * 16 + bhf * 8 + i) * 68 + bc] = f[i];
            }
            __syncthreads();
#pragma unroll
            for (int k = 0; k < 16; ++k) { const f32x4 a = *(const LAS f32x4*)(As + k * 132 + ty * 4);
#pragma unroll
                for (int o = 0; o < NBOP; ++o) { const f32x4 b = *(const LAS f32x4*)(Bs + (o * 16 + k) * 68 + tx * 4);
                    acc[o][0][0] += a.x * b.x; acc[o][0][1] += a.x * b.y; acc[o][0][2] += a.x * b.z; acc[o][0][3] += a.x * b.w;
                    acc[o][1][0] += a.y * b.x; acc[o][1][1] += a.y * b.y; acc[o][1][2] += a.y * b.z; acc[o][1][3] += a.y * b.w;
                    acc[o][2][0] += a.z * b.x; acc[o][2][1] += a.z * b.y; acc[o][2][2] += a.z * b.z; acc[o][2][3] += a.z * b.w;
                    acc[o][3][0] += a.w * b.x; acc[o][3][1] += a.w * b.y; acc[o][3][2] += a.w * b.z; acc[o][3][3] += a.w * b.w; } }
            __syncthreads();
        }
        sp.epilogue(mt, nt, ty * 4, tx * 4, acc);
    }
}

struct SpecInProj {
    const bf16* XN; const bf16* W; bf16* O;
    __device__ int n_mtiles() const { return NTOK / 128; } __device__ int n_ntiles() const { return NPROJ / 64; } __device__ int K() const { return DM; }
    __device__ const bf16* a_row(int mt, int, int r) const { return XN + (size_t)(mt * 128 + r) * DM; }
    __device__ const bf16* b_row(int, int nt, int, int c, int k0) const { return W + (size_t)(nt * 64 + c) * DM + k0; }
    __device__ void epilogue(int mt, int nt, int r0, int c0, const float (&acc)[1][4][4]) const {
#pragma unroll
        for (int i = 0; i < 4; ++i) { u32x2 w; w.x = pk2(acc[0][i][0], acc[0][i][1]); w.y = pk2(acc[0][i][2], acc[0][i][3]);
            *(u32x2*)(O + (size_t)(mt * 128 + r0 + i) * NPROJ + nt * 64 + c0) = w; }
    }
};
struct SpecPool {
    const bf16* P; const bf16* W; bf16* O; const float* bias; const float* scale;
    __device__ int n_mtiles() const { return NTOK / 128; } __device__ int n_ntiles() const { return 8; } __device__ int K() const { return 128; }
    __device__ const bf16* a_row(int mt, int nt, int r) const { return P + (size_t)(mt * 128 + r) * 512 + (nt >> 1) * 128; }
    __device__ const bf16* b_row(int, int nt, int, int c, int k0) const { return W + (size_t)(nt >> 1) * 16384 + (size_t)((nt & 1) * 64 + c) * 128 + k0; }
    __device__ void epilogue(int mt, int nt, int r0, int c0, const float (&acc)[1][4][4]) const {
        const int col = nt * 64 + c0; const f32x4 b = *(const f32x4*)(bias + col), s = *(const f32x4*)(scale + col);
#pragma unroll
        for (int i = 0; i < 4; ++i) { u32x2 w; w.x = pk2((acc[0][i][0] + b.x) * s.x, (acc[0][i][1] + b.y) * s.y); w.y = pk2((acc[0][i][2] + b.z) * s.z, (acc[0][i][3] + b.w) * s.w);
            *(u32x2*)(O + (size_t)(mt * 128 + r0 + i) * DM + 512 + col) = w; }
    }
};
struct SpecOutProj {
    const bf16* Y; const bf16* W; const bf16* XN; bf16* O;
    __device__ int n_mtiles() const { return NTOK / 128; } __device__ int n_ntiles() const { return DM / 64; } __device__ int K() const { return DM; }
    __device__ const bf16* a_row(int mt, int, int r) const { return Y + (size_t)(mt * 128 + r) * DM; }
    __device__ const bf16* b_row(int, int nt, int, int c, int k0) const { return W + (size_t)(nt * 64 + c) * DM + k0; }
    __device__ void epilogue(int mt, int nt, int r0, int c0, const float (&acc)[1][4][4]) const {
#pragma unroll
        for (int i = 0; i < 4; ++i) { const size_t off = (size_t)(mt * 128 + r0 + i) * DM + nt * 64 + c0; const u32x2 xv = *(const u32x2*)(XN + off);
            u32x2 w; w.x = pk2(ALPHA * bflo(xv.x) + acc[0][i][0], ALPHA * bfhi(xv.x) + acc[0][i][1]); w.y = pk2(ALPHA * bflo(xv.y) + acc[0][i][2], ALPHA * bfhi(xv.y) + acc[0][i][3]);
            *(u32x2*)(O + off) = w; }
    }
};
struct SpecMoe1 {
    const bf16* H1; const bf16* WGU; bf16* HB; const int* LIST; const float* LW; const LAS MoeTab* tb;
    __device__ int n_mtiles() const { return tb->ntiles * 2; } __device__ int n_ntiles() const { return 16; } __device__ int K() const { return DM; }
    __device__ const bf16* a_row(int mt, int, int r) const { const int t = mt >> 1, c = tb->cls[t], rr = tb->row0[t] + (mt & 1) * 128 + r;
        if (rr >= tb->cnt[c]) return nullptr; return H1 + (size_t)LIST[c * LISTCAP + rr] * DM; }
    __device__ const bf16* b_row(int mt, int nt, int op, int c, int k0) const { const int cl = tb->cls[mt >> 1]; int elo, ehi; class_experts(cl, elo, ehi);
        const int hc = nt * 64 + c, slot = hc >> 9, hh = hc & 511, e = slot ? ehi : elo; return WGU + (size_t)e * 1048576 + (size_t)((hh >> 7) * 256 + op * 128 + (hh & 127)) * DM + k0; }
    __device__ void epilogue(int mt, int nt, int r0, int c0, const float (&acc)[2][4][4]) const {
        const int t = mt >> 1, c = tb->cls[t]; const int slot = (nt * 64) >> 9;
#pragma unroll
        for (int i = 0; i < 4; ++i) { const int rr = tb->row0[t] + (mt & 1) * 128 + r0 + i; const float w = rr < tb->cnt[c] ? LW[((size_t)c * LISTCAP + rr) * 2 + slot] : 0.f;
            float h[4];
#pragma unroll
            for (int j = 0; j < 4; ++j) h[j] = w * silu_f(acc[0][i][j]) * acc[1][i][j];
            u32x2 o; o.x = pk2(h[0], h[1]); o.y = pk2(h[2], h[3]);
            *(u32x2*)(HB + (size_t)(mt * 128 + r0 + i) * DM + nt * 64 + c0) = o; }
    }
};
struct SpecMoe2 {
    const bf16* H1; const bf16* WD; const bf16* HB; bf16* R2; const int* LIST; const LAS MoeTab* tb;
    __device__ int n_mtiles() const { return tb->ntiles * 2; } __device__ int n_ntiles() const { return 16; } __device__ int K() const { return DM; }
    __device__ const bf16* a_row(int mt, int, int r) const { return HB + (size_t)(mt * 128 + r) * DM; }
    __device__ const bf16* b_row(int mt, int nt, int, int c, int k0) const { const int cl = tb->cls[mt >> 1]; int elo, ehi; class_experts(cl, elo, ehi);
        const int e = k0 < 512 ? elo : ehi; return WD + (size_t)e * 524288 + (size_t)(nt * 64 + c) * 512 + (k0 & 511); }
    __device__ void epilogue(int mt, int nt, int r0, int c0, const float (&acc)[1][4][4]) const {
        const int t = mt >> 1, c = tb->cls[t];
#pragma unroll
        for (int i = 0; i < 4; ++i) { const int rr = tb->row0[t] + (mt & 1) * 128 + r0 + i; if (rr >= tb->cnt[c]) continue;
            const size_t off = (size_t)LIST[c * LISTCAP + rr] * DM + nt * 64 + c0; const u32x2 xv = *(const u32x2*)(H1 + off);
            u32x2 w; w.x = pk2(ALPHA * bflo(xv.x) + acc[0][i][0], ALPHA * bfhi(xv.x) + acc[0][i][1]); w.y = pk2(ALPHA * bflo(xv.y) + acc[0][i][2], ALPHA * bfhi(xv.y) + acc[0][i][3]);
            *(u32x2*)(R2 + off) = w; }
    }
};

__device__ __forceinline__ void phase_poolwin_simple(const Ctx& C) {
    const int gt = C.bid * NTHREADS + C.tid, NGT = C.G * NTHREADS;
    for (int task = gt; task < NTOK * 64; task += NGT) {
        const int tok = task >> 6, c8 = (task & 63) * 8, g = c8 >> 7, w = 2 << g, t = tok & (SEQ - 1);
        float s[8], u0[8];
#pragma unroll
        for (int i = 0; i < 8; ++i) s[i] = 0.f;
        for (int d = 0; d < w; ++d) { if (t - d < 0) break; float f[8]; unpack8(*(const u32x4*)(C.PROJ + (size_t)(tok - d) * NPROJ + PC_U + c8), f);
#pragma unroll
            for (int i = 0; i < 8; ++i) { s[i] += f[i]; if (d == 0) u0[i] = f[i]; } }
        const float inv = 1.0f / (float)((t + 1) < w ? (t + 1) : w);
        u32x4 o; o.x = pk2(s[0] * inv - u0[0], s[1] * inv - u0[1]); o.y = pk2(s[2] * inv - u0[2], s[3] * inv - u0[3]); o.z = pk2(s[4] * inv - u0[4], s[5] * inv - u0[5]); o.w = pk2(s[6] * inv - u0[6], s[7] * inv - u0[7]);
        *(u32x4*)(C.PWIN + (size_t)tok * 512 + c8) = o;
    }
}
__device__ __forceinline__ void phase_conv_simple(const Ctx& C) {
    const int gt = C.bid * NTHREADS + C.tid, NGT = C.G * NTHREADS;
    for (int task = gt; task < NTOK * 128; task += NGT) {
        const int tok = task >> 7, c8 = (task & 127) * 8, t = tok & (SEQ - 1);
        float a[8];
        { const f32x4 b0 = *(const f32x4*)(C.conv_b + c8), b1 = *(const f32x4*)(C.conv_b + c8 + 4); a[0] = b0.x; a[1] = b0.y; a[2] = b0.z; a[3] = b0.w; a[4] = b1.x; a[5] = b1.y; a[6] = b1.z; a[7] = b1.w; }
#pragma unroll
        for (int k = 0; k < 4; ++k) { const int d = 3 - k; if (t - d < 0) continue; float f[8]; unpack8(*(const u32x4*)(C.PROJ + (size_t)(tok - d) * NPROJ + PC_X + c8), f);
            const f32x4 w0 = *(const f32x4*)(C.conv_w + k * 1024 + c8), w1 = *(const f32x4*)(C.conv_w + k * 1024 + c8 + 4);
            a[0] += w0.x * f[0]; a[1] += w0.y * f[1]; a[2] += w0.z * f[2]; a[3] += w0.w * f[3]; a[4] += w1.x * f[4]; a[5] += w1.y * f[5]; a[6] += w1.z * f[6]; a[7] += w1.w * f[7]; }
        u32x4 o; o.x = pk2(silu_f(a[0]), silu_f(a[1])); o.y = pk2(silu_f(a[2]), silu_f(a[3])); o.z = pk2(silu_f(a[4]), silu_f(a[5])); o.w = pk2(silu_f(a[6]), silu_f(a[7]));
        *(u32x4*)(C.XBCC + (size_t)tok * 1024 + c8) = o;
    }
}
__device__ __forceinline__ void phase_dt_simple(const Ctx& C) {
    const int gt = C.bid * NTHREADS + C.tid;
    if (gt < NBATCH * NCHUNK * NHEAD) {
        const int h = gt & 7, bc = gt >> 3; const float bias = C.dt_bias[h], A = -__expf(C.a_log[h]); float acc = 0.f;
        for (int l = 0; l < CHUNK; ++l) { const size_t idx = (size_t)(bc * CHUNK + l) * 8 + h; const float v = C.DTRAW[idx] + bias; const float dt = v > 20.f ? v : log1pf(__expf(v));
            acc += dt * A; C.DTV[idx] = dt; C.ACL[idx] = acc; }
        C.CHD[gt] = __expf(acc);
    }
}
__device__ __forceinline__ void phase_states_simple(const Ctx& C) {
    LAS float* wl = (LAS float*)C.lds;
    for (int item = C.bid; item < NBATCH * NCHUNK * NHEAD; item += C.G) {
        const int h = item & 7, bc = item >> 3, g = h >> 2, tok0 = bc * CHUNK;
        __syncthreads();
        if (C.tid < CHUNK) { const float last = C.ACL[(size_t)(tok0 + CHUNK - 1) * 8 + h]; const size_t idx = (size_t)(tok0 + C.tid) * 8 + h; wl[C.tid] = C.DTV[idx] * __expf(last - C.ACL[idx]); }
        __syncthreads();
        const int p = C.tid >> 3, n0 = (C.tid & 7) * 16;
        float acc[16];
#pragma unroll
        for (int i = 0; i < 16; ++i) acc[i] = 0.f;
        for (int l = 0; l < CHUNK; ++l) { const bf16* row = C.XBCC + (size_t)(tok0 + l) * 1024; const float xv = bf2f(row[h * 64 + p]) * wl[l];
            float f[8]; unpack8(*(const u32x4*)(row + 512 + g * 128 + n0), f);
#pragma unroll
            for (int i = 0; i < 8; ++i) acc[i] += xv * f[i];
            unpack8(*(const u32x4*)(row + 512 + g * 128 + n0 + 8), f);
#pragma unroll
            for (int i = 0; i < 8; ++i) acc[8 + i] += xv * f[i]; }
        float* o = C.STATES + (size_t)item * 8192 + p * 128 + n0;
#pragma unroll
        for (int i = 0; i < 4; ++i) *(f32x4*)(o + 4 * i) = (f32x4){acc[4 * i], acc[4 * i + 1], acc[4 * i + 2], acc[4 * i + 3]};
    }
}
__device__ __forceinline__ void phase_scan(const Ctx& C) {
    const int gt = C.bid * NTHREADS + C.tid, NGT = C.G * NTHREADS;
    for (int task = gt; task < NBATCH * NHEAD * 2048; task += NGT) {
        const int e4 = task & 2047, bh = task >> 11, b = bh >> 3, h = bh & 7;
        f32x4 run = (f32x4){0.f, 0.f, 0.f, 0.f};
        f32x4 st[NCHUNK]; float dec[NCHUNK];
#pragma unroll
        for (int c = 0; c < NCHUNK; ++c) { const size_t item = (size_t)((b * NCHUNK + c) * 8 + h); st[c] = *(const f32x4*)(C.STATES + item * 8192 + e4 * 4); dec[c] = C.CHD[item]; }
#pragma unroll
        for (int c = 0; c < NCHUNK; ++c) { const size_t item = (size_t)((b * NCHUNK + c) * 8 + h);
            u32x2 o; o.x = pk2(run.x, run.y); o.y = pk2(run.z, run.w); *(u32x2*)(C.PREV + item * 8192 + e4 * 4) = o;
            run = run * dec[c] + st[c]; }
    }
}
__device__ __forceinline__ void phase_y_simple(const Ctx& C) {
    LAS float* S = (LAS float*)C.lds;
    LAS float* acl = S + 128 * 129;
    LAS float* dtl = acl + 512;
    for (int item = C.bid; item < NBATCH * NCHUNK * 2; item += C.G) {
        const int g = item & 1, bc = item >> 1, tok0 = bc * CHUNK;
        __syncthreads();
        { const int l = C.tid & 127, j = C.tid >> 7; const size_t idx = (size_t)(tok0 + l) * 8 + g * 4 + j; acl[j * 128 + l] = C.ACL[idx]; dtl[j * 128 + l] = C.DTV[idx]; }
        { const int l = C.tid >> 2, s0 = (C.tid & 3) * 32; const bf16* crow = C.XBCC + (size_t)(tok0 + l) * 1024 + 768 + g * 128;
            for (int s = s0; s < s0 + 32; ++s) { float a = 0.f;
                if (s <= l) { const bf16* brow = C.XBCC + (size_t)(tok0 + s) * 1024 + 512 + g * 128;
                    for (int n = 0; n < 128; n += 8) { float cf[8], bf[8]; unpack8(*(const u32x4*)(crow + n), cf); unpack8(*(const u32x4*)(brow + n), bf);
#pragma unroll
                        for (int i = 0; i < 8; ++i) a += cf[i] * bf[i]; } }
                S[l * 129 + s] = a; } }
        __syncthreads();
        for (int tk = C.tid; tk < 128 * 4 * 8; tk += NTHREADS) {
            const int pc = tk & 7, j = (tk >> 3) & 3, l = tk >> 5, h = g * 4 + j, ch = h * 64 + pc * 8;
            float y[8];
#pragma unroll
            for (int i = 0; i < 8; ++i) y[i] = 0.f;
            const float al = acl[j * 128 + l];
            for (int s = 0; s <= l; ++s) { const float gsc = S[l * 129 + s] * __expf(al - acl[j * 128 + s]) * dtl[j * 128 + s];
                float f[8]; unpack8(*(const u32x4*)(C.XBCC + (size_t)(tok0 + s) * 1024 + ch), f);
#pragma unroll
                for (int i = 0; i < 8; ++i) y[i] += gsc * f[i]; }
            const float el = __expf(al); const bf16* crow = C.XBCC + (size_t)(tok0 + l) * 1024 + 768 + g * 128;
            const bf16* pv = C.PREV + (size_t)(bc * 8 + h) * 8192 + (size_t)(pc * 8) * 128;
            for (int n = 0; n < 128; n += 8) { float cf[8]; unpack8(*(const u32x4*)(crow + n), cf);
#pragma unroll
                for (int i = 0; i < 8; ++i) { float pf[8]; unpack8(*(const u32x4*)(pv + i * 128 + n), pf); float a = 0.f;
#pragma unroll
                    for (int q = 0; q < 8; ++q) a += cf[q] * pf[q];
                    y[i] += el * a; } }
            float xf[8], zf[8]; unpack8(*(const u32x4*)(C.XBCC + (size_t)(tok0 + l) * 1024 + ch), xf); unpack8(*(const u32x4*)(C.PROJ + (size_t)(tok0 + l) * NPROJ + PC_Z + ch), zf);
            const float dsk = C.d_skip[h];
            float* o = C.YG + (size_t)(tok0 + l) * 512 + ch;
            f32x4 o0, o1;
            o0.x = (y[0] + dsk * xf[0]) * silu_f(zf[0]); o0.y = (y[1] + dsk * xf[1]) * silu_f(zf[1]); o0.z = (y[2] + dsk * xf[2]) * silu_f(zf[2]); o0.w = (y[3] + dsk * xf[3]) * silu_f(zf[3]);
            o1.x = (y[4] + dsk * xf[4]) * silu_f(zf[4]); o1.y = (y[5] + dsk * xf[5]) * silu_f(zf[5]); o1.z = (y[6] + dsk * xf[6]) * silu_f(zf[6]); o1.w = (y[7] + dsk * xf[7]) * silu_f(zf[7]);
            *(f32x4*)o = o0; *(f32x4*)(o + 4) = o1;
        }
    }
}
__device__ __forceinline__ void phase_rms_simple(const Ctx& C) {
    const int gw = C.bid * NWAVES + C.wave, NGW = C.G * NWAVES;
    for (int task = gw; task < NTOK * 2; task += NGW) {
        const int tok = task >> 1, g = task & 1; const f32x4 v = *(const f32x4*)(C.YG + (size_t)tok * 512 + g * 256 + 4 * C.lane);
        const float ss = wave_sum((v.x * v.x + v.y * v.y) + (v.z * v.z + v.w * v.w)); const float r = 1.0f / sqrtf(ss * (1.f / 256.f) + RMS_EPS);
        const f32x4 ng = *(const f32x4*)(C.ssm_norm_g + g * 256 + 4 * C.lane);
        u32x2 o; o.x = pk2(v.x * r * ng.x, v.y * r * ng.y); o.y = pk2(v.z * r * ng.z, v.w * r * ng.w);
        *(u32x2*)(C.YMIX + (size_t)tok * DM + g * 256 + 4 * C.lane) = o;
    }
}

__device__ __forceinline__ void phase_ln1_router(const Ctx& C) {
    LAS float* wr = (LAS float*)C.lds;
    LAS int* rcls = (LAS int*)(C.lds + 20 * 4096);
    LAS float* rw = (LAS float*)(C.lds + 20 * 4096 + 512);
    LAS int* rpos = (LAS int*)(C.lds + 20 * 4096 + 512 + 1024);
    LAS int* lcnt = (LAS int*)(C.lds + 20 * 4096 + 512 + 1024 + 512);
    LAS int* lbase = lcnt + 32;
    for (int i = C.tid; i < 1024 * 4; i += NTHREADS) { const int k = i >> 2, n = i & 3; wr[n * 1024 + k] = C.w_rg[i]; }
    for (int i = C.tid; i < 1024 * 16; i += NTHREADS) { const int k = i >> 4, n = i & 15; wr[(4 + n) * 1024 + k] = C.w_re[i]; }
    f32x4 gg[4], bb[4];
#pragma unroll
    for (int j = 0; j < 4; ++j) { gg[j] = *(const f32x4*)(C.ln1_g + 4 * C.lane + 256 * j); bb[j] = *(const f32x4*)(C.ln1_b + 4 * C.lane + 256 * j); }
    float brg[4], bre[16];
#pragma unroll
    for (int i = 0; i < 4; ++i) brg[i] = C.b_rg[i];
#pragma unroll
    for (int i = 0; i < 16; ++i) bre[i] = C.b_re[i];
    for (int rb = C.bid; rb < NTOK / 128; rb += C.G) {
        __syncthreads();
        if (C.tid < 32) lcnt[C.tid] = 0;
        for (int rr = 0; rr < 16; ++rr) {
            const int r = C.wave * 16 + rr, m = rb * 128 + r;
            const u32x2* xr = (const u32x2*)(C.R1 + (size_t)m * DM) + C.lane;
            f32x4 v[4]; float s = 0.f;
#pragma unroll
            for (int j = 0; j < 4; ++j) { const u32x2 w = xr[64 * j]; v[j] = (f32x4){bflo(w.x), bfhi(w.x), bflo(w.y), bfhi(w.y)}; s += (v[j].x + v[j].y) + (v[j].z + v[j].w); }
            const float mean = wave_sum(s) * (1.f / DM); float s2 = 0.f;
#pragma unroll
            for (int j = 0; j < 4; ++j) { v[j] = v[j] - mean; s2 += (v[j].x * v[j].x + v[j].y * v[j].y) + (v[j].z * v[j].z + v[j].w * v[j].w); }
            const float rstd = 1.f / sqrtf(wave_sum(s2) * (1.f / DM) + LN_EPS);
            u32x2* o8 = (u32x2*)(C.H1 + (size_t)m * DM) + C.lane;
#pragma unroll
            for (int j = 0; j < 4; ++j) { v[j] = v[j] * rstd * gg[j] + bb[j]; u32x2 o; o.x = pk2(v[j].x, v[j].y); o.y = pk2(v[j].z, v[j].w); o8[64 * j] = o; }
            float lg[20];
#pragma unroll
            for (int n = 0; n < 20; ++n) { float a = 0.f;
#pragma unroll
                for (int j = 0; j < 4; ++j) { const f32x4 w = *(const LAS f32x4*)(wr + n * 1024 + 4 * C.lane + 256 * j); a += (v[j].x * w.x + v[j].y * w.y) + (v[j].z * w.z + v[j].w * w.w); }
                lg[n] = wave_sum(a); }
            float g0 = lg[0] + brg[0], g1 = lg[1] + brg[1], g2 = lg[2] + brg[2], g3 = lg[3] + brg[3];
            int gi = 0; float gm = g0; if (g1 > gm) { gm = g1; gi = 1; } if (g2 > gm) { gm = g2; gi = 2; } if (g3 > gm) { gm = g3; gi = 3; }
            const float gwt = 1.0f / (__expf(g0 - gm) + __expf(g1 - gm) + __expf(g2 - gm) + __expf(g3 - gm));
            float e[4];
#pragma unroll
            for (int i = 0; i < 4; ++i) { const float a0 = lg[4 + i] + bre[i], a1 = lg[8 + i] + bre[4 + i], a2 = lg[12 + i] + bre[8 + i], a3 = lg[16 + i] + bre[12 + i]; e[i] = gi == 0 ? a0 : (gi == 1 ? a1 : (gi == 2 ? a2 : a3)); }
            int i1 = 0; float v1 = e[0]; if (e[1] > v1) { v1 = e[1]; i1 = 1; } if (e[2] > v1) { v1 = e[2]; i1 = 2; } if (e[3] > v1) { v1 = e[3]; i1 = 3; }
            int i2 = -1; float v2 = -3.0e38f;
#pragma unroll
            for (int i = 0; i < 4; ++i) if (i != i1 && e[i] > v2) { v2 = e[i]; i2 = i; }
            const float ex = __expf(v2 - v1), p1 = 1.0f / (1.0f + ex), p2 = ex * p1;
            const int il = i1 < i2 ? i1 : i2, ih = i1 < i2 ? i2 : i1; const float wl = (i1 < i2 ? p1 : p2) * gwt, wh = (i1 < i2 ? p2 : p1) * gwt;
            const int q = il == 0 ? ih - 1 : (il == 1 ? ih + 1 : 5);
            if (C.lane == 0) { rcls[r] = gi * 6 + q; rw[r * 2] = wl; rw[r * 2 + 1] = wh; }
        }
        __syncthreads();
        if (C.tid < 128) rpos[C.tid] = atomicAdd((int*)&lcnt[rcls[C.tid]], 1);
        __syncthreads();
        if (C.tid < NCLS) lbase[C.tid] = lcnt[C.tid] > 0 ? (int)__hip_atomic_fetch_add(C.ctl + CW_CNT + C.tid, (unsigned)lcnt[C.tid], __ATOMIC_RELAXED, __HIP_MEMORY_SCOPE_AGENT) : 0;
        __syncthreads();
        if (C.tid < 128) { const int c = rcls[C.tid], pos = lbase[c] + rpos[C.tid];
            if (pos < LISTCAP) { C.LIST[c * LISTCAP + pos] = rb * 128 + C.tid; C.LW[((size_t)c * LISTCAP + pos) * 2] = rw[C.tid * 2]; C.LW[((size_t)c * LISTCAP + pos) * 2 + 1] = rw[C.tid * 2 + 1]; } }
    }
}

__device__ __forceinline__ void phase_ln2(const Ctx& C) {
    const int gw = C.bid * NWAVES + C.wave, NGW = C.G * NWAVES;
    f32x4 gg[4], bb[4];
#pragma unroll
    for (int j = 0; j < 4; ++j) { gg[j] = *(const f32x4*)(C.ln2_g + 4 * C.lane + 256 * j); bb[j] = *(const f32x4*)(C.ln2_b + 4 * C.lane + 256 * j); }
    for (int m = gw; m < NTOK; m += NGW) {
        const u32x2* xr = (const u32x2*)(C.R2 + (size_t)m * DM) + C.lane;
        f32x4 v[4]; float s = 0.f;
#pragma unroll
        for (int j = 0; j < 4; ++j) { const u32x2 w = xr[64 * j]; v[j] = (f32x4){bflo(w.x), bfhi(w.x), bflo(w.y), bfhi(w.y)}; s += (v[j].x + v[j].y) + (v[j].z + v[j].w); }
        const float mean = wave_sum(s) * (1.f / DM); float s2 = 0.f;
#pragma unroll
        for (int j = 0; j < 4; ++j) { v[j] = v[j] - mean; s2 += (v[j].x * v[j].x + v[j].y * v[j].y) + (v[j].z * v[j].z + v[j].w * v[j].w); }
        const float rstd = 1.f / sqrtf(wave_sum(s2) * (1.f / DM) + LN_EPS);
        f32x4* o = (f32x4*)(C.out + (size_t)m * DM) + C.lane;
#pragma unroll
        for (int j = 0; j < 4; ++j) o[64 * j] = v[j] * rstd * gg[j] + bb[j];
    }
}

constexpr int N_PHASES = 15;
template <int LO, int HI> __global__ void __launch_bounds__(NTHREADS, 2) fwd_kernel(Args args) {
    extern __shared__ __attribute__((aligned(16))) unsigned char lds_raw[];
    Ctx C;
    C.lds = (LAS unsigned char*)lds_raw;
    C.tid = threadIdx.x; C.lane = C.tid & 63; C.wave = __builtin_amdgcn_readfirstlane(C.tid >> 6); C.G = gridDim.x; C.bid = blockIdx.x;
    C.x = args.in[0]; C.ln0_g = args.in[1]; C.ln0_b = args.in[2]; C.w_in = args.in[3]; C.conv_w = args.in[4]; C.conv_b = args.in[5]; C.dt_bias = args.in[6]; C.a_log = args.in[7];
    C.d_skip = args.in[8]; C.ssm_norm_g = args.in[9]; C.w_pool = args.in[10]; C.b_pool = args.in[11]; C.pool_scale = args.in[12]; C.w_out = args.in[13]; C.ln1_g = args.in[14]; C.ln1_b = args.in[15];
    C.w_rg = args.in[16]; C.b_rg = args.in[17]; C.w_re = args.in[18]; C.b_re = args.in[19]; C.w_gate = args.in[20]; C.w_up = args.in[21]; C.w_down = args.in[22]; C.ln2_g = args.in[23]; C.ln2_b = args.in[24];
    C.out = args.out; C.ws = args.ws; unsigned char* ws = args.ws; C.ctl = (unsigned*)(ws + WS_CTL);
    C.WIN = (bf16*)(ws + WS_WIN); C.WOUT = (bf16*)(ws + WS_WOUT); C.WPOOL = (bf16*)(ws + WS_WPOOL); C.WGU = (bf16*)(ws + WS_WGU); C.WD = (bf16*)(ws + WS_WD);
    C.XN = (bf16*)(ws + WS_XN); C.PROJ = (bf16*)(ws + WS_PROJ); C.YMIX = (bf16*)(ws + WS_YMIX); C.PREV = (bf16*)(ws + WS_PREV); C.XBCC = (bf16*)(ws + WS_XBCC);
    C.R1 = (bf16*)(ws + WS_R1); C.H1 = (bf16*)(ws + WS_H1); C.HB = (bf16*)(ws + WS_HB); C.R2 = (bf16*)(ws + WS_R2); C.PWIN = (bf16*)(ws + WS_PWIN);
    C.DTRAW = (float*)(ws + WS_DTRAW); C.DTV = (float*)(ws + WS_DTV); C.ACL = (float*)(ws + WS_ACL); C.CHD = (float*)(ws + WS_CHD); C.STATES = (float*)(ws + WS_STATES);
    C.LW = (float*)(ws + WS_LW); C.YG = (float*)(ws + WS_YG); C.LIST = (int*)(ws + WS_LIST);
    const LAS MoeTab* tb = (const LAS MoeTab*)(C.lds + MOETAB_OFF);
#define IN(k) (LO <= (k) && (k) < HI)
    if constexpr (IN(0)) phase_prep(C);
    if constexpr (IN(1)) { SpecInProj sp{C.XN, C.WIN, C.PROJ}; simple_gemm<1>(C, sp); }
    if constexpr (IN(2)) phase_poolwin_simple(C);
    if constexpr (IN(3)) { SpecPool sp{C.PWIN, C.WPOOL, C.YMIX, C.b_pool, C.pool_scale}; simple_gemm<1>(C, sp); }
    if constexpr (IN(4)) phase_conv_simple(C);
    if constexpr (IN(5)) phase_dt_simple(C);
    if constexpr (IN(6)) phase_states_simple(C);
    if constexpr (IN(7)) phase_scan(C);
    if constexpr (IN(8)) phase_y_simple(C);
    if constexpr (IN(9)) phase_rms_simple(C);
    if constexpr (IN(10)) { SpecOutProj sp{C.YMIX, C.WOUT, C.XN, C.R1}; simple_gemm<1>(C, sp); }
    if constexpr (IN(11)) phase_ln1_router(C);
    if constexpr (IN(12)) { build_moetab(C); SpecMoe1 sp{C.H1, C.WGU, C.HB, C.LIST, C.LW, tb}; simple_gemm<2>(C, sp); }
    if constexpr (IN(13)) { build_moetab(C); SpecMoe2 sp{C.H1, C.WD, C.HB, C.R2, C.LIST, tb}; simple_gemm<1>(C, sp); }
    if constexpr (IN(14)) phase_ln2(C);
#undef IN
}

template <int P> static void launch_phase(int grid, hipStream_t stream, const Args& a) {
    static bool attr = false;
    if (!attr) { (void)hipFuncSetAttribute((const void*)fwd_kernel<P, P + 1>, hipFuncAttributeMaxDynamicSharedMemorySize, LDS_BYTES); (void)hipGetLastError(); attr = true; }
    hipLaunchKernelGGL((fwd_kernel<P, P + 1>), dim3(grid), dim3(NTHREADS), LDS_BYTES, stream, a);
}

extern "C" void kernel_launch(void* const* d_in, const int* in_sizes, int n_in, void* d_out, int out_size, void* d_ws, size_t ws_size, hipStream_t stream) {
    static int grid = 0;
    if (grid == 0) {
        if (n_in != 25 || in_sizes[0] != NTOK * DM || out_size != NTOK * DM || ws_size < WS_END) { fprintf(stderr, "kernel_launch: unexpected shapes (n_in %d, in0 %d, out %d, ws %zu)\n", n_in, n_in > 0 ? in_sizes[0] : -1, out_size, ws_size); grid = -1; return; }
        int dev = 0, cus = 0;
        if (hipGetDevice(&dev) != hipSuccess || hipDeviceGetAttribute(&cus, hipDeviceAttributeMultiprocessorCount, dev) != hipSuccess) { grid = -1; return; }
        (void)hipGetLastError();
        grid = cus > 0 ? cus : 256;
    }
    if (grid < 0) return;
    (void)hipMemsetAsync((char*)d_ws + WS_CTL, 0, CTL_ZERO_BYTES, stream);
    Args a{};
    for (int i = 0; i < 25; ++i) a.in[i] = (const float*)d_in[i];
    a.out = (float*)d_out; a.ws = (unsigned char*)d_ws;
    launch_phase<0>(grid, stream, a); launch_phase<1>(grid, stream, a); launch_phase<2>(grid, stream, a); launch_phase<3>(grid, stream, a); launch_phase<4>(grid, stream, a);
    launch_phase<5>(grid, stream, a); launch_phase<6>(grid, stream, a); launch_phase<7>(grid, stream, a); launch_phase<8>(grid, stream, a); launch_phase<9>(grid, stream, a);
    launch_phase<10>(grid, stream, a); launch_phase<11>(grid, stream, a); launch_phase<12>(grid, stream, a); launch_phase<13>(grid, stream, a); launch_phase<14>(grid, stream, a);
}
```

```cpp
#include <hip/hip_runtime.h>
#include <cstdio>
#include <cstdint>

#define GAS __attribute__((address_space(1)))
#define LAS __attribute__((address_space(3)))
typedef unsigned short bf16;
typedef float f32x4 __attribute__((ext_vector_type(4)));
typedef float f32x2 __attribute__((ext_vector_type(2)));
typedef unsigned u32x4 __attribute__((ext_vector_type(4)));
typedef unsigned u32x2 __attribute__((ext_vector_type(2)));

constexpr int NTOK = 32768, DM = 1024, SEQ = 2048, NBATCH = 16, NPROJ = 2048, DINP = 2056;
constexpr int NCHUNK = 16, CHUNK = 128, NHEAD = 8, HP = 64, NST = 128;
constexpr int NCLS = 24, LISTCAP = 32768, MAXT256 = 160;
constexpr float LN_EPS = 1e-5f, RMS_EPS = 1e-5f;
constexpr float ALPHA = 1.189207115002721f;

constexpr int PC_Z = 0, PC_X = 512, PC_B = 1024, PC_C = 1280, PC_U = 1536;

constexpr size_t MiB = 1u << 20;
constexpr size_t WS_CTL = 0, CTL_ZERO_BYTES = 1 * MiB;
constexpr size_t WS_WIN = 2 * MiB;
constexpr size_t WS_WOUT = 6 * MiB;
constexpr size_t WS_WPOOL = 8 * MiB;
constexpr size_t WS_WGU = 10 * MiB;
constexpr size_t WS_WD = 42 * MiB;
constexpr size_t WS_DTRAW = 58 * MiB;
constexpr size_t WS_DTV = 59 * MiB;
constexpr size_t WS_ACL = 60 * MiB;
constexpr size_t WS_CHD = 61 * MiB;
constexpr size_t WS_LIST = 62 * MiB;
constexpr size_t WS_LW = 65 * MiB;
constexpr size_t WS_XN = 72 * MiB;
constexpr size_t WS_PROJ = 136 * MiB;
constexpr size_t WS_YMIX = 264 * MiB;
constexpr size_t WS_STATES = 328 * MiB;
constexpr size_t WS_PREV = 392 * MiB;
constexpr size_t WS_XBCC = 424 * MiB;
constexpr size_t WS_R1 = WS_PROJ;
constexpr size_t WS_H1 = WS_PROJ + 64 * MiB;
constexpr size_t WS_HB = WS_STATES;
constexpr size_t WS_R2 = WS_XN;
constexpr size_t WS_PWIN = WS_STATES;
constexpr size_t WS_YG = WS_STATES;
constexpr size_t WS_END = 488 * MiB;
constexpr int CW_CNT = 1024;

constexpr int LDS_BYTES = 147456;
constexpr int NTHREADS = 512, NWAVES = 8;

__device__ __forceinline__ unsigned f2bf(float f) { unsigned u = __builtin_bit_cast(unsigned, f); return (u + 0x7fffu + ((u >> 16) & 1u)) >> 16; }
__device__ __forceinline__ unsigned pk2(float lo, float hi) { return f2bf(lo) | (f2bf(hi) << 16); }
__device__ __forceinline__ float bf2f(bf16 h) { return __uint_as_float((unsigned)h << 16); }
__device__ __forceinline__ float bflo(unsigned w) { return __uint_as_float(w << 16); }
__device__ __forceinline__ float bfhi(unsigned w) { return __uint_as_float(w & 0xffff0000u); }
__device__ __forceinline__ float wave_sum(float v) {
#pragma unroll
    for (int o = 1; o < 64; o <<= 1) v += __shfl_xor(v, o);
    return v;
}
__device__ __forceinline__ float silu_f(float v) { return v / (1.0f + __expf(-v)); }
__device__ __forceinline__ void unpack8(const u32x4 v, float (&f)[8]) {
    f[0] = bflo(v.x); f[1] = bfhi(v.x); f[2] = bflo(v.y); f[3] = bfhi(v.y); f[4] = bflo(v.z); f[5] = bfhi(v.z); f[6] = bflo(v.w); f[7] = bfhi(v.w);
}

struct Args { const float* in[25]; float* out; unsigned char* ws; int ph_lo, ph_hi; };

struct Ctx {
    const float *x, *ln0_g, *ln0_b, *w_in, *conv_w, *conv_b, *dt_bias, *a_log, *d_skip, *ssm_norm_g, *w_pool, *b_pool, *pool_scale, *w_out, *ln1_g, *ln1_b,
        *w_rg, *b_rg, *w_re, *b_re, *w_gate, *w_up, *w_down, *ln2_g, *ln2_b;
    float* out; unsigned char* ws; unsigned* ctl;
    bf16 *WIN, *WOUT, *WPOOL, *WGU, *WD, *XN, *PROJ, *YMIX, *PREV, *XBCC, *R1, *H1, *HB, *R2, *PWIN;
    float *DTRAW, *DTV, *ACL, *CHD, *STATES, *LW, *YG; int* LIST;
    LAS unsigned char* lds;
    int tid, lane, wave, G, bid;
};

__device__ __forceinline__ void transpose_item(const float* src, int ld_src, bf16* dst, int ld_dst, LAS float* scr, int lane) {
#pragma unroll 8
    for (int i = 0; i < 32; ++i) { const int kk = 2 * i + (lane >> 5); scr[kk * 33 + (lane & 31)] = src[(size_t)kk * ld_src + (lane & 31)]; }
    asm volatile("s_waitcnt lgkmcnt(0)" ::: "memory");
    const int c = lane & 7;
#pragma unroll
    for (int j = 0; j < 4; ++j) { const int n = (lane >> 3) + 8 * j; const LAS float* s = scr + (8 * c) * 33 + n;
        u32x4 o; o.x = pk2(s[0 * 33], s[1 * 33]); o.y = pk2(s[2 * 33], s[3 * 33]); o.z = pk2(s[4 * 33], s[5 * 33]); o.w = pk2(s[6 * 33], s[7 * 33]);
        *(u32x4*)(dst + (size_t)n * ld_dst + 8 * c) = o; }
    asm volatile("s_waitcnt lgkmcnt(0)" ::: "memory");
}

__device__ __forceinline__ void phase_prep(const Ctx& C) {
    LAS float* scr = (LAS float*)(C.lds + C.wave * 8704);
    LAS float* wdt = (LAS float*)(C.lds + 8 * 8704);
    const int gw = C.bid * NWAVES + C.wave, NGW = C.G * NWAVES;
    for (int i = C.tid; i < 8 * 1024; i += NTHREADS) { const int k = i >> 3, n = i & 7; wdt[n * 1024 + k] = C.w_in[(size_t)k * DINP + 1536 + n]; }
    constexpr int I_WIN = 16 * 64, I_WOUT = 16 * 32, I_WPOOL = 4 * 2 * 4, I_WGU = 16 * 16 * 32, I_WD = 16 * 8 * 32;
    constexpr int NITEMS = I_WIN + I_WOUT + I_WPOOL + I_WGU + I_WD;
    for (int it = gw; it < NITEMS; it += NGW) {
        int r = it;
        if (r < I_WIN) { const int kb = r / 64, nb = r % 64, n0 = nb * 32, n0s = n0 + (n0 >= 1536 ? 8 : 0);
            transpose_item(C.w_in + (size_t)(kb * 64) * DINP + n0s, DINP, C.WIN + (size_t)n0 * 1024 + kb * 64, 1024, scr, C.lane); continue; }
        r -= I_WIN;
        if (r < I_WOUT) { const int kb = r / 32, nb = r % 32;
            transpose_item(C.w_out + (size_t)(kb * 64) * 1024 + nb * 32, 1024, C.WOUT + (size_t)(nb * 32) * 1024 + kb * 64, 1024, scr, C.lane); continue; }
        r -= I_WOUT;
        if (r < I_WPOOL) { const int g = r / 8, kb = (r % 8) / 4, nb = r % 4;
            transpose_item(C.w_pool + (size_t)g * 16384 + (size_t)(kb * 64) * 128 + nb * 32, 128, C.WPOOL + (size_t)g * 16384 + (size_t)(nb * 32) * 128 + kb * 64, 128, scr, C.lane); continue; }
        r -= I_WPOOL;
        if (r < I_WGU) { const int e = r / 512, q = r % 512, kb = q / 32, nb = q % 32;
            const int row0 = nb * 32, t = row0 >> 8, half = (row0 >> 7) & 1, i0 = row0 & 127;
            const float* src = (half ? C.w_up : C.w_gate) + (size_t)e * 1024 * 512 + (size_t)(kb * 64) * 512 + 128 * t + i0;
            transpose_item(src, 512, C.WGU + (size_t)e * 1048576 + (size_t)row0 * 1024 + kb * 64, 1024, scr, C.lane); continue; }
        r -= I_WGU;
        { const int e = r / 256, q = r % 256, kb = q / 32, nb = q % 32;
            transpose_item(C.w_down + (size_t)e * 524288 + (size_t)(kb * 64) * 1024 + nb * 32, 1024, C.WD + (size_t)e * 524288 + (size_t)(nb * 32) * 512 + kb * 64, 512, scr, C.lane); }
    }
    __syncthreads();
    f32x4 gg[4], bb[4];
#pragma unroll
    for (int j = 0; j < 4; ++j) { gg[j] = *(const f32x4*)(C.ln0_g + 4 * C.lane + 256 * j); bb[j] = *(const f32x4*)(C.ln0_b + 4 * C.lane + 256 * j); }
    for (int m = gw; m < NTOK; m += NGW) {
        const f32x4* xr = (const f32x4*)(C.x + (size_t)m * DM) + C.lane;
        f32x4 v[4]; float s = 0.f;
#pragma unroll
        for (int j = 0; j < 4; ++j) { v[j] = xr[64 * j]; s += (v[j].x + v[j].y) + (v[j].z + v[j].w); }
        const float mean = wave_sum(s) * (1.f / DM); float s2 = 0.f;
#pragma unroll
        for (int j = 0; j < 4; ++j) { v[j] = v[j] - mean; s2 += (v[j].x * v[j].x + v[j].y * v[j].y) + (v[j].z * v[j].z + v[j].w * v[j].w); }
        const float rstd = 1.f / sqrtf(wave_sum(s2) * (1.f / DM) + LN_EPS);
        unsigned long long* o8 = (unsigned long long*)(C.XN + (size_t)m * DM) + C.lane;
#pragma unroll
        for (int j = 0; j < 4; ++j) { v[j] = v[j] * rstd * gg[j] + bb[j];
            o8[64 * j] = (unsigned long long)pk2(v[j].x, v[j].y) | ((unsigned long long)pk2(v[j].z, v[j].w) << 32); }
        float d[8];
#pragma unroll
        for (int n = 0; n < 8; ++n) { float a = 0.f;
#pragma unroll
            for (int j = 0; j < 4; ++j) { const f32x4 w = *(const LAS f32x4*)(wdt + n * 1024 + 4 * C.lane + 256 * j); a += (v[j].x * w.x + v[j].y * w.y) + (v[j].z * w.z + v[j].w * w.w); }
            d[n] = wave_sum(a); }
        if (C.lane == 0) { *(f32x4*)(C.DTRAW + (size_t)m * 8) = (f32x4){d[0], d[1], d[2], d[3]}; *(f32x4*)(C.DTRAW + (size_t)m * 8 + 4) = (f32x4){d[4], d[5], d[6], d[7]}; }
    }
}

struct MoeTab { int ntiles; int cnt[NCLS]; int cls[MAXT256]; int row0[MAXT256]; };
constexpr int MOETAB_OFF = 140 * 1024;
__device__ __forceinline__ void class_experts(int c, int& elo, int& ehi) {
    const int g = c / 6, q = c % 6; const int il = q < 3 ? 0 : (q < 5 ? 1 : 2); const int ih = q < 3 ? q + 1 : (q < 5 ? q - 1 : 3);
    elo = g * 4 + il; ehi = g * 4 + ih;
}
__device__ __forceinline__ void build_moetab(const Ctx& C) {
    LAS MoeTab* tb = (LAS MoeTab*)(C.lds + MOETAB_OFF);
    if (C.tid == 0) {
        int nt = 0;
        for (int c = 0; c < NCLS; ++c) { int n = (int)__hip_atomic_load(C.ctl + CW_CNT + c, __ATOMIC_RELAXED, __HIP_MEMORY_SCOPE_AGENT); if (n > LISTCAP) n = LISTCAP; tb->cnt[c] = n;
            for (int r = 0; r < n; r += 256) { if (nt < MAXT256) { tb->cls[nt] = c; tb->row0[nt] = r; ++nt; } } }
        tb->ntiles = nt;
    }
    __syncthreads();
}

template <int NBOP, class Spec> __device__ __forceinline__ void simple_gemm(const Ctx& C, const Spec& sp) {
    LAS float* As = (LAS float*)C.lds;
    LAS float* Bs = As + 16 * 132;
    const int tid = C.tid, ty = tid >> 4, tx = tid & 15;
    const int nmt = sp.n_mtiles(), nnt = sp.n_ntiles(), K = sp.K();
    for (int tile = C.bid; tile < nmt * nnt; tile += C.G) {
        const int mt = tile / nnt, nt = tile % nnt;
        float acc[NBOP][4][4];
#pragma unroll
        for (int o = 0; o < NBOP; ++o)
#pragma unroll
            for (int i = 0; i < 4; ++i)
#pragma unroll
                for (int j = 0; j < 4; ++j) acc[o][i][j] = 0.f;
        const bf16* ap = nullptr; const bf16* bp = nullptr; int bop = 0, bc = 0, bhf = 0;
        if (tid < 256) ap = sp.a_row(mt, nt, tid >> 1);
        else { const int idx = tid - 256; bop = idx >> 7; bc = (idx & 127) >> 1; bhf = idx & 1; }
        for (int k0 = 0; k0 < K; k0 += 16) {
            if (tid < 256) { const int r = tid >> 1, hf = tid & 1; float f[8];
                if (ap) { unpack8(*(const u32x4*)(ap + k0 + hf * 8), f); } else {
#pragma unroll
                    for (int i = 0; i < 8; ++i) f[i] = 0.f; }
#pragma unroll
                for (int i = 0; i < 8; ++i) As[(hf * 8 + i) * 132 + r] = f[i];
            } else if (bop < NBOP) { float f[8]; bp = sp.b_row(mt, nt, bop, bc, k0); unpack8(*(const u32x4*)(bp + bhf * 8), f);
#pragma unroll
                for (int i = 0; i < 8; ++i) Bs[(bop * 16 + bhf * 8 + i) * 68 + bc] = f[i];
            }
            __syncthreads();
#pragma unroll
            for (int k = 0; k < 16; ++k) { const f32x4 a = *(const LAS f32x4*)(As + k * 132 + ty * 4);
#pragma unroll
                for (int o = 0; o < NBOP; ++o) { const f32x4 b = *(const LAS f32x4*)(Bs + (o * 16 + k) * 68 + tx * 4);
                    acc[o][0][0] += a.x * b.x; acc[o][0][1] += a.x * b.y; acc[o][0][2] += a.x * b.z; acc[o][0][3] += a.x * b.w;
                    acc[o][1][0] += a.y * b.x; acc[o][1][1] += a.y * b.y; acc[o][1][2] += a.y * b.z; acc[o][1][3] += a.y * b.w;
                    acc[o][2][0] += a.z * b.x; acc[o][2][1] += a.z * b.y; acc[o][2][2] += a.z * b.z; acc[o][2][3] += a.z * b.w;
                    acc[o][3][0] += a.w * b.x; acc[o][3][1] += a.w * b.y; acc[o][3][2] += a.w * b.z; acc[o][3][3] += a.w * b.w; } }
            __syncthreads();
        }
        sp.epilogue(mt, nt, ty * 4, tx * 4, acc);
    }
}

struct SpecInProj {
    const bf16* XN; const bf16* W; bf16* O;
    __device__ int n_mtiles() const { return NTOK / 128; } __device__ int n_ntiles() const { return NPROJ / 64; } __device__ int K() const { return DM; }
    __device__ const bf16* a_row(int mt, int, int r) const { return XN + (size_t)(mt * 128 + r) * DM; }
    __device__ const bf16* b_row(int, int nt, int, int c, int k0) const { return W + (size_t)(nt * 64 + c) * DM + k0; }
    __device__ void epilogue(int mt, int nt, int r0, int c0, const float (&acc)[1][4][4]) const {
#pragma unroll
        for (int i = 0; i < 4; ++i) { u32x2 w; w.x = pk2(acc[0][i][0], acc[0][i][1]); w.y = pk2(acc[0][i][2], acc[0][i][3]);
            *(u32x2*)(O + (size_t)(mt * 128 + r0 + i) * NPROJ + nt * 64 + c0) = w; }
    }
};
struct SpecPool {
    const bf16* P; const bf16* W; bf16* O; const float* bias; const float* scale;
    __device__ int n_mtiles() const { return NTOK / 128; } __device__ int n_ntiles() const { return 8; } __device__ int K() const { return 128; }
    __device__ const bf16* a_row(int mt, int nt, int r) const { return P + (size_t)(mt * 128 + r) * 512 + (nt >> 1) * 128; }
    __device__ const bf16* b_row(int, int nt, int, int c, int k0) const { return W + (size_t)(nt >> 1) * 16384 + (size_t)((nt & 1) * 64 + c) * 128 + k0; }
    __device__ void epilogue(int mt, int nt, int r0, int c0, const float (&acc)[1][4][4]) const {
        const int col = nt * 64 + c0; const f32x4 b = *(const f32x4*)(bias + col), s = *(const f32x4*)(scale + col);
#pragma unroll
        for (int i = 0; i < 4; ++i) { u32x2 w; w.x = pk2((acc[0][i][0] + b.x) * s.x, (acc[0][i][1] + b.y) * s.y); w.y = pk2((acc[0][i][2] + b.z) * s.z, (acc[0][i][3] + b.w) * s.w);
            *(u32x2*)(O + (size_t)(mt * 128 + r0 + i) * DM + 512 + col) = w; }
    }
};
struct SpecOutProj {
    const bf16* Y; const bf16* W; const bf16* XN; bf16* O;
    __device__ int n_mtiles() const { return NTOK / 128; } __device__ int n_ntiles() const { return DM / 64; } __device__ int K() const { return DM; }
    __device__ const bf16* a_row(int mt, int, int r) const { return Y + (size_t)(mt * 128 + r) * DM; }
    __device__ const bf16* b_row(int, int nt, int, int c, int k0) const { return W + (size_t)(nt * 64 + c) * DM + k0; }
    __device__ void epilogue(int mt, int nt, int r0, int c0, const float (&acc)[1][4][4]) const {
#pragma unroll
        for (int i = 0; i < 4; ++i) { const size_t off = (size_t)(mt * 128 + r0 + i) * DM + nt * 64 + c0; const u32x2 xv = *(const u32x2*)(XN + off);
            u32x2 w; w.x = pk2(ALPHA * bflo(xv.x) + acc[0][i][0], ALPHA * bfhi(xv.x) + acc[0][i][1]); w.y = pk2(ALPHA * bflo(xv.y) + acc[0][i][2], ALPHA * bfhi(xv.y) + acc[0][i][3]);
            *(u32x2*)(O + off) = w; }
    }
};
struct SpecMoe1 {
    const bf16* H1; const bf16* WGU; bf16* HB; const int* LIST; const float* LW; const LAS MoeTab* tb;
    __device__ int n_mtiles() const { return tb->ntiles * 2; } __device__ int n_ntiles() const { return 16; } __device__ int K() const { return DM; }
    __device__ const bf16* a_row(int mt, int, int r) const { const int t = mt >> 1, c = tb->cls[t], rr = tb->row0[t] + (mt & 1) * 128 + r;
        if (rr >= tb->cnt[c]) return nullptr; return H1 + (size_t)LIST[c * LISTCAP + rr] * DM; }
    __device__ const bf16* b_row(int mt, int nt, int op, int c, int k0) const { const int cl = tb->cls[mt >> 1]; int elo, ehi; class_experts(cl, elo, ehi);
        const int hc = nt * 64 + c, slot = hc >> 9, hh = hc & 511, e = slot ? ehi : elo; return WGU + (size_t)e * 1048576 + (size_t)((hh >> 7) * 256 + op * 128 + (hh & 127)) * DM + k0; }
    __device__ void epilogue(int mt, int nt, int r0, int c0, const float (&acc)[2][4][4]) const {
        const int t = mt >> 1, c = tb->cls[t]; const int slot = (nt * 64) >> 9;
#pragma unroll
        for (int i = 0; i < 4; ++i) { const int rr = tb->row0[t] + (mt & 1) * 128 + r0 + i; const float w = rr < tb->cnt[c] ? LW[((size_t)c * LISTCAP + rr) * 2 + slot] : 0.f;
            float h[4];
#pragma unroll
            for (int j = 0; j < 4; ++j) h[j] = w * silu_f(acc[0][i][j]) * acc[1][i][j];
            u32x2 o; o.x = pk2(h[0], h[1]); o.y = pk2(h[2], h[3]);
            *(u32x2*)(HB + (size_t)(mt * 128 + r0 + i) * DM + nt * 64 + c0) = o; }
    }
};
struct SpecMoe2 {
    const bf16* H1; const bf16* WD; const bf16* HB; bf16* R2; const int* LIST; const LAS MoeTab* tb;
    __device__ int n_mtiles() const { return tb->ntiles * 2; } __device__ int n_ntiles() const { return 16; } __device__ int K() const { return DM; }
    __device__ const bf16* a_row(int mt, int, int r) const { return HB + (size_t)(mt * 128 + r) * DM; }
    __device__ const bf16* b_row(int mt, int nt, int, int c, int k0) const { const int cl = tb->cls[mt >> 1]; int elo, ehi; class_experts(cl, elo, ehi);
        const int e = k0 < 512 ? elo : ehi; return WD + (size_t)e * 524288 + (size_t)(nt * 64 + c) * 512 + (k0 & 511); }
    __device__ void epilogue(int mt, int nt, int r0, int c0, const float (&acc)[1][4][4]) const {
        const int t = mt >> 1, c = tb->cls[t];
#pragma unroll
        for (int i = 0; i < 4; ++i) { const int rr = tb->row0[t] + (mt & 1) * 128 + r0 + i; if (rr >= tb->cnt[c]) continue;
            const size_t off = (size_t)LIST[c * LISTCAP + rr] * DM + nt * 64 + c0; const u32x2 xv = *(const u32x2*)(H1 + off);
            u32x2 w; w.x = pk2(ALPHA * bflo(xv.x) + acc[0][i][0], ALPHA * bfhi(xv.x) + acc[0][i][1]); w.y = pk2(ALPHA * bflo(xv.y) + acc[0][i][2], ALPHA * bfhi(xv.y) + acc[0][i][3]);
            *(u32x2*)(R2 + off) = w; }
    }
};

__device__ __forceinline__ void phase_poolwin_simple(const Ctx& C) {
    const int gt = C.bid * NTHREADS + C.tid, NGT = C.G * NTHREADS;
    for (int task = gt; task < NTOK * 64; task += NGT) {
        const int tok = task >> 6, c8 = (task & 63) * 8, g = c8 >> 7, w = 2 << g, t = tok & (SEQ - 1);
        float s[8], u0[8];
#pragma unroll
        for (int i = 0; i < 8; ++i) s[i] = 0.f;
        for (int d = 0; d < w; ++d) { if (t - d < 0) break; float f[8]; unpack8(*(const u32x4*)(C.PROJ + (size_t)(tok - d) * NPROJ + PC_U + c8), f);
#pragma unroll
            for (int i = 0; i < 8; ++i) { s[i] += f[i]; if (d == 0) u0[i] = f[i]; } }
        const float inv = 1.0f / (float)((t + 1) < w ? (t + 1) : w);
        u32x4 o; o.x = pk2(s[0] * inv - u0[0], s[1] * inv - u0[1]); o.y = pk2(s[2] * inv - u0[2], s[3] * inv - u0[3]); o.z = pk2(s[4] * inv - u0[4], s[5] * inv - u0[5]); o.w = pk2(s[6] * inv - u0[6], s[7] * inv - u0[7]);
        *(u32x4*)(C.PWIN + (size_t)tok * 512 + c8) = o;
    }
}
__device__ __forceinline__ void phase_conv_simple(const Ctx& C) {
    const int gt = C.bid * NTHREADS + C.tid, NGT = C.G * NTHREADS;
    for (int task = gt; task < NTOK * 128; task += NGT) {
        const int tok = task >> 7, c8 = (task & 127) * 8, t = tok & (SEQ - 1);
        float a[8];
        { const f32x4 b0 = *(const f32x4*)(C.conv_b + c8), b1 = *(const f32x4*)(C.conv_b + c8 + 4); a[0] = b0.x; a[1] = b0.y; a[2] = b0.z; a[3] = b0.w; a[4] = b1.x; a[5] = b1.y; a[6] = b1.z; a[7] = b1.w; }
#pragma unroll
        for (int k = 0; k < 4; ++k) { const int d = 3 - k; if (t - d < 0) continue; float f[8]; unpack8(*(const u32x4*)(C.PROJ + (size_t)(tok - d) * NPROJ + PC_X + c8), f);
            const f32x4 w0 = *(const f32x4*)(C.conv_w + k * 1024 + c8), w1 = *(const f32x4*)(C.conv_w + k * 1024 + c8 + 4);
            a[0] += w0.x * f[0]; a[1] += w0.y * f[1]; a[2] += w0.z * f[2]; a[3] += w0.w * f[3]; a[4] += w1.x * f[4]; a[5] += w1.y * f[5]; a[6] += w1.z * f[6]; a[7] += w1.w * f[7]; }
        u32x4 o; o.x = pk2(silu_f(a[0]), silu_f(a[1])); o.y = pk2(silu_f(a[2]), silu_f(a[3])); o.z = pk2(silu_f(a[4]), silu_f(a[5])); o.w = pk2(silu_f(a[6]), silu_f(a[7]));
        *(u32x4*)(C.XBCC + (size_t)tok * 1024 + c8) = o;
    }
}
__device__ __forceinline__ void phase_dt_simple(const Ctx& C) {
    const int gt = C.bid * NTHREADS + C.tid;
    if (gt < NBATCH * NCHUNK * NHEAD) {
        const int h = gt & 7, bc = gt >> 3; const float bias = C.dt_bias[h], A = -__expf(C.a_log[h]); float acc = 0.f;
        for (int l = 0; l < CHUNK; ++l) { const size_t idx = (size_t)(bc * CHUNK + l) * 8 + h; const float v = C.DTRAW[idx] + bias; const float dt = v > 20.f ? v : log1pf(__expf(v));
            acc += dt * A; C.DTV[idx] = dt; C.ACL[idx] = acc; }
        C.CHD[gt] = __expf(acc);
    }
}
__device__ __forceinline__ void phase_states_simple(const Ctx& C) {
    LAS float* wl = (LAS float*)C.lds;
    for (int item = C.bid; item < NBATCH * NCHUNK * NHEAD; item += C.G) {
        const int h = item & 7, bc = item >> 3, g = h >> 2, tok0 = bc * CHUNK;
        __syncthreads();
        if (C.tid < CHUNK) { const float last = C.ACL[(size_t)(tok0 + CHUNK - 1) * 8 + h]; const size_t idx = (size_t)(tok0 + C.tid) * 8 + h; wl[C.tid] = C.DTV[idx] * __expf(last - C.ACL[idx]); }
        __syncthreads();
        const int p = C.tid >> 3, n0 = (C.tid & 7) * 16;
        float acc[16];
#pragma unroll
        for (int i = 0; i < 16; ++i) acc[i] = 0.f;
        for (int l = 0; l < CHUNK; ++l) { const bf16* row = C.XBCC + (size_t)(tok0 + l) * 1024; const float xv = bf2f(row[h * 64 + p]) * wl[l];
            float f[8]; unpack8(*(const u32x4*)(row + 512 + g * 128 + n0), f);
#pragma unroll
            for (int i = 0; i < 8; ++i) acc[i] += xv * f[i];
            unpack8(*(const u32x4*)(row + 512 + g * 128 + n0 + 8), f);
#pragma unroll
            for (int i = 0; i < 8; ++i) acc[8 + i] += xv * f[i]; }
        float* o = C.STATES + (size_t)item * 8192 + p * 128 + n0;
#pragma unroll
        for (int i = 0; i < 4; ++i) *(f32x4*)(o + 4 * i) = (f32x4){acc[4 * i], acc[4 * i + 1], acc[4 * i + 2], acc[4 * i + 3]};
    }
}
__device__ __forceinline__ void phase_scan(const Ctx& C) {
    const int gt = C.bid * NTHREADS + C.tid, NGT = C.G * NTHREADS;
    for (int task = gt; task < NBATCH * NHEAD * 2048; task += NGT) {
        const int e4 = task & 2047, bh = task >> 11, b = bh >> 3, h = bh & 7;
        f32x4 run = (f32x4){0.f, 0.f, 0.f, 0.f};
        f32x4 st[NCHUNK]; float dec[NCHUNK];
#pragma unroll
        for (int c = 0; c < NCHUNK; ++c) { const size_t item = (size_t)((b * NCHUNK + c) * 8 + h); st[c] = *(const f32x4*)(C.STATES + item * 8192 + e4 * 4); dec[c] = C.CHD[item]; }
#pragma unroll
        for (int c = 0; c < NCHUNK; ++c) { const size_t item = (size_t)((b * NCHUNK + c) * 8 + h);
            u32x2 o; o.x = pk2(run.x, run.y); o.y = pk2(run.z, run.w); *(u32x2*)(C.PREV + item * 8192 + e4 * 4) = o;
            run = run * dec[c] + st[c]; }
    }
}
__device__ __forceinline__ void phase_y_simple(const Ctx& C) {
    LAS float* S = (LAS float*)C.lds;
    LAS float* acl = S + 128 * 129;
    LAS float* dtl = acl + 512;
    for (int item = C.bid; item < NBATCH * NCHUNK * 2; item += C.G) {
        const int g = item & 1, bc = item >> 1, tok0 = bc * CHUNK;
        __syncthreads();
        { const int l = C.tid & 127, j = C.tid >> 7; const size_t idx = (size_t)(tok0 + l) * 8 + g * 4 + j; acl[j * 128 + l] = C.ACL[idx]; dtl[j * 128 + l] = C.DTV[idx]; }
        { const int l = C.tid >> 2, s0 = (C.tid & 3) * 32; const bf16* crow = C.XBCC + (size_t)(tok0 + l) * 1024 + 768 + g * 128;
            for (int s = s0; s < s0 + 32; ++s) { float a = 0.f;
                if (s <= l) { const bf16* brow = C.XBCC + (size_t)(tok0 + s) * 1024 + 512 + g * 128;
                    for (int n = 0; n < 128; n += 8) { float cf[8], bf[8]; unpack8(*(const u32x4*)(crow + n), cf); unpack8(*(const u32x4*)(brow + n), bf);
#pragma unroll
                        for (int i = 0; i < 8; ++i) a += cf[i] * bf[i]; } }
                S[l * 129 + s] = a; } }
        __syncthreads();
        for (int tk = C.tid; tk < 128 * 4 * 8; tk += NTHREADS) {
            const int pc = tk & 7, j = (tk >> 3) & 3, l = tk >> 5, h = g * 4 + j, ch = h * 64 + pc * 8;
            float y[8];
#pragma unroll
            for (int i = 0; i < 8; ++i) y[i] = 0.f;
            const float al = acl[j * 128 + l];
            for (int s = 0; s <= l; ++s) { const float gsc = S[l * 129 + s] * __expf(al - acl[j * 128 + s]) * dtl[j * 128 + s];
                float f[8]; unpack8(*(const u32x4*)(C.XBCC + (size_t)(tok0 + s) * 1024 + ch), f);
#pragma unroll
                for (int i = 0; i < 8; ++i) y[i] += gsc * f[i]; }
            const float el = __expf(al); const bf16* crow = C.XBCC + (size_t)(tok0 + l) * 1024 + 768 + g * 128;
            const bf16* pv = C.PREV + (size_t)(bc * 8 + h) * 8192 + (size_t)(pc * 8) * 128;
            for (int n = 0; n < 128; n += 8) { float cf[8]; unpack8(*(const u32x4*)(crow + n), cf);
#pragma unroll
                for (int i = 0; i < 8; ++i) { float pf[8]; unpack8(*(const u32x4*)(pv + i * 128 + n), pf); float a = 0.f;
#pragma unroll
                    for (int q = 0; q < 8; ++q) a += cf[q] * pf[q];
                    y[i] += el * a; } }
            float xf[8], zf[8]; unpack8(*(const u32x4*)(C.XBCC + (size_t)(tok0 + l) * 1024 + ch), xf); unpack8(*(const u32x4*)(C.PROJ + (size_t)(tok0 + l) * NPROJ + PC_Z + ch), zf);
            const float dsk = C.d_skip[h];
            float* o = C.YG + (size_t)(tok0 + l) * 512 + ch;
            f32x4 o0, o1;
            o0.x = (y[0] + dsk * xf[0]) * silu_f(zf[0]); o0.y = (y[1] + dsk * xf[1]) * silu_f(zf[1]); o0.z = (y[2] + dsk * xf[2]) * silu_f(zf[2]); o0.w = (y[3] + dsk * xf[3]) * silu_f(zf[3]);
            o1.x = (y[4] + dsk * xf[4]) * silu_f(zf[4]); o1.y = (y[5] + dsk * xf[5]) * silu_f(zf[5]); o1.z = (y[6] + dsk * xf[6]) * silu_f(zf[6]); o1.w = (y[7] + dsk * xf[7]) * silu_f(zf[7]);
            *(f32x4*)o = o0; *(f32x4*)(o + 4) = o1;
        }
    }
}
__device__ __forceinline__ void phase_rms_simple(const Ctx& C) {
    const int gw = C.bid * NWAVES + C.wave, NGW = C.G * NWAVES;
    for (int task = gw; task < NTOK * 2; task += NGW) {
        const int tok = task >> 1, g = task & 1; const f32x4 v = *(const f32x4*)(C.YG + (size_t)tok * 512 + g * 256 + 4 * C.lane);
        const float ss = wave_sum((v.x * v.x + v.y * v.y) + (v.z * v.z + v.w * v.w)); const float r = 1.0f / sqrtf(ss * (1.f / 256.f) + RMS_EPS);
        const f32x4 ng = *(const f32x4*)(C.ssm_norm_g + g * 256 + 4 * C.lane);
        u32x2 o; o.x = pk2(v.x * r * ng.x, v.y * r * ng.y); o.y = pk2(v.z * r * ng.z, v.w * r * ng.w);
        *(u32x2*)(C.YMIX + (size_t)tok * DM + g * 256 + 4 * C.lane) = o;
    }
}

__device__ __forceinline__ void phase_ln1_router(const Ctx& C) {
    LAS float* wr = (LAS float*)C.lds;
    LAS int* rcls = (LAS int*)(C.lds + 20 * 4096);
    LAS float* rw = (LAS float*)(C.lds + 20 * 4096 + 512);
    LAS int* rpos = (LAS int*)(C.lds + 20 * 4096 + 512 + 1024);
    LAS int* lcnt = (LAS int*)(C.lds + 20 * 4096 + 512 + 1024 + 512);
    LAS int* lbase = lcnt + 32;
    for (int i = C.tid; i < 1024 * 4; i += NTHREADS) { const int k = i >> 2, n = i & 3; wr[n * 1024 + k] = C.w_rg[i]; }
    for (int i = C.tid; i < 1024 * 16; i += NTHREADS) { const int k = i >> 4, n = i & 15; wr[(4 + n) * 1024 + k] = C.w_re[i]; }
    f32x4 gg[4], bb[4];
#pragma unroll
    for (int j = 0; j < 4; ++j) { gg[j] = *(const f32x4*)(C.ln1_g + 4 * C.lane + 256 * j); bb[j] = *(const f32x4*)(C.ln1_b + 4 * C.lane + 256 * j); }
    float brg[4], bre[16];
#pragma unroll
    for (int i = 0; i < 4; ++i) brg[i] = C.b_rg[i];
#pragma unroll
    for (int i = 0; i < 16; ++i) bre[i] = C.b_re[i];
    for (int rb = C.bid; rb < NTOK / 128; rb += C.G) {
        __syncthreads();
        if (C.tid < 32) lcnt[C.tid] = 0;
        for (int rr = 0; rr < 16; ++rr) {
            const int r = C.wave * 16 + rr, m = rb * 128 + r;
            const u32x2* xr = (const u32x2*)(C.R1 + (size_t)m * DM) + C.lane;
            f32x4 v[4]; float s = 0.f;
#pragma unroll
            for (int j = 0; j < 4; ++j) { const u32x2 w = xr[64 * j]; v[j] = (f32x4){bflo(w.x), bfhi(w.x), bflo(w.y), bfhi(w.y)}; s += (v[j].x + v[j].y) + (v[j].z + v[j].w); }
            const float mean = wave_sum(s) * (1.f / DM); float s2 = 0.f;
#pragma unroll
            for (int j = 0; j < 4; ++j) { v[j] = v[j] - mean; s2 += (v[j].x * v[j].x + v[j].y * v[j].y) + (v[j].z * v[j].z + v[j].w * v[j].w); }
            const float rstd = 1.f / sqrtf(wave_sum(s2) * (1.f / DM) + LN_EPS);
            u32x2* o8 = (u32x2*)(C.H1 + (size_t)m * DM) + C.lane;
#pragma unroll
            for (int j = 0; j < 4; ++j) { v[j] = v[j] * rstd * gg[j] + bb[j]; u32x2 o; o.x = pk2(v[j].x, v[j].y); o.y = pk2(v[j].z, v[j].w); o8[64 * j] = o; }
            float lg[20];
#pragma unroll
            for (int n = 0; n < 20; ++n) { float a = 0.f;
#pragma unroll
                for (int j = 0; j < 4; ++j) { const f32x4 w = *(const LAS f32x4*)(wr + n * 1024 + 4 * C.lane + 256 * j); a += (v[j].x * w.x + v[j].y * w.y) + (v[j].z * w.z + v[j].w * w.w); }
                lg[n] = wave_sum(a); }
            float g0 = lg[0] + brg[0], g1 = lg[1] + brg[1], g2 = lg[2] + brg[2], g3 = lg[3] + brg[3];
            int gi = 0; float gm = g0; if (g1 > gm) { gm = g1; gi = 1; } if (g2 > gm) { gm = g2; gi = 2; } if (g3 > gm) { gm = g3; gi = 3; }
            const float gwt = 1.0f / (__expf(g0 - gm) + __expf(g1 - gm) + __expf(g2 - gm) + __expf(g3 - gm));
            float e[4];
#pragma unroll
            for (int i = 0; i < 4; ++i) { const float a0 = lg[4 + i] + bre[i], a1 = lg[8 + i] + bre[4 + i], a2 = lg[12 + i] + bre[8 + i], a3 = lg[16 + i] + bre[12 + i]; e[i] = gi == 0 ? a0 : (gi == 1 ? a1 : (gi == 2 ? a2 : a3)); }
            int i1 = 0; float v1 = e[0]; if (e[1] > v1) { v1 = e[1]; i1 = 1; } if (e[2] > v1) { v1 = e[2]; i1 = 2; } if (e[3] > v1) { v1 = e[3]; i1 = 3; }
            int i2 = -1; float v2 = -3.0e38f;
#pragma unroll
            for (int i = 0; i < 4; ++i) if (i != i1 && e[i] > v2) { v2 = e[i]; i2 = i; }
            const float ex = __expf(v2 - v1), p1 = 1.0f / (1.0f + ex), p2 = ex * p1;
            const int il = i1 < i2 ? i1 : i2, ih = i1 < i2 ? i2 : i1; const float wl = (i1 < i2 ? p1 : p2) * gwt, wh = (i1 < i2 ? p2 : p1) * gwt;
            const int q = il == 0 ? ih - 1 : (il == 1 ? ih + 1 : 5);
            if (C.lane == 0) { rcls[r] = gi * 6 + q; rw[r * 2] = wl; rw[r * 2 + 1] = wh; }
        }
        __syncthreads();
        if (C.tid < 128) rpos[C.tid] = atomicAdd((int*)&lcnt[rcls[C.tid]], 1);
        __syncthreads();
        if (C.tid < NCLS) lbase[C.tid] = lcnt[C.tid] > 0 ? (int)__hip_atomic_fetch_add(C.ctl + CW_CNT + C.tid, (unsigned)lcnt[C.tid], __ATOMIC_RELAXED, __HIP_MEMORY_SCOPE_AGENT) : 0;
        __syncthreads();
        if (C.tid < 128) { const int c = rcls[C.tid], pos = lbase[c] + rpos[C.tid];
            if (pos < LISTCAP) { C.LIST[c * LISTCAP + pos] = rb * 128 + C.tid; C.LW[((size_t)c * LISTCAP + pos) * 2] = rw[C.tid * 2]; C.LW[((size_t)c * LISTCAP + pos) * 2 + 1] = rw[C.tid * 2 + 1]; } }
    }
}

__device__ __forceinline__ void phase_ln2(const Ctx& C) {
    const int gw = C.bid * NWAVES + C.wave, NGW = C.G * NWAVES;
    f32x4 gg[4], bb[4];
#pragma unroll
    for (int j = 0; j < 4; ++j) { gg[j] = *(const f32x4*)(C.ln2_g + 4 * C.lane + 256 * j); bb[j] = *(const f32x4*)(C.ln2_b + 4 * C.lane + 256 * j); }
    for (int m = gw; m < NTOK; m += NGW) {
        const u32x2* xr = (const u32x2*)(C.R2 + (size_t)m * DM) + C.lane;
        f32x4 v[4]; float s = 0.f;
#pragma unroll
        for (int j = 0; j < 4; ++j) { const u32x2 w = xr[64 * j]; v[j] = (f32x4){bflo(w.x), bfhi(w.x), bflo(w.y), bfhi(w.y)}; s += (v[j].x + v[j].y) + (v[j].z + v[j].w); }
        const float mean = wave_sum(s) * (1.f / DM); float s2 = 0.f;
#pragma unroll
        for (int j = 0; j < 4; ++j) { v[j] = v[j] - mean; s2 += (v[j].x * v[j].x + v[j].y * v[j].y) + (v[j].z * v[j].z + v[j].w * v[j].w); }
        const float rstd = 1.f / sqrtf(wave_sum(s2) * (1.f / DM) + LN_EPS);
        f32x4* o = (f32x4*)(C.out + (size_t)m * DM) + C.lane;
#pragma unroll
        for (int j = 0; j < 4; ++j) o[64 * j] = v[j] * rstd * gg[j] + bb[j];
    }
}

#define XB_TMO      128
#define XB_XCNT(j)  (256  + 64 * (j))
#define XB_XSUB(j)  (1280 + 64 * (j))
#define XB_XGEN(j)  (2304 + 64 * (j))
#define XB_TOP      3328
#define XB_TOPGEN   3392
#define XCD_BAR_WORDS 3456
#define XB_SPIN_CAP (1u << 18)
constexpr int CW_BAR = 4096;
constexpr int MISC_OFF = LDS_BYTES - 256;
__device__ __forceinline__ unsigned xb_ld(unsigned* p)              { return __hip_atomic_load(p, __ATOMIC_RELAXED, __HIP_MEMORY_SCOPE_AGENT); }
__device__ __forceinline__ unsigned xb_add(unsigned* p, unsigned v) { return __hip_atomic_fetch_add(p, v, __ATOMIC_RELAXED, __HIP_MEMORY_SCOPE_AGENT); }
__device__ __forceinline__ unsigned xb_xcc_id() { return (unsigned)__builtin_amdgcn_s_getreg((3 << 11) | 20) & 0xFu; }
#define XB_SPIN(cond, bar) do { unsigned _sp = 0; while (cond) { __builtin_amdgcn_s_sleep(1); \
    if ((++_sp & 255u) == 0u) { if (xb_ld(&(bar)[XB_TMO])) break; if (_sp > XB_SPIN_CAP) { atomicAdd(&(bar)[XB_TMO], 1u); break; } } } } while (0)
struct XcdBarrier { unsigned* bar; unsigned x; volatile LAS unsigned* st; };
__device__ __forceinline__ XcdBarrier xcd_barrier_post(unsigned* bar, volatile LAS unsigned* st) {
    XcdBarrier b; b.bar = bar; b.x = xb_xcc_id(); b.st = st;
    if (threadIdx.x == 0) (void)xb_add(&bar[XB_XCNT(b.x)], 1u);
    return b;
}
__device__ __forceinline__ void xcd_barrier_complete(unsigned* bar, unsigned x, unsigned& nloc, unsigned& nx) {
    const unsigned G = gridDim.x * gridDim.y * gridDim.z;
    unsigned sum, cnt, mine, sp = 0u;
    for (;;) {
        sum = 0u; cnt = 0u; mine = 0u;
#pragma unroll
        for (unsigned j = 0; j < 16; ++j) { const unsigned c = xb_ld(&bar[XB_XCNT(j)]); sum += c; cnt += (c > 0u) ? 1u : 0u; mine = (j == x) ? c : mine; }
        if (sum == G) break;
        __builtin_amdgcn_s_sleep(1);
        if ((++sp & 255u) == 0u) { if (xb_ld(&bar[XB_TMO])) break; if (sp > XB_SPIN_CAP) { atomicAdd(&bar[XB_TMO], 1u); break; } }
    }
    nloc = mine > 0u ? mine : 1u; nx = cnt > 0u ? cnt : 1u;
}
__device__ __forceinline__ void xcd_barrier(const XcdBarrier& b) {
    asm volatile("s_waitcnt vmcnt(0)" ::: "memory");
    __syncthreads();
    if (threadIdx.x == 0) {
        unsigned* bar = b.bar;
        __builtin_amdgcn_s_waitcnt(0);
        unsigned nloc = b.st[0], nx = b.st[1];
        if (nloc == 0u) { xcd_barrier_complete(bar, b.x, nloc, nx); b.st[0] = nloc; b.st[1] = nx; }
        const unsigned old = xb_add(&bar[XB_XSUB(b.x)], 1u);
        const unsigned gen = old / nloc;
        if (old + 1u == (gen + 1u) * nloc) {
            __builtin_amdgcn_fence(__ATOMIC_RELEASE, "agent");
            asm volatile("s_waitcnt vmcnt(0)" ::: "memory");
            const unsigned og = xb_add(&bar[XB_TOP], 1u);
            const unsigned tg = og / nx;
            if (og + 1u == (tg + 1u) * nx) xb_add(&bar[XB_TOPGEN], 1u);
            else XB_SPIN(xb_ld(&bar[XB_TOPGEN]) == tg, bar);
            __builtin_amdgcn_fence(__ATOMIC_ACQUIRE, "agent");
            xb_add(&bar[XB_XGEN(b.x)], 1u);
            asm volatile("s_waitcnt vmcnt(0)" ::: "memory");
        } else {
            XB_SPIN(xb_ld(&bar[XB_XGEN(b.x)]) == gen, bar);
            __builtin_amdgcn_fence(__ATOMIC_ACQUIRE, "agent");
            asm volatile("s_waitcnt vmcnt(0)" ::: "memory");
        }
    }
    __syncthreads();
}

constexpr int N_PHASES = 15;
template <int LO, int HI> __global__ void __launch_bounds__(NTHREADS, 2) fwd_kernel(Args args) {
    extern __shared__ __attribute__((aligned(16))) unsigned char lds_raw[];
    Ctx C;
    C.lds = (LAS unsigned char*)lds_raw;
    C.tid = threadIdx.x; C.lane = C.tid & 63; C.wave = __builtin_amdgcn_readfirstlane(C.tid >> 6); C.G = gridDim.x; C.bid = blockIdx.x;
    C.x = args.in[0]; C.ln0_g = args.in[1]; C.ln0_b = args.in[2]; C.w_in = args.in[3]; C.conv_w = args.in[4]; C.conv_b = args.in[5]; C.dt_bias = args.in[6]; C.a_log = args.in[7];
    C.d_skip = args.in[8]; C.ssm_norm_g = args.in[9]; C.w_pool = args.in[10]; C.b_pool = args.in[11]; C.pool_scale = args.in[12]; C.w_out = args.in[13]; C.ln1_g = args.in[14]; C.ln1_b = args.in[15];
    C.w_rg = args.in[16]; C.b_rg = args.in[17]; C.w_re = args.in[18]; C.b_re = args.in[19]; C.w_gate = args.in[20]; C.w_up = args.in[21]; C.w_down = args.in[22]; C.ln2_g = args.in[23]; C.ln2_b = args.in[24];
    C.out = args.out; C.ws = args.ws; unsigned char* ws = args.ws; C.ctl = (unsigned*)(ws + WS_CTL);
    C.WIN = (bf16*)(ws + WS_WIN); C.WOUT = (bf16*)(ws + WS_WOUT); C.WPOOL = (bf16*)(ws + WS_WPOOL); C.WGU = (bf16*)(ws + WS_WGU); C.WD = (bf16*)(ws + WS_WD);
    C.XN = (bf16*)(ws + WS_XN); C.PROJ = (bf16*)(ws + WS_PROJ); C.YMIX = (bf16*)(ws + WS_YMIX); C.PREV = (bf16*)(ws + WS_PREV); C.XBCC = (bf16*)(ws + WS_XBCC);
    C.R1 = (bf16*)(ws + WS_R1); C.H1 = (bf16*)(ws + WS_H1); C.HB = (bf16*)(ws + WS_HB); C.R2 = (bf16*)(ws + WS_R2); C.PWIN = (bf16*)(ws + WS_PWIN);
    C.DTRAW = (float*)(ws + WS_DTRAW); C.DTV = (float*)(ws + WS_DTV); C.ACL = (float*)(ws + WS_ACL); C.CHD = (float*)(ws + WS_CHD); C.STATES = (float*)(ws + WS_STATES);
    C.LW = (float*)(ws + WS_LW); C.YG = (float*)(ws + WS_YG); C.LIST = (int*)(ws + WS_LIST);
    const LAS MoeTab* tb = (const LAS MoeTab*)(C.lds + MOETAB_OFF);
    XcdBarrier bar; bar.bar = C.ctl + CW_BAR; bar.x = 0; bar.st = nullptr;
    if constexpr (HI - LO > 1) {
        volatile LAS unsigned* misc = (volatile LAS unsigned*)(C.lds + MISC_OFF);
        if (C.tid < 64) misc[C.tid] = 0u;
        __syncthreads();
        bar = xcd_barrier_post(C.ctl + CW_BAR, misc + 8);
    }
#define IN(k) (LO <= (k) && (k) < HI)
#define SEAM(k) do { if constexpr (IN(k) && IN((k) + 1)) xcd_barrier(bar); } while (0)
    if constexpr (IN(0)) phase_prep(C);
    SEAM(0);
    if constexpr (IN(1)) { SpecInProj sp{C.XN, C.WIN, C.PROJ}; simple_gemm<1>(C, sp); }
    SEAM(1);
    if constexpr (IN(2)) phase_poolwin_simple(C);
    SEAM(2);
    if constexpr (IN(3)) { SpecPool sp{C.PWIN, C.WPOOL, C.YMIX, C.b_pool, C.pool_scale}; simple_gemm<1>(C, sp); }
    SEAM(3);
    if constexpr (IN(4)) phase_conv_simple(C);
    SEAM(4);
    if constexpr (IN(5)) phase_dt_simple(C);
    SEAM(5);
    if constexpr (IN(6)) phase_states_simple(C);
    SEAM(6);
    if constexpr (IN(7)) phase_scan(C);
    SEAM(7);
    if constexpr (IN(8)) phase_y_simple(C);
    SEAM(8);
    if constexpr (IN(9)) phase_rms_simple(C);
    SEAM(9);
    if constexpr (IN(10)) { SpecOutProj sp{C.YMIX, C.WOUT, C.XN, C.R1}; simple_gemm<1>(C, sp); }
    SEAM(10);
    if constexpr (IN(11)) phase_ln1_router(C);
    SEAM(11);
    if constexpr (IN(12)) { build_moetab(C); SpecMoe1 sp{C.H1, C.WGU, C.HB, C.LIST, C.LW, tb}; simple_gemm<2>(C, sp); }
    SEAM(12);
    if constexpr (IN(13)) { build_moetab(C); SpecMoe2 sp{C.H1, C.WD, C.HB, C.R2, C.LIST, tb}; simple_gemm<1>(C, sp); }
    SEAM(13);
    if constexpr (IN(14)) phase_ln2(C);
#undef IN
#undef SEAM
}

#ifndef ONE_LAUNCH
#define ONE_LAUNCH 1
#endif
template <int P, int Q> static void launch_phase(int grid, hipStream_t stream, const Args& a) {
    static bool attr = false;
    if (!attr) { (void)hipFuncSetAttribute((const void*)fwd_kernel<P, Q>, hipFuncAttributeMaxDynamicSharedMemorySize, LDS_BYTES); (void)hipGetLastError(); attr = true; }
    hipLaunchKernelGGL((fwd_kernel<P, Q>), dim3(grid), dim3(NTHREADS), LDS_BYTES, stream, a);
}

extern "C" void kernel_launch(void* const* d_in, const int* in_sizes, int n_in, void* d_out, int out_size, void* d_ws, size_t ws_size, hipStream_t stream) {
    static int grid = 0;
    if (grid == 0) {
        if (n_in != 25 || in_sizes[0] != NTOK * DM || out_size != NTOK * DM || ws_size < WS_END) { fprintf(stderr, "kernel_launch: unexpected shapes (n_in %d, in0 %d, out %d, ws %zu)\n", n_in, n_in > 0 ? in_sizes[0] : -1, out_size, ws_size); grid = -1; return; }
        int dev = 0, cus = 0;
        if (hipGetDevice(&dev) != hipSuccess || hipDeviceGetAttribute(&cus, hipDeviceAttributeMultiprocessorCount, dev) != hipSuccess) { grid = -1; return; }
        (void)hipGetLastError();
        grid = cus > 0 ? cus : 256;
    }
    if (grid < 0) return;
    (void)hipMemsetAsync((char*)d_ws + WS_CTL, 0, CTL_ZERO_BYTES, stream);
    Args a{};
    for (int i = 0; i < 25; ++i) a.in[i] = (const float*)d_in[i];
    a.out = (float*)d_out; a.ws = (unsigned char*)d_ws;
#if ONE_LAUNCH
    launch_phase<0, N_PHASES>(grid, stream, a);
#else
    launch_phase<0, 1>(grid, stream, a); launch_phase<1, 2>(grid, stream, a); launch_phase<2, 3>(grid, stream, a); launch_phase<3, 4>(grid, stream, a); launch_phase<4, 5>(grid, stream, a);
    launch_phase<5, 6>(grid, stream, a); launch_phase<6, 7>(grid, stream, a); launch_phase<7, 8>(grid, stream, a); launch_phase<8, 9>(grid, stream, a); launch_phase<9, 10>(grid, stream, a);
    launch_phase<10, 11>(grid, stream, a); launch_phase<11, 12>(grid, stream, a); launch_phase<12, 13>(grid, stream, a); launch_phase<13, 14>(grid, stream, a); launch_phase<14, 15>(grid, stream, a);
#endif
}
```

```cpp
#include <hip/hip_runtime.h>
#include <cstdio>
#include <cstdint>

#define GAS __attribute__((address_space(1)))
#define LAS __attribute__((address_space(3)))
typedef unsigned short bf16;
typedef float f32x4 __attribute__((ext_vector_type(4)));
typedef float f32x2 __attribute__((ext_vector_type(2)));
typedef unsigned u32x4 __attribute__((ext_vector_type(4)));
typedef unsigned u32x2 __attribute__((ext_vector_type(2)));

constexpr int NTOK = 32768, DM = 1024, SEQ = 2048, NBATCH = 16, NPROJ = 2048, DINP = 2056;
constexpr int NCHUNK = 16, CHUNK = 128, NHEAD = 8, HP = 64, NST = 128;
constexpr int NCLS = 24, LISTCAP = 32768, MAXT256 = 160;
constexpr float LN_EPS = 1e-5f, RMS_EPS = 1e-5f;
constexpr float ALPHA = 1.189207115002721f;

constexpr int PC_Z = 0, PC_X = 512, PC_B = 1024, PC_C = 1280, PC_U = 1536;

constexpr size_t MiB = 1u << 20;
constexpr size_t WS_CTL = 0, CTL_ZERO_BYTES = 1 * MiB;
constexpr size_t WS_WIN = 2 * MiB;
constexpr size_t WS_WOUT = 6 * MiB;
constexpr size_t WS_WPOOL = 8 * MiB;
constexpr size_t WS_WGU = 10 * MiB;
constexpr size_t WS_WD = 42 * MiB;
constexpr size_t WS_DTRAW = 58 * MiB;
constexpr size_t WS_DTV = 59 * MiB;
constexpr size_t WS_ACL = 60 * MiB;
constexpr size_t WS_CHD = 61 * MiB;
constexpr size_t WS_LIST = 62 * MiB;
constexpr size_t WS_LW = 65 * MiB;
constexpr size_t WS_XN = 72 * MiB;
constexpr size_t WS_PROJ = 136 * MiB;
constexpr size_t WS_YMIX = 264 * MiB;
constexpr size_t WS_STATES = 328 * MiB;
constexpr size_t WS_PREV = 392 * MiB;
constexpr size_t WS_XBCC = 424 * MiB;
constexpr size_t WS_R1 = WS_PROJ;
constexpr size_t WS_H1 = WS_PROJ + 64 * MiB;
constexpr size_t WS_HB = WS_STATES;
constexpr size_t WS_R2 = WS_XN;
constexpr size_t WS_PWIN = WS_STATES;
constexpr size_t WS_YG = WS_STATES;
constexpr size_t WS_END = 488 * MiB;
constexpr int CW_CNT = 1024;

#ifndef FAST_INPROJ
#define FAST_INPROJ 1
#endif
#ifndef FAST_OUTPROJ
#define FAST_OUTPROJ 1
#endif
#ifndef FAST_MOE1
#define FAST_MOE1 1
#endif
#ifndef FAST_MOE2
#define FAST_MOE2 1
#endif
constexpr int LDS_BYTES = 147456;
constexpr int NTHREADS = 512, NWAVES = 8;

__device__ __forceinline__ unsigned f2bf(float f) { unsigned u = __builtin_bit_cast(unsigned, f); return (u + 0x7fffu + ((u >> 16) & 1u)) >> 16; }
__device__ __forceinline__ unsigned pk2(float lo, float hi) { return f2bf(lo) | (f2bf(hi) << 16); }
__device__ __forceinline__ float bf2f(bf16 h) { return __uint_as_float((unsigned)h << 16); }
__device__ __forceinline__ float bflo(unsigned w) { return __uint_as_float(w << 16); }
__device__ __forceinline__ float bfhi(unsigned w) { return __uint_as_float(w & 0xffff0000u); }
__device__ __forceinline__ float wave_sum(float v) {
#pragma unroll
    for (int o = 1; o < 64; o <<= 1) v += __shfl_xor(v, o);
    return v;
}
__device__ __forceinline__ float silu_f(float v) { return v / (1.0f + __expf(-v)); }
__device__ __forceinline__ void unpack8(const u32x4 v, float (&f)[8]) {
    f[0] = bflo(v.x); f[1] = bfhi(v.x); f[2] = bflo(v.y); f[3] = bfhi(v.y); f[4] = bflo(v.z); f[5] = bfhi(v.z); f[6] = bflo(v.w); f[7] = bfhi(v.w);
}

struct Args { const float* in[25]; float* out; unsigned char* ws; int ph_lo, ph_hi; };

struct Ctx {
    const Args* a; unsigned char* ws; LAS unsigned char* lds;
    int tid, lane, wave, G, bid;
    __device__ __forceinline__ const float* x() const { return a->in[0]; }
    __device__ __forceinline__ const float* ln0_g() const { return a->in[1]; }
    __device__ __forceinline__ const float* ln0_b() const { return a->in[2]; }
    __device__ __forceinline__ const float* w_in() const { return a->in[3]; }
    __device__ __forceinline__ const float* conv_w() const { return a->in[4]; }
    __device__ __forceinline__ const float* conv_b() const { return a->in[5]; }
    __device__ __forceinline__ const float* dt_bias() const { return a->in[6]; }
    __device__ __forceinline__ const float* a_log() const { return a->in[7]; }
    __device__ __forceinline__ const float* d_skip() const { return a->in[8]; }
    __device__ __forceinline__ const float* ssm_norm_g() const { return a->in[9]; }
    __device__ __forceinline__ const float* w_pool() const { return a->in[10]; }
    __device__ __forceinline__ const float* b_pool() const { return a->in[11]; }
    __device__ __forceinline__ const float* pool_scale() const { return a->in[12]; }
    __device__ __forceinline__ const float* w_out() const { return a->in[13]; }
    __device__ __forceinline__ const float* ln1_g() const { return a->in[14]; }
    __device__ __forceinline__ const float* ln1_b() const { return a->in[15]; }
    __device__ __forceinline__ const float* w_rg() const { return a->in[16]; }
    __device__ __forceinline__ const float* b_rg() const { return a->in[17]; }
    __device__ __forceinline__ const float* w_re() const { return a->in[18]; }
    __device__ __forceinline__ const float* b_re() const { return a->in[19]; }
    __device__ __forceinline__ const float* w_gate() const { return a->in[20]; }
    __device__ __forceinline__ const float* w_up() const { return a->in[21]; }
    __device__ __forceinline__ const float* w_down() const { return a->in[22]; }
    __device__ __forceinline__ const float* ln2_g() const { return a->in[23]; }
    __device__ __forceinline__ const float* ln2_b() const { return a->in[24]; }
    __device__ __forceinline__ float* out() const { return a->out; }
    __device__ __forceinline__ unsigned* ctl() const { return (unsigned*)(ws + WS_CTL); }
    __device__ __forceinline__ bf16* WIN() const { return (bf16*)(ws + WS_WIN); }
    __device__ __forceinline__ bf16* WOUT() const { return (bf16*)(ws + WS_WOUT); }
    __device__ __forceinline__ bf16* WPOOL() const { return (bf16*)(ws + WS_WPOOL); }
    __device__ __forceinline__ bf16* WGU() const { return (bf16*)(ws + WS_WGU); }
    __device__ __forceinline__ bf16* WD() const { return (bf16*)(ws + WS_WD); }
    __device__ __forceinline__ bf16* XN() const { return (bf16*)(ws + WS_XN); }
    __device__ __forceinline__ bf16* PROJ() const { return (bf16*)(ws + WS_PROJ); }
    __device__ __forceinline__ bf16* YMIX() const { return (bf16*)(ws + WS_YMIX); }
    __device__ __forceinline__ bf16* PREV() const { return (bf16*)(ws + WS_PREV); }
    __device__ __forceinline__ bf16* XBCC() const { return (bf16*)(ws + WS_XBCC); }
    __device__ __forceinline__ bf16* R1() const { return (bf16*)(ws + WS_R1); }
    __device__ __forceinline__ bf16* H1() const { return (bf16*)(ws + WS_H1); }
    __device__ __forceinline__ bf16* HB() const { return (bf16*)(ws + WS_HB); }
    __device__ __forceinline__ bf16* R2() const { return (bf16*)(ws + WS_R2); }
    __device__ __forceinline__ bf16* PWIN() const { return (bf16*)(ws + WS_PWIN); }
    __device__ __forceinline__ float* DTRAW() const { return (float*)(ws + WS_DTRAW); }
    __device__ __forceinline__ float* DTV() const { return (float*)(ws + WS_DTV); }
    __device__ __forceinline__ float* ACL() const { return (float*)(ws + WS_ACL); }
    __device__ __forceinline__ float* CHD() const { return (float*)(ws + WS_CHD); }
    __device__ __forceinline__ float* STATES() const { return (float*)(ws + WS_STATES); }
    __device__ __forceinline__ float* LW() const { return (float*)(ws + WS_LW); }
    __device__ __forceinline__ float* YG() const { return (float*)(ws + WS_YG); }
    __device__ __forceinline__ int* LIST() const { return (int*)(ws + WS_LIST); }
};

__device__ __forceinline__ void transpose_item(const float* src, int ld_src, bf16* dst, int ld_dst, LAS float* scr, int lane) {
#pragma unroll 8
    for (int i = 0; i < 32; ++i) { const int kk = 2 * i + (lane >> 5); scr[kk * 33 + (lane & 31)] = src[(size_t)kk * ld_src + (lane & 31)]; }
    asm volatile("s_waitcnt lgkmcnt(0)" ::: "memory");
    const int c = lane & 7;
#pragma unroll
    for (int j = 0; j < 4; ++j) { const int n = (lane >> 3) + 8 * j; const LAS float* s = scr + (8 * c) * 33 + n;
        u32x4 o; o.x = pk2(s[0 * 33], s[1 * 33]); o.y = pk2(s[2 * 33], s[3 * 33]); o.z = pk2(s[4 * 33], s[5 * 33]); o.w = pk2(s[6 * 33], s[7 * 33]);
        *(u32x4*)(dst + (size_t)n * ld_dst + 8 * c) = o; }
    asm volatile("s_waitcnt lgkmcnt(0)" ::: "memory");
}

__device__ __forceinline__ void phase_prep(const Ctx& C) {
    LAS float* scr = (LAS float*)(C.lds + C.wave * 8704);
    LAS float* wdt = (LAS float*)(C.lds + 8 * 8704);
    const int gw = C.bid * NWAVES + C.wave, NGW = C.G * NWAVES;
    for (int i = C.tid; i < 8 * 1024; i += NTHREADS) { const int k = i >> 3, n = i & 7; wdt[n * 1024 + k] = C.w_in()[(size_t)k * DINP + 1536 + n]; }
    constexpr int I_WIN = 16 * 64, I_WOUT = 16 * 32, I_WPOOL = 4 * 2 * 4, I_WGU = 16 * 16 * 32, I_WD = 16 * 8 * 32;
    constexpr int NITEMS = I_WIN + I_WOUT + I_WPOOL + I_WGU + I_WD;
    for (int it = gw; it < NITEMS; it += NGW) {
        int r = it;
        if (r < I_WIN) { const int kb = r / 64, nb = r % 64, n0 = nb * 32, n0s = n0 + (n0 >= 1536 ? 8 : 0);
            transpose_item(C.w_in() + (size_t)(kb * 64) * DINP + n0s, DINP, C.WIN() + (size_t)n0 * 1024 + kb * 64, 1024, scr, C.lane); continue; }
        r -= I_WIN;
        if (r < I_WOUT) { const int kb = r / 32, nb = r % 32;
            transpose_item(C.w_out() + (size_t)(kb * 64) * 1024 + nb * 32, 1024, C.WOUT() + (size_t)(nb * 32) * 1024 + kb * 64, 1024, scr, C.lane); continue; }
        r -= I_WOUT;
        if (r < I_WPOOL) { const int g = r / 8, kb = (r % 8) / 4, nb = r % 4;
            transpose_item(C.w_pool() + (size_t)g * 16384 + (size_t)(kb * 64) * 128 + nb * 32, 128, C.WPOOL() + (size_t)g * 16384 + (size_t)(nb * 32) * 128 + kb * 64, 128, scr, C.lane); continue; }
        r -= I_WPOOL;
        if (r < I_WGU) { const int e = r / 512, q = r % 512, kb = q / 32, nb = q % 32;
            const int row0 = nb * 32, t = row0 >> 8, half = (row0 >> 7) & 1, i0 = row0 & 127;
            const float* src = (half ? C.w_up() : C.w_gate()) + (size_t)e * 1024 * 512 + (size_t)(kb * 64) * 512 + 128 * t + i0;
            transpose_item(src, 512, C.WGU() + (size_t)e * 1048576 + (size_t)row0 * 1024 + kb * 64, 1024, scr, C.lane); continue; }
        r -= I_WGU;
        { const int e = r / 256, q = r % 256, kb = q / 32, nb = q % 32;
            transpose_item(C.w_down() + (size_t)e * 524288 + (size_t)(kb * 64) * 1024 + nb * 32, 1024, C.WD() + (size_t)e * 524288 + (size_t)(nb * 32) * 512 + kb * 64, 512, scr, C.lane); }
    }
    __syncthreads();
    f32x4 gg[4], bb[4];
#pragma unroll
    for (int j = 0; j < 4; ++j) { gg[j] = *(const f32x4*)(C.ln0_g() + 4 * C.lane + 256 * j); bb[j] = *(const f32x4*)(C.ln0_b() + 4 * C.lane + 256 * j); }
    for (int m = gw; m < NTOK; m += NGW) {
        const f32x4* xr = (const f32x4*)(C.x() + (size_t)m * DM) + C.lane;
        f32x4 v[4]; float s = 0.f;
#pragma unroll
        for (int j = 0; j < 4; ++j) { v[j] = xr[64 * j]; s += (v[j].x + v[j].y) + (v[j].z + v[j].w); }
        const float mean = wave_sum(s) * (1.f / DM); float s2 = 0.f;
#pragma unroll
        for (int j = 0; j < 4; ++j) { v[j] = v[j] - mean; s2 += (v[j].x * v[j].x + v[j].y * v[j].y) + (v[j].z * v[j].z + v[j].w * v[j].w); }
        const float rstd = 1.f / sqrtf(wave_sum(s2) * (1.f / DM) + LN_EPS);
        unsigned long long* o8 = (unsigned long long*)(C.XN() + (size_t)m * DM) + C.lane;
#pragma unroll
        for (int j = 0; j < 4; ++j) { v[j] = v[j] * rstd * gg[j] + bb[j];
            o8[64 * j] = (unsigned long long)pk2(v[j].x, v[j].y) | ((unsigned long long)pk2(v[j].z, v[j].w) << 32); }
        float d[8];
#pragma unroll
        for (int n = 0; n < 8; ++n) { float a = 0.f;
#pragma unroll
            for (int j = 0; j < 4; ++j) { const f32x4 w = *(const LAS f32x4*)(wdt + n * 1024 + 4 * C.lane + 256 * j); a += (v[j].x * w.x + v[j].y * w.y) + (v[j].z * w.z + v[j].w * w.w); }
            d[n] = wave_sum(a); }
        if (C.lane == 0) { *(f32x4*)(C.DTRAW() + (size_t)m * 8) = (f32x4){d[0], d[1], d[2], d[3]}; *(f32x4*)(C.DTRAW() + (size_t)m * 8 + 4) = (f32x4){d[4], d[5], d[6], d[7]}; }
    }
}

struct MoeTab { int ntiles; int cnt[NCLS]; int cls[MAXT256]; int row0[MAXT256]; };
constexpr int MOETAB_OFF = 140 * 1024;
__device__ __forceinline__ void class_experts(int c, int& elo, int& ehi) {
    const int g = c / 6, q = c % 6; const int il = q < 3 ? 0 : (q < 5 ? 1 : 2); const int ih = q < 3 ? q + 1 : (q < 5 ? q - 1 : 3);
    elo = g * 4 + il; ehi = g * 4 + ih;
}
__device__ __forceinline__ void build_moetab(const Ctx& C) {
    LAS MoeTab* tb = (LAS MoeTab*)(C.lds + MOETAB_OFF);
    if (C.tid == 0) {
        int nt = 0;
        for (int c = 0; c < NCLS; ++c) { int n = (int)__hip_atomic_load(C.ctl() + CW_CNT + c, __ATOMIC_RELAXED, __HIP_MEMORY_SCOPE_AGENT); if (n > LISTCAP) n = LISTCAP; tb->cnt[c] = n;
            for (int r = 0; r < n; r += 256) { if (nt < MAXT256) { tb->cls[nt] = c; tb->row0[nt] = r; ++nt; } } }
        tb->ntiles = nt;
    }
    __syncthreads();
}

template <int NBOP, class Spec> __device__ __forceinline__ void simple_gemm(const Ctx& C, const Spec& sp) {
    LAS float* As = (LAS float*)C.lds;
    LAS float* Bs = As + 16 * 132;
    const int tid = C.tid, ty = tid >> 4, tx = tid & 15;
    const int nmt = sp.n_mtiles(), nnt = sp.n_ntiles(), K = sp.K();
    for (int tile = C.bid; tile < nmt * nnt; tile += C.G) {
        const int mt = tile / nnt, nt = tile % nnt;
        float acc[NBOP][4][4];
#pragma unroll
        for (int o = 0; o < NBOP; ++o)
#pragma unroll
            for (int i = 0; i < 4; ++i)
#pragma unroll
                for (int j = 0; j < 4; ++j) acc[o][i][j] = 0.f;
        const bf16* ap = nullptr; const bf16* bp = nullptr; int bop = 0, bc = 0, bhf = 0;
        if (tid < 256) ap = sp.a_row(mt, nt, tid >> 1);
        else { const int idx = tid - 256; bop = idx >> 7; bc = (idx & 127) >> 1; bhf = idx & 1; }
        for (int k0 = 0; k0 < K; k0 += 16) {
            if (tid < 256) { const int r = tid >> 1, hf = tid & 1; float f[8];
                if (ap) { unpack8(*(const u32x4*)(ap + k0 + hf * 8), f); } else {
#pragma unroll
                    for (int i = 0; i < 8; ++i) f[i] = 0.f; }
#pragma unroll
                for (int i = 0; i < 8; ++i) As[(hf * 8 + i) * 132 + r] = f[i];
            } else if (bop < NBOP) { float f[8]; bp = sp.b_row(mt, nt, bop, bc, k0); unpack8(*(const u32x4*)(bp + bhf * 8), f);
#pragma unroll
                for (int i = 0; i < 8; ++i) Bs[(bop * 16 + bhf * 8 + i) * 68 + bc] = f[i];
            }
            __syncthreads();
#pragma unroll
            for (int k = 0; k < 16; ++k) { const f32x4 a = *(const LAS f32x4*)(As + k * 132 + ty * 4);
#pragma unroll
                for (int o = 0; o < NBOP; ++o) { const f32x4 b = *(const LAS f32x4*)(Bs + (o * 16 + k) * 68 + tx * 4);
                    acc[o][0][0] += a.x * b.x; acc[o][0][1] += a.x * b.y; acc[o][0][2] += a.x * b.z; acc[o][0][3] += a.x * b.w;
                    acc[o][1][0] += a.y * b.x; acc[o][1][1] += a.y * b.y; acc[o][1][2] += a.y * b.z; acc[o][1][3] += a.y * b.w;
                    acc[o][2][0] += a.z * b.x; acc[o][2][1] += a.z * b.y; acc[o][2][2] += a.z * b.z; acc[o][2][3] += a.z * b.w;
                    acc[o][3][0] += a.w * b.x; acc[o][3][1] += a.w * b.y; acc[o][3][2] += a.w * b.z; acc[o][3][3] += a.w * b.w; } }
            __syncthreads();
        }
        sp.epilogue(mt, nt, ty * 4, tx * 4, acc);
    }
}

struct SpecInProj {
    const bf16* XN; const bf16* W; bf16* O;
    __device__ int n_mtiles() const { return NTOK / 128; } __device__ int n_ntiles() const { return NPROJ / 64; } __device__ int K() const { return DM; }
    __device__ const bf16* a_row(int mt, int, int r) const { return XN + (size_t)(mt * 128 + r) * DM; }
    __device__ const bf16* b_row(int, int nt, int, int c, int k0) const { return W + (size_t)(nt * 64 + c) * DM + k0; }
    __device__ void epilogue(int mt, int nt, int r0, int c0, const float (&acc)[1][4][4]) const {
#pragma unroll
        for (int i = 0; i < 4; ++i) { u32x2 w; w.x = pk2(acc[0][i][0], acc[0][i][1]); w.y = pk2(acc[0][i][2], acc[0][i][3]);
            *(u32x2*)(O + (size_t)(mt * 128 + r0 + i) * NPROJ + nt * 64 + c0) = w; }
    }
};
struct SpecPool {
    const bf16* P; const bf16* W; bf16* O; const float* bias; const float* scale;
    __device__ int n_mtiles() const { return NTOK / 128; } __device__ int n_ntiles() const { return 8; } __device__ int K() const { return 128; }
    __device__ const bf16* a_row(int mt, int nt, int r) const { return P + (size_t)(mt * 128 + r) * 512 + (nt >> 1) * 128; }
    __device__ const bf16* b_row(int, int nt, int, int c, int k0) const { return W + (size_t)(nt >> 1) * 16384 + (size_t)((nt & 1) * 64 + c) * 128 + k0; }
    __device__ void epilogue(int mt, int nt, int r0, int c0, const float (&acc)[1][4][4]) const {
        const int col = nt * 64 + c0; const f32x4 b = *(const f32x4*)(bias + col), s = *(const f32x4*)(scale + col);
#pragma unroll
        for (int i = 0; i < 4; ++i) { u32x2 w; w.x = pk2((acc[0][i][0] + b.x) * s.x, (acc[0][i][1] + b.y) * s.y); w.y = pk2((acc[0][i][2] + b.z) * s.z, (acc[0][i][3] + b.w) * s.w);
            *(u32x2*)(O + (size_t)(mt * 128 + r0 + i) * DM + 512 + col) = w; }
    }
};
struct SpecOutProj {
    const bf16* Y; const bf16* W; const bf16* XN; bf16* O;
    __device__ int n_mtiles() const { return NTOK / 128; } __device__ int n_ntiles() const { return DM / 64; } __device__ int K() const { return DM; }
    __device__ const bf16* a_row(int mt, int, int r) const { return Y + (size_t)(mt * 128 + r) * DM; }
    __device__ const bf16* b_row(int, int nt, int, int c, int k0) const { return W + (size_t)(nt * 64 + c) * DM + k0; }
    __device__ void epilogue(int mt, int nt, int r0, int c0, const float (&acc)[1][4][4]) const {
#pragma unroll
        for (int i = 0; i < 4; ++i) { const size_t off = (size_t)(mt * 128 + r0 + i) * DM + nt * 64 + c0; const u32x2 xv = *(const u32x2*)(XN + off);
            u32x2 w; w.x = pk2(ALPHA * bflo(xv.x) + acc[0][i][0], ALPHA * bfhi(xv.x) + acc[0][i][1]); w.y = pk2(ALPHA * bflo(xv.y) + acc[0][i][2], ALPHA * bfhi(xv.y) + acc[0][i][3]);
            *(u32x2*)(O + off) = w; }
    }
};
struct SpecMoe1 {
    const bf16* H1; const bf16* WGU; bf16* HB; const int* LIST; const float* LW; const LAS MoeTab* tb;
    __device__ int n_mtiles() const { return tb->ntiles * 2; } __device__ int n_ntiles() const { return 16; } __device__ int K() const { return DM; }
    __device__ const bf16* a_row(int mt, int, int r) const { const int t = mt >> 1, c = tb->cls[t], rr = tb->row0[t] + (mt & 1) * 128 + r;
        if (rr >= tb->cnt[c]) return nullptr; return H1 + (size_t)LIST[c * LISTCAP + rr] * DM; }
    __device__ const bf16* b_row(int mt, int nt, int op, int c, int k0) const { const int cl = tb->cls[mt >> 1]; int elo, ehi; class_experts(cl, elo, ehi);
        const int hc = nt * 64 + c, slot = hc >> 9, hh = hc & 511, e = slot ? ehi : elo; return WGU + (size_t)e * 1048576 + (size_t)((hh >> 7) * 256 + op * 128 + (hh & 127)) * DM + k0; }
    __device__ void epilogue(int mt, int nt, int r0, int c0, const float (&acc)[2][4][4]) const {
        const int t = mt >> 1, c = tb->cls[t]; const int slot = (nt * 64) >> 9;
#pragma unroll
        for (int i = 0; i < 4; ++i) { const int rr = tb->row0[t] + (mt & 1) * 128 + r0 + i; const float w = rr < tb->cnt[c] ? LW[((size_t)c * LISTCAP + rr) * 2 + slot] : 0.f;
            float h[4];
#pragma unroll
            for (int j = 0; j < 4; ++j) h[j] = w * silu_f(acc[0][i][j]) * acc[1][i][j];
            u32x2 o; o.x = pk2(h[0], h[1]); o.y = pk2(h[2], h[3]);
            *(u32x2*)(HB + (size_t)(mt * 128 + r0 + i) * DM + nt * 64 + c0) = o; }
    }
};
struct SpecMoe2 {
    const bf16* H1; const bf16* WD; const bf16* HB; bf16* R2; const int* LIST; const LAS MoeTab* tb;
    __device__ int n_mtiles() const { return tb->ntiles * 2; } __device__ int n_ntiles() const { return 16; } __device__ int K() const { return DM; }
    __device__ const bf16* a_row(int mt, int, int r) const { return HB + (size_t)(mt * 128 + r) * DM; }
    __device__ const bf16* b_row(int mt, int nt, int, int c, int k0) const { const int cl = tb->cls[mt >> 1]; int elo, ehi; class_experts(cl, elo, ehi);
        const int e = k0 < 512 ? elo : ehi; return WD + (size_t)e * 524288 + (size_t)(nt * 64 + c) * 512 + (k0 & 511); }
    __device__ void epilogue(int mt, int nt, int r0, int c0, const float (&acc)[1][4][4]) const {
        const int t = mt >> 1, c = tb->cls[t];
#pragma unroll
        for (int i = 0; i < 4; ++i) { const int rr = tb->row0[t] + (mt & 1) * 128 + r0 + i; if (rr >= tb->cnt[c]) continue;
            const size_t off = (size_t)LIST[c * LISTCAP + rr] * DM + nt * 64 + c0; const u32x2 xv = *(const u32x2*)(H1 + off);
            u32x2 w; w.x = pk2(ALPHA * bflo(xv.x) + acc[0][i][0], ALPHA * bfhi(xv.x) + acc[0][i][1]); w.y = pk2(ALPHA * bflo(xv.y) + acc[0][i][2], ALPHA * bfhi(xv.y) + acc[0][i][3]);
            *(u32x2*)(R2 + off) = w; }
    }
};

namespace pg8 {
typedef short bf16x8 __attribute__((ext_vector_type(8)));
constexpr int BM = 256, BK = 64, HALF = 128, HTB = HALF * BK * 2, STAGE_BYTES = 8 * HTB, NXCD = 8, WGM = 8;
__host__ __device__ __forceinline__ int lds_byte(int r, int c) { const int st = (r >> 4) * 2 + (c >> 5), rr = r & 15, cc = c & 31, ob = rr * 64 + cc * 2; return st * 1024 + (ob ^ (((ob >> 9) & 1) << 5)); }
__host__ __device__ __forceinline__ void stage_rc(int b, int& R, int& C) { const int st = b / 1024, sb = b % 1024, swz = sb ^ (((sb >> 9) & 1) << 5); R = (st >> 1) * 16 + swz / 64; C = (st & 1) * 32 + (swz % 64) / 2; }
__host__ __device__ __forceinline__ int perm32(int rho) { const int n = rho >> 4, i = rho & 15; return 8 * (i >> 2) + 4 * n + (i & 3); }
struct Unit { int pm, pn, xa, xb; };
__device__ __forceinline__ bool order_next(int i, int G, int c, int nM, int nN, Unit& u) {
    const int nwg = nM * nN; const long L = (long)i * G + c; if (L >= nwg) return false;
    int wgid = (int)L; { const int q = nwg / NXCD, r = nwg % NXCD, xcd = wgid % NXCD, off = wgid / NXCD; wgid = (xcd < r ? xcd * (q + 1) : r * (q + 1) + (xcd - r) * q) + off; }
    const int nig = WGM * nN, gid = wgid / nig, fm = gid * WGM, gsz = (nM - fm) < WGM ? (nM - fm) : WGM;
    u.pm = fm + ((wgid % nig) % gsz); u.pn = (wgid % nig) / gsz; return true;
}
__device__ __forceinline__ unsigned cvt_pk_bf16(float lo, float hi) { unsigned r; asm volatile("v_cvt_pk_bf16_f32 %0, %1, %2" : "=v"(r) : "v"(lo), "v"(hi)); return r; }

template <class Prob, class Epi>
__device__ __forceinline__ void gemm_phase(LAS unsigned char* lds, const Prob& P, const Epi& E) {
    constexpr bool GA = Prob::GATHER;
    const int tid = threadIdx.x, wid = __builtin_amdgcn_readfirstlane(tid >> 6), lane = tid & 63, wr = wid >> 2, wc = wid & 3, fr = lane & 15, fq = lane >> 4;
    const int nt = P.ktiles();
    const unsigned ldb = P.ldb_bytes();
    unsigned voffB[2], voffA[2];
#pragma unroll
    for (int i = 0; i < 2; ++i) { int R, Cc; stage_rc(tid * 16 + i * 8192, R, Cc); const int Rb = (R & ~31) + perm32(R & 31); voffB[i] = (unsigned)Rb * ldb + (unsigned)Cc * 2u;
        voffA[i] = GA ? 0u : P.a_voff_dense(R, Cc); }
    const unsigned hstepB = 128u * ldb;
    const unsigned ldsw = (unsigned)wid * 1024u;
    const int aoff = lds_byte(wr * 64 + fr, fq * 8), boff = lds_byte(wc * 32 + fr, fq * 8);
#define PG8_SA(b, h) (((b) * 2 + (h)) * HTB)
#define PG8_SB(b, h) ((4 + (b) * 2 + (h)) * HTB)
#define PG8_STAGE(bufoff, gbase, voff) do { _Pragma("unroll") for (int _i = 0; _i < 2; ++_i) \
        __builtin_amdgcn_global_load_lds((const unsigned*)((const char*)(gbase) + (voff)[_i]), (LAS unsigned*)(lds + (bufoff) + ldsw + _i * 8192), 16, 0, 0); } while (0)
#define PG8_LDA(dst, b, h) do { _Pragma("unroll") for (int m = 0; m < 4; ++m) _Pragma("unroll") for (int k = 0; k < 2; ++k) dst[m][k] = *(const LAS bf16x8*)(lds + PG8_SA(b, h) + aoff + m * 2048 + k * 1024); } while (0)
#define PG8_LDB(dst, b, h) do { _Pragma("unroll") for (int n = 0; n < 2; ++n) _Pragma("unroll") for (int k = 0; k < 2; ++k) dst[n][k] = *(const LAS bf16x8*)(lds + PG8_SB(b, h) + boff + n * 2048 + k * 1024); } while (0)
#define PG8_MMA(ai, bj, At, Bt) do { __builtin_amdgcn_s_setprio(1); _Pragma("unroll") for (int m = 0; m < 4; ++m) _Pragma("unroll") for (int n = 0; n < 2; ++n) _Pragma("unroll") for (int k = 0; k < 2; ++k) \
        acc[ai][bj][m][n] = __builtin_amdgcn_mfma_f32_16x16x32_bf16(Bt[n][k], At[m][k], acc[ai][bj][m][n], 0, 0, 0); __builtin_amdgcn_s_setprio(0); } while (0)
#define PG8_WAIT_V(n) asm volatile("s_waitcnt vmcnt(" #n ")" ::: "memory")
#define PG8_WAIT_L(n) asm volatile("s_waitcnt lgkmcnt(" #n ")" ::: "memory")
#define PG8_BAR __builtin_amdgcn_s_barrier()
#define PG8_SCHED __builtin_amdgcn_sched_barrier(0)
    Unit cur, nxt; int ui = 0;
    if (!P.next(0, cur)) return;
    f32x4 acc[2][2][4][2];
#pragma unroll
    for (int a = 0; a < 2; ++a)
#pragma unroll
        for (int b = 0; b < 2; ++b)
#pragma unroll
            for (int m = 0; m < 4; ++m)
#pragma unroll
                for (int n = 0; n < 2; ++n) acc[a][b][m][n] = (f32x4){0.f, 0.f, 0.f, 0.f};
    bf16x8 At[4][2], B0[2][2], B1[2][2];
    unsigned vc0[2], vc1[2], vn0[2], vn1[2];
    const char* cA0; const char* cA1; const char* nA0; const char* nA1;
    if constexpr (GA) { cA0 = cA1 = nA0 = nA1 = P.a_base();
#pragma unroll
        for (int i = 0; i < 2; ++i) { int R, Cc; stage_rc(tid * 16 + i * 8192, R, Cc); vc0[i] = P.a_voff(cur, 0, R, Cc); vc1[i] = P.a_voff(cur, 1, R, Cc); vn0[i] = vc0[i]; vn1[i] = vc1[i]; }
    } else { cA0 = P.a_half(cur, 0); cA1 = P.a_half(cur, 1); nA0 = cA0; nA1 = cA1;
#pragma unroll
        for (int i = 0; i < 2; ++i) { vc0[i] = vc1[i] = vn0[i] = vn1[i] = voffA[i]; } }
    const size_t kstep = (size_t)(BK * 2);
    {
        const char* cB0 = P.b_tile(cur, 0); const char* cB1 = P.b_tile(cur, 1);
        PG8_STAGE(PG8_SB(0, 0), cB0, voffB); PG8_STAGE(PG8_SB(0, 1), cB0 + hstepB, voffB); PG8_STAGE(PG8_SA(0, 0), cA0, vc0); PG8_STAGE(PG8_SA(0, 1), cA1, vc1);
        if (wr == 1) PG8_BAR;
        PG8_WAIT_V(2); PG8_BAR;
        PG8_STAGE(PG8_SB(1, 0), cB1, voffB); PG8_STAGE(PG8_SA(1, 0), cA0 + kstep, vc0); PG8_STAGE(PG8_SB(1, 1), cB1 + hstepB, voffB);
        PG8_WAIT_V(6); PG8_BAR;
    }
    for (;;) {
        const bool has_next = P.next(ui + 1, nxt);
        if (!has_next) nxt = cur;
        if constexpr (!GA) { nA0 = P.a_half(nxt, 0); nA1 = P.a_half(nxt, 1); }
        for (int t = 0; t < nt; t += 2) {
            const bool last = (t == nt - 2);
            if constexpr (GA) { if (last) {
#pragma unroll
                for (int i = 0; i < 2; ++i) { int R, Cc; stage_rc(tid * 16 + i * 8192, R, Cc); vn0[i] = P.a_voff(nxt, 0, R, Cc); vn1[i] = P.a_voff(nxt, 1, R, Cc); } } }
            const char* a11 = cA1 + (size_t)(t + 1) * kstep;
            const char* a20 = last ? nA0 : cA0 + (size_t)(t + 2) * kstep; const char* a21 = last ? nA1 : cA1 + (size_t)(t + 2) * kstep;
            const char* a30 = a20 + kstep;
            const char* b2 = last ? P.b_tile(nxt, 0) : P.b_tile(cur, t + 2); const char* b3 = last ? P.b_tile(nxt, 1) : P.b_tile(cur, t + 3);
            PG8_LDB(B0, 0, 0); PG8_LDB(B1, 0, 1); PG8_SCHED; PG8_LDA(At, 0, 0); PG8_STAGE(PG8_SA(1, 1), a11, vc1);
            if constexpr (GA) { if (last) {
#pragma unroll
                for (int i = 0; i < 2; ++i) { vc0[i] = vn0[i]; vc1[i] = vn1[i]; } } }
            PG8_WAIT_V(8); PG8_WAIT_L(0); PG8_BAR; PG8_MMA(0, 0, At, B0); PG8_MMA(0, 1, At, B1); PG8_BAR; PG8_SCHED;
            PG8_LDA(At, 0, 1); PG8_STAGE(PG8_SB(0, 0), b2, voffB); PG8_STAGE(PG8_SB(0, 1), b2 + hstepB, voffB); PG8_STAGE(PG8_SA(0, 0), a20, vc0);
            PG8_WAIT_V(8); PG8_WAIT_L(0); PG8_BAR; PG8_MMA(1, 0, At, B0); PG8_MMA(1, 1, At, B1); PG8_BAR; PG8_SCHED;
            PG8_LDB(B0, 1, 0); PG8_LDB(B1, 1, 1); PG8_SCHED; PG8_LDA(At, 1, 0); PG8_STAGE(PG8_SA(0, 1), a21, vc1);
            PG8_WAIT_V(8); PG8_WAIT_L(0); PG8_BAR; PG8_MMA(0, 0, At, B0); PG8_MMA(0, 1, At, B1); PG8_BAR; PG8_SCHED;
            PG8_LDA(At, 1, 1); PG8_STAGE(PG8_SB(1, 0), b3, voffB); PG8_STAGE(PG8_SB(1, 1), b3 + hstepB, voffB); PG8_STAGE(PG8_SA(1, 0), a30, vc0);
            PG8_WAIT_V(8); PG8_WAIT_L(0); PG8_BAR; PG8_MMA(1, 0, At, B0); PG8_MMA(1, 1, At, B1); PG8_BAR; PG8_SCHED;
        }
        if (wr == 0) PG8_BAR;
        E(acc, cur, wr, wc, fr, fq);
        if (!has_next) break;
#pragma unroll
        for (int a = 0; a < 2; ++a)
#pragma unroll
            for (int b = 0; b < 2; ++b)
#pragma unroll
                for (int m = 0; m < 4; ++m)
#pragma unroll
                    for (int n = 0; n < 2; ++n) acc[a][b][m][n] = (f32x4){0.f, 0.f, 0.f, 0.f};
        cur = nxt; ++ui; cA0 = nA0; cA1 = nA1;
        if (wr == 1) PG8_BAR;
    }
    PG8_WAIT_V(0);
    PG8_BAR;
#undef PG8_SA
#undef PG8_SB
#undef PG8_STAGE
#undef PG8_LDA
#undef PG8_LDB
#undef PG8_MMA
#undef PG8_WAIT_V
#undef PG8_WAIT_L
#undef PG8_BAR
#undef PG8_SCHED
}
}

struct ProbDense {
    static constexpr bool GATHER = false;
    const bf16* A; const bf16* Bt; int nM, nN, K, G, c;
    __device__ __forceinline__ bool next(int i, pg8::Unit& u) const { return pg8::order_next(i, G, c, nM, nN, u); }
    __device__ __forceinline__ int ktiles() const { return K / 64; }
    __device__ __forceinline__ unsigned ldb_bytes() const { return (unsigned)K * 2u; }
    __device__ __forceinline__ unsigned a_voff_dense(int R, int Cc) const { return ((unsigned)R * (unsigned)K + (unsigned)Cc) * 2u; }
    __device__ __forceinline__ const char* a_half(const pg8::Unit& u, int h) const { return (const char*)A + (size_t)(u.pm * 256 + h * 128) * K * 2; }
    __device__ __forceinline__ const char* a_base() const { return (const char*)A; }
    __device__ __forceinline__ unsigned a_voff(const pg8::Unit&, int, int, int) const { return 0u; }
    __device__ __forceinline__ const char* b_tile(const pg8::Unit& u, int kt) const { return (const char*)Bt + ((size_t)u.pn * 256 * K + (size_t)kt * 64) * 2; }
};
struct EpiStoreBf16 {
    bf16* O; int ldc;
    __device__ __forceinline__ void operator()(const f32x4 (&acc)[2][2][4][2], const pg8::Unit& u, int wr, int wc, int fr, int fq) const {
        const int row0 = u.pm * 256 + wr * 64 + fr, col0 = u.pn * 256 + wc * 32 + 8 * fq;
#pragma unroll
        for (int ai = 0; ai < 2; ++ai)
#pragma unroll
            for (int m = 0; m < 4; ++m) { bf16* rowp = O + (size_t)(row0 + ai * 128 + m * 16) * ldc + col0;
#pragma unroll
                for (int bj = 0; bj < 2; ++bj) { const f32x4 v0 = acc[ai][bj][m][0], v1 = acc[ai][bj][m][1];
                    u32x4 w; w.x = pg8::cvt_pk_bf16(v0[0], v0[1]); w.y = pg8::cvt_pk_bf16(v0[2], v0[3]); w.z = pg8::cvt_pk_bf16(v1[0], v1[1]); w.w = pg8::cvt_pk_bf16(v1[2], v1[3]);
                    *(u32x4*)(rowp + bj * 128) = w; } }
    }
};
struct EpiResBf16 {
    const bf16* X; bf16* O;
    __device__ __forceinline__ void operator()(const f32x4 (&acc)[2][2][4][2], const pg8::Unit& u, int wr, int wc, int fr, int fq) const {
        const int row0 = u.pm * 256 + wr * 64 + fr, col0 = u.pn * 256 + wc * 32 + 8 * fq;
#pragma unroll
        for (int ai = 0; ai < 2; ++ai)
#pragma unroll
            for (int m = 0; m < 4; ++m) { const size_t off = (size_t)(row0 + ai * 128 + m * 16) * DM + col0;
#pragma unroll
                for (int bj = 0; bj < 2; ++bj) { const f32x4 v0 = acc[ai][bj][m][0], v1 = acc[ai][bj][m][1]; const u32x4 xv = *(const u32x4*)(X + off + bj * 128);
                    u32x4 w; w.x = pg8::cvt_pk_bf16(ALPHA * bflo(xv.x) + v0[0], ALPHA * bfhi(xv.x) + v0[1]); w.y = pg8::cvt_pk_bf16(ALPHA * bflo(xv.y) + v0[2], ALPHA * bfhi(xv.y) + v0[3]);
                    w.z = pg8::cvt_pk_bf16(ALPHA * bflo(xv.z) + v1[0], ALPHA * bfhi(xv.z) + v1[1]); w.w = pg8::cvt_pk_bf16(ALPHA * bflo(xv.w) + v1[2], ALPHA * bfhi(xv.w) + v1[3]);
                    *(u32x4*)(O + off + bj * 128) = w; } }
    }
};

struct ProbMoe1 {
    static constexpr bool GATHER = true;
    const bf16* H1; const bf16* WGU; const int* LIST; const LAS MoeTab* tb; int G, c;
    __device__ __forceinline__ bool next(int i, pg8::Unit& u) const { if (!pg8::order_next(i, G, c, tb->ntiles, 8, u)) return false;
        const int cl = tb->cls[u.pm]; int elo, ehi; class_experts(cl, elo, ehi); u.xa = elo | (ehi << 8) | (cl << 16); u.xb = tb->row0[u.pm]; return true; }
    __device__ __forceinline__ int ktiles() const { return 16; }
    __device__ __forceinline__ unsigned ldb_bytes() const { return 2048u; }
    __device__ __forceinline__ unsigned a_voff_dense(int, int) const { return 0u; }
    __device__ __forceinline__ const char* a_half(const pg8::Unit&, int) const { return (const char*)H1; }
    __device__ __forceinline__ const char* a_base() const { return (const char*)H1; }
    __device__ __forceinline__ unsigned a_voff(const pg8::Unit& u, int h, int R, int Cc) const { const int cl = u.xa >> 16; int rr = u.xb + h * 128 + R; if (rr >= tb->cnt[cl]) rr = u.xb;
        const unsigned tok = (unsigned)LIST[cl * LISTCAP + rr]; return (tok * 1024u + (unsigned)Cc) * 2u; }
    __device__ __forceinline__ const char* b_tile(const pg8::Unit& u, int kt) const { const int e = (u.pn < 4) ? (u.xa & 255) : ((u.xa >> 8) & 255);
        return (const char*)WGU + ((size_t)e * 1048576 + (size_t)(u.pn & 3) * 262144 + (size_t)kt * 64) * 2; }
};
struct EpiMoe1 {
    bf16* HB; const float* LW; const LAS MoeTab* tb;
    __device__ __forceinline__ void operator()(const f32x4 (&acc)[2][2][4][2], const pg8::Unit& u, int wr, int wc, int fr, int fq) const {
        const int cl = u.xa >> 16, cnt = tb->cnt[cl], slot = u.pn >> 2; const int col0 = slot * 512 + (u.pn & 3) * 128 + wc * 32 + 8 * fq;
#pragma unroll
        for (int ai = 0; ai < 2; ++ai)
#pragma unroll
            for (int m = 0; m < 4; ++m) { const int r = ai * 128 + wr * 64 + m * 16 + fr, rr = u.xb + r; const float w = rr < cnt ? LW[((size_t)cl * LISTCAP + rr) * 2 + slot] : 0.f;
                const f32x4 g0 = acc[ai][0][m][0], g1 = acc[ai][0][m][1], u0 = acc[ai][1][m][0], u1 = acc[ai][1][m][1];
                u32x4 o; o.x = pg8::cvt_pk_bf16(w * silu_f(g0[0]) * u0[0], w * silu_f(g0[1]) * u0[1]); o.y = pg8::cvt_pk_bf16(w * silu_f(g0[2]) * u0[2], w * silu_f(g0[3]) * u0[3]);
                o.z = pg8::cvt_pk_bf16(w * silu_f(g1[0]) * u1[0], w * silu_f(g1[1]) * u1[1]); o.w = pg8::cvt_pk_bf16(w * silu_f(g1[2]) * u1[2], w * silu_f(g1[3]) * u1[3]);
                *(u32x4*)(HB + (size_t)(u.pm * 256 + r) * DM + col0) = o; }
    }
};
struct ProbMoe2 {
    static constexpr bool GATHER = false;
    const bf16* HB; const bf16* WD; const LAS MoeTab* tb; int G, c;
    __device__ __forceinline__ bool next(int i, pg8::Unit& u) const { if (!pg8::order_next(i, G, c, tb->ntiles, 4, u)) return false;
        const int cl = tb->cls[u.pm]; int elo, ehi; class_experts(cl, elo, ehi); u.xa = elo | (ehi << 8) | (cl << 16); u.xb = tb->row0[u.pm]; return true; }
    __device__ __forceinline__ int ktiles() const { return 16; }
    __device__ __forceinline__ unsigned ldb_bytes() const { return 1024u; }
    __device__ __forceinline__ unsigned a_voff_dense(int R, int Cc) const { return ((unsigned)R * 1024u + (unsigned)Cc) * 2u; }
    __device__ __forceinline__ const char* a_half(const pg8::Unit& u, int h) const { return (const char*)HB + (size_t)(u.pm * 256 + h * 128) * 2048; }
    __device__ __forceinline__ const char* a_base() const { return (const char*)HB; }
    __device__ __forceinline__ unsigned a_voff(const pg8::Unit&, int, int, int) const { return 0u; }
    __device__ __forceinline__ const char* b_tile(const pg8::Unit& u, int kt) const { const int e = (kt < 8) ? (u.xa & 255) : ((u.xa >> 8) & 255);
        return (const char*)WD + ((size_t)e * 524288 + (size_t)u.pn * 131072 + (size_t)(kt & 7) * 64) * 2; }
};
struct EpiMoe2 {
    const bf16* H1; bf16* R2; const int* LIST; const LAS MoeTab* tb;
    __device__ __forceinline__ void operator()(const f32x4 (&acc)[2][2][4][2], const pg8::Unit& u, int wr, int wc, int fr, int fq) const {
        const int cl = u.xa >> 16, cnt = tb->cnt[cl]; const int col0 = u.pn * 256 + wc * 32 + 8 * fq;
#pragma unroll
        for (int ai = 0; ai < 2; ++ai)
#pragma unroll
            for (int m = 0; m < 4; ++m) { const int r = ai * 128 + wr * 64 + m * 16 + fr, rr = u.xb + r; if (rr >= cnt) continue;
                const size_t off = (size_t)LIST[cl * LISTCAP + rr] * DM + col0;
#pragma unroll
                for (int bj = 0; bj < 2; ++bj) { const f32x4 v0 = acc[ai][bj][m][0], v1 = acc[ai][bj][m][1]; const u32x4 xv = *(const u32x4*)(H1 + off + bj * 128);
                    u32x4 w; w.x = pg8::cvt_pk_bf16(ALPHA * bflo(xv.x) + v0[0], ALPHA * bfhi(xv.x) + v0[1]); w.y = pg8::cvt_pk_bf16(ALPHA * bflo(xv.y) + v0[2], ALPHA * bfhi(xv.y) + v0[3]);
                    w.z = pg8::cvt_pk_bf16(ALPHA * bflo(xv.z) + v1[0], ALPHA * bfhi(xv.z) + v1[1]); w.w = pg8::cvt_pk_bf16(ALPHA * bflo(xv.w) + v1[2], ALPHA * bfhi(xv.w) + v1[3]);
                    *(u32x4*)(R2 + off + bj * 128) = w; } }
    }
};

__device__ __forceinline__ void phase_poolwin_simple(const Ctx& C) {
    const int gt = C.bid * NTHREADS + C.tid, NGT = C.G * NTHREADS;
    for (int task = gt; task < NTOK * 64; task += NGT) {
        const int tok = task >> 6, c8 = (task & 63) * 8, g = c8 >> 7, w = 2 << g, t = tok & (SEQ - 1);
        float s[8], u0[8];
#pragma unroll
        for (int i = 0; i < 8; ++i) s[i] = 0.f;
        for (int d = 0; d < w; ++d) { if (t - d < 0) break; float f[8]; unpack8(*(const u32x4*)(C.PROJ() + (size_t)(tok - d) * NPROJ + PC_U + c8), f);
#pragma unroll
            for (int i = 0; i < 8; ++i) { s[i] += f[i]; if (d == 0) u0[i] = f[i]; } }
        const float inv = 1.0f / (float)((t + 1) < w ? (t + 1) : w);
        u32x4 o; o.x = pk2(s[0] * inv - u0[0], s[1] * inv - u0[1]); o.y = pk2(s[2] * inv - u0[2], s[3] * inv - u0[3]); o.z = pk2(s[4] * inv - u0[4], s[5] * inv - u0[5]); o.w = pk2(s[6] * inv - u0[6], s[7] * inv - u0[7]);
        *(u32x4*)(C.PWIN() + (size_t)tok * 512 + c8) = o;
    }
}
__device__ __forceinline__ void phase_conv_simple(const Ctx& C) {
    const int gt = C.bid * NTHREADS + C.tid, NGT = C.G * NTHREADS;
    for (int task = gt; task < NTOK * 128; task += NGT) {
        const int tok = task >> 7, c8 = (task & 127) * 8, t = tok & (SEQ - 1);
        float a[8];
        { const f32x4 b0 = *(const f32x4*)(C.conv_b() + c8), b1 = *(const f32x4*)(C.conv_b() + c8 + 4); a[0] = b0.x; a[1] = b0.y; a[2] = b0.z; a[3] = b0.w; a[4] = b1.x; a[5] = b1.y; a[6] = b1.z; a[7] = b1.w; }
#pragma unroll
        for (int k = 0; k < 4; ++k) { const int d = 3 - k; if (t - d < 0) continue; float f[8]; unpack8(*(const u32x4*)(C.PROJ() + (size_t)(tok - d) * NPROJ + PC_X + c8), f);
            const f32x4 w0 = *(const f32x4*)(C.conv_w() + k * 1024 + c8), w1 = *(const f32x4*)(C.conv_w() + k * 1024 + c8 + 4);
            a[0] += w0.x * f[0]; a[1] += w0.y * f[1]; a[2] += w0.z * f[2]; a[3] += w0.w * f[3]; a[4] += w1.x * f[4]; a[5] += w1.y * f[5]; a[6] += w1.z * f[6]; a[7] += w1.w * f[7]; }
        u32x4 o; o.x = pk2(silu_f(a[0]), silu_f(a[1])); o.y = pk2(silu_f(a[2]), silu_f(a[3])); o.z = pk2(silu_f(a[4]), silu_f(a[5])); o.w = pk2(silu_f(a[6]), silu_f(a[7]));
        *(u32x4*)(C.XBCC() + (size_t)tok * 1024 + c8) = o;
    }
}
__device__ __forceinline__ void phase_dt_simple(const Ctx& C) {
    const int gt = C.bid * NTHREADS + C.tid;
    if (gt < NBATCH * NCHUNK * NHEAD) {
        const int h = gt & 7, bc = gt >> 3; const float bias = C.dt_bias()[h], A = -__expf(C.a_log()[h]); float acc = 0.f;
        for (int l = 0; l < CHUNK; ++l) { const size_t idx = (size_t)(bc * CHUNK + l) * 8 + h; const float v = C.DTRAW()[idx] + bias; const float dt = v > 20.f ? v : log1pf(__expf(v));
            acc += dt * A; C.DTV()[idx] = dt; C.ACL()[idx] = acc; }
        C.CHD()[gt] = __expf(acc);
    }
}
__device__ __forceinline__ void phase_states_simple(const Ctx& C) {
    LAS float* wl = (LAS float*)C.lds;
    for (int item = C.bid; item < NBATCH * NCHUNK * NHEAD; item += C.G) {
        const int h = item & 7, bc = item >> 3, g = h >> 2, tok0 = bc * CHUNK;
        __syncthreads();
        if (C.tid < CHUNK) { const float last = C.ACL()[(size_t)(tok0 + CHUNK - 1) * 8 + h]; const size_t idx = (size_t)(tok0 + C.tid) * 8 + h; wl[C.tid] = C.DTV()[idx] * __expf(last - C.ACL()[idx]); }
        __syncthreads();
        const int p = C.tid >> 3, n0 = (C.tid & 7) * 16;
        float acc[16];
#pragma unroll
        for (int i = 0; i < 16; ++i) acc[i] = 0.f;
        for (int l = 0; l < CHUNK; ++l) { const bf16* row = C.XBCC() + (size_t)(tok0 + l) * 1024; const float xv = bf2f(row[h * 64 + p]) * wl[l];
            float f[8]; unpack8(*(const u32x4*)(row + 512 + g * 128 + n0), f);
#pragma unroll
            for (int i = 0; i < 8; ++i) acc[i] += xv * f[i];
            unpack8(*(const u32x4*)(row + 512 + g * 128 + n0 + 8), f);
#pragma unroll
            for (int i = 0; i < 8; ++i) acc[8 + i] += xv * f[i]; }
        float* o = C.STATES() + (size_t)item * 8192 + p * 128 + n0;
#pragma unroll
        for (int i = 0; i < 4; ++i) *(f32x4*)(o + 4 * i) = (f32x4){acc[4 * i], acc[4 * i + 1], acc[4 * i + 2], acc[4 * i + 3]};
    }
}
__device__ __forceinline__ void phase_scan(const Ctx& C) {
    const int gt = C.bid * NTHREADS + C.tid, NGT = C.G * NTHREADS;
    for (int task = gt; task < NBATCH * NHEAD * 2048; task += NGT) {
        const int e4 = task & 2047, bh = task >> 11, b = bh >> 3, h = bh & 7;
        f32x4 run = (f32x4){0.f, 0.f, 0.f, 0.f};
        f32x4 st[NCHUNK]; float dec[NCHUNK];
#pragma unroll
        for (int c = 0; c < NCHUNK; ++c) { const size_t item = (size_t)((b * NCHUNK + c) * 8 + h); st[c] = *(const f32x4*)(C.STATES() + item * 8192 + e4 * 4); dec[c] = C.CHD()[item]; }
#pragma unroll
        for (int c = 0; c < NCHUNK; ++c) { const size_t item = (size_t)((b * NCHUNK + c) * 8 + h);
            u32x2 o; o.x = pk2(run.x, run.y); o.y = pk2(run.z, run.w); *(u32x2*)(C.PREV() + item * 8192 + e4 * 4) = o;
            run = run * dec[c] + st[c]; }
    }
}
__device__ __forceinline__ void phase_y_simple(const Ctx& C) {
    LAS float* S = (LAS float*)C.lds;
    LAS float* acl = S + 128 * 129;
    LAS float* dtl = acl + 512;
    for (int item = C.bid; item < NBATCH * NCHUNK * 2; item += C.G) {
        const int g = item & 1, bc = item >> 1, tok0 = bc * CHUNK;
        __syncthreads();
        { const int l = C.tid & 127, j = C.tid >> 7; const size_t idx = (size_t)(tok0 + l) * 8 + g * 4 + j; acl[j * 128 + l] = C.ACL()[idx]; dtl[j * 128 + l] = C.DTV()[idx]; }
        { const int l = C.tid >> 2, s0 = (C.tid & 3) * 32; const bf16* crow = C.XBCC() + (size_t)(tok0 + l) * 1024 + 768 + g * 128;
            for (int s = s0; s < s0 + 32; ++s) { float a = 0.f;
                if (s <= l) { const bf16* brow = C.XBCC() + (size_t)(tok0 + s) * 1024 + 512 + g * 128;
                    for (int n = 0; n < 128; n += 8) { float cf[8], bf[8]; unpack8(*(const u32x4*)(crow + n), cf); unpack8(*(const u32x4*)(brow + n), bf);
#pragma unroll
                        for (int i = 0; i < 8; ++i) a += cf[i] * bf[i]; } }
                S[l * 129 + s] = a; } }
        __syncthreads();
        for (int tk = C.tid; tk < 128 * 4 * 8; tk += NTHREADS) {
            const int pc = tk & 7, j = (tk >> 3) & 3, l = tk >> 5, h = g * 4 + j, ch = h * 64 + pc * 8;
            float y[8];
#pragma unroll
            for (int i = 0; i < 8; ++i) y[i] = 0.f;
            const float al = acl[j * 128 + l];
            for (int s = 0; s <= l; ++s) { const float gsc = S[l * 129 + s] * __expf(al - acl[j * 128 + s]) * dtl[j * 128 + s];
                float f[8]; unpack8(*(const u32x4*)(C.XBCC() + (size_t)(tok0 + s) * 1024 + ch), f);
#pragma unroll
                for (int i = 0; i < 8; ++i) y[i] += gsc * f[i]; }
            const float el = __expf(al); const bf16* crow = C.XBCC() + (size_t)(tok0 + l) * 1024 + 768 + g * 128;
            const bf16* pv = C.PREV() + (size_t)(bc * 8 + h) * 8192 + (size_t)(pc * 8) * 128;
            for (int n = 0; n < 128; n += 8) { float cf[8]; unpack8(*(const u32x4*)(crow + n), cf);
#pragma unroll
                for (int i = 0; i < 8; ++i) { float pf[8]; unpack8(*(const u32x4*)(pv + i * 128 + n), pf); float a = 0.f;
#pragma unroll
                    for (int q = 0; q < 8; ++q) a += cf[q] * pf[q];
                    y[i] += el * a; } }
            float xf[8], zf[8]; unpack8(*(const u32x4*)(C.XBCC() + (size_t)(tok0 + l) * 1024 + ch), xf); unpack8(*(const u32x4*)(C.PROJ() + (size_t)(tok0 + l) * NPROJ + PC_Z + ch), zf);
            const float dsk = C.d_skip()[h];
            float* o = C.YG() + (size_t)(tok0 + l) * 512 + ch;
            f32x4 o0, o1;
            o0.x = (y[0] + dsk * xf[0]) * silu_f(zf[0]); o0.y = (y[1] + dsk * xf[1]) * silu_f(zf[1]); o0.z = (y[2] + dsk * xf[2]) * silu_f(zf[2]); o0.w = (y[3] + dsk * xf[3]) * silu_f(zf[3]);
            o1.x = (y[4] + dsk * xf[4]) * silu_f(zf[4]); o1.y = (y[5] + dsk * xf[5]) * silu_f(zf[5]); o1.z = (y[6] + dsk * xf[6]) * silu_f(zf[6]); o1.w = (y[7] + dsk * xf[7]) * silu_f(zf[7]);
            *(f32x4*)o = o0; *(f32x4*)(o + 4) = o1;
        }
    }
}
__device__ __forceinline__ void phase_rms_simple(const Ctx& C) {
    const int gw = C.bid * NWAVES + C.wave, NGW = C.G * NWAVES;
    for (int task = gw; task < NTOK * 2; task += NGW) {
        const int tok = task >> 1, g = task & 1; const f32x4 v = *(const f32x4*)(C.YG() + (size_t)tok * 512 + g * 256 + 4 * C.lane);
        const float ss = wave_sum((v.x * v.x + v.y * v.y) + (v.z * v.z + v.w * v.w)); const float r = 1.0f / sqrtf(ss * (1.f / 256.f) + RMS_EPS);
        const f32x4 ng = *(const f32x4*)(C.ssm_norm_g() + g * 256 + 4 * C.lane);
        u32x2 o; o.x = pk2(v.x * r * ng.x, v.y * r * ng.y); o.y = pk2(v.z * r * ng.z, v.w * r * ng.w);
        *(u32x2*)(C.YMIX() + (size_t)tok * DM + g * 256 + 4 * C.lane) = o;
    }
}

__device__ __forceinline__ void phase_ln1_router(const Ctx& C) {
    LAS float* wr = (LAS float*)C.lds;
    LAS int* rcls = (LAS int*)(C.lds + 20 * 4096);
    LAS float* rw = (LAS float*)(C.lds + 20 * 4096 + 512);
    LAS int* rpos = (LAS int*)(C.lds + 20 * 4096 + 512 + 1024);
    LAS int* lcnt = (LAS int*)(C.lds + 20 * 4096 + 512 + 1024 + 512);
    LAS int* lbase = lcnt + 32;
    for (int i = C.tid; i < 1024 * 4; i += NTHREADS) { const int k = i >> 2, n = i & 3; wr[n * 1024 + k] = C.w_rg()[i]; }
    for (int i = C.tid; i < 1024 * 16; i += NTHREADS) { const int k = i >> 4, n = i & 15; wr[(4 + n) * 1024 + k] = C.w_re()[i]; }
    f32x4 gg[4], bb[4];
#pragma unroll
    for (int j = 0; j < 4; ++j) { gg[j] = *(const f32x4*)(C.ln1_g() + 4 * C.lane + 256 * j); bb[j] = *(const f32x4*)(C.ln1_b() + 4 * C.lane + 256 * j); }
    float brg[4], bre[16];
#pragma unroll
    for (int i = 0; i < 4; ++i) brg[i] = C.b_rg()[i];
#pragma unroll
    for (int i = 0; i < 16; ++i) bre[i] = C.b_re()[i];
    for (int rb = C.bid; rb < NTOK / 128; rb += C.G) {
        __syncthreads();
        if (C.tid < 32) lcnt[C.tid] = 0;
        for (int rr = 0; rr < 16; ++rr) {
            const int r = C.wave * 16 + rr, m = rb * 128 + r;
            const u32x2* xr = (const u32x2*)(C.R1() + (size_t)m * DM) + C.lane;
            f32x4 v[4]; float s = 0.f;
#pragma unroll
            for (int j = 0; j < 4; ++j) { const u32x2 w = xr[64 * j]; v[j] = (f32x4){bflo(w.x), bfhi(w.x), bflo(w.y), bfhi(w.y)}; s += (v[j].x + v[j].y) + (v[j].z + v[j].w); }
            const float mean = wave_sum(s) * (1.f / DM); float s2 = 0.f;
#pragma unroll
            for (int j = 0; j < 4; ++j) { v[j] = v[j] - mean; s2 += (v[j].x * v[j].x + v[j].y * v[j].y) + (v[j].z * v[j].z + v[j].w * v[j].w); }
            const float rstd = 1.f / sqrtf(wave_sum(s2) * (1.f / DM) + LN_EPS);
            u32x2* o8 = (u32x2*)(C.H1() + (size_t)m * DM) + C.lane;
#pragma unroll
            for (int j = 0; j < 4; ++j) { v[j] = v[j] * rstd * gg[j] + bb[j]; u32x2 o; o.x = pk2(v[j].x, v[j].y); o.y = pk2(v[j].z, v[j].w); o8[64 * j] = o; }
            float lg[20];
#pragma unroll
            for (int n = 0; n < 20; ++n) { float a = 0.f;
#pragma unroll
                for (int j = 0; j < 4; ++j) { const f32x4 w = *(const LAS f32x4*)(wr + n * 1024 + 4 * C.lane + 256 * j); a += (v[j].x * w.x + v[j].y * w.y) + (v[j].z * w.z + v[j].w * w.w); }
                lg[n] = wave_sum(a); }
            float g0 = lg[0] + brg[0], g1 = lg[1] + brg[1], g2 = lg[2] + brg[2], g3 = lg[3] + brg[3];
            int gi = 0; float gm = g0; if (g1 > gm) { gm = g1; gi = 1; } if (g2 > gm) { gm = g2; gi = 2; } if (g3 > gm) { gm = g3; gi = 3; }
            const float gwt = 1.0f / (__expf(g0 - gm) + __expf(g1 - gm) + __expf(g2 - gm) + __expf(g3 - gm));
            float e[4];
#pragma unroll
            for (int i = 0; i < 4; ++i) { const float a0 = lg[4 + i] + bre[i], a1 = lg[8 + i] + bre[4 + i], a2 = lg[12 + i] + bre[8 + i], a3 = lg[16 + i] + bre[12 + i]; e[i] = gi == 0 ? a0 : (gi == 1 ? a1 : (gi == 2 ? a2 : a3)); }
            int i1 = 0; float v1 = e[0]; if (e[1] > v1) { v1 = e[1]; i1 = 1; } if (e[2] > v1) { v1 = e[2]; i1 = 2; } if (e[3] > v1) { v1 = e[3]; i1 = 3; }
            int i2 = -1; float v2 = -3.0e38f;
#pragma unroll
            for (int i = 0; i < 4; ++i) if (i != i1 && e[i] > v2) { v2 = e[i]; i2 = i; }
            const float ex = __expf(v2 - v1), p1 = 1.0f / (1.0f + ex), p2 = ex * p1;
            const int il = i1 < i2 ? i1 : i2, ih = i1 < i2 ? i2 : i1; const float wl = (i1 < i2 ? p1 : p2) * gwt, wh = (i1 < i2 ? p2 : p1) * gwt;
            const int q = il == 0 ? ih - 1 : (il == 1 ? ih + 1 : 5);
            if (C.lane == 0) { rcls[r] = gi * 6 + q; rw[r * 2] = wl; rw[r * 2 + 1] = wh; }
        }
        __syncthreads();
        if (C.tid < 128) rpos[C.tid] = atomicAdd((int*)&lcnt[rcls[C.tid]], 1);
        __syncthreads();
        if (C.tid < NCLS) lbase[C.tid] = lcnt[C.tid] > 0 ? (int)__hip_atomic_fetch_add(C.ctl() + CW_CNT + C.tid, (unsigned)lcnt[C.tid], __ATOMIC_RELAXED, __HIP_MEMORY_SCOPE_AGENT) : 0;
        __syncthreads();
        if (C.tid < 128) { const int c = rcls[C.tid], pos = lbase[c] + rpos[C.tid];
            if (pos < LISTCAP) { C.LIST()[c * LISTCAP + pos] = rb * 128 + C.tid; C.LW()[((size_t)c * LISTCAP + pos) * 2] = rw[C.tid * 2]; C.LW()[((size_t)c * LISTCAP + pos) * 2 + 1] = rw[C.tid * 2 + 1]; } }
    }
}

__device__ __forceinline__ void phase_ln2(const Ctx& C) {
    const int gw = C.bid * NWAVES + C.wave, NGW = C.G * NWAVES;
    f32x4 gg[4], bb[4];
#pragma unroll
    for (int j = 0; j < 4; ++j) { gg[j] = *(const f32x4*)(C.ln2_g() + 4 * C.lane + 256 * j); bb[j] = *(const f32x4*)(C.ln2_b() + 4 * C.lane + 256 * j); }
    for (int m = gw; m < NTOK; m += NGW) {
        const u32x2* xr = (const u32x2*)(C.R2() + (size_t)m * DM) + C.lane;
        f32x4 v[4]; float s = 0.f;
#pragma unroll
        for (int j = 0; j < 4; ++j) { const u32x2 w = xr[64 * j]; v[j] = (f32x4){bflo(w.x), bfhi(w.x), bflo(w.y), bfhi(w.y)}; s += (v[j].x + v[j].y) + (v[j].z + v[j].w); }
        const float mean = wave_sum(s) * (1.f / DM); float s2 = 0.f;
#pragma unroll
        for (int j = 0; j < 4; ++j) { v[j] = v[j] - mean; s2 += (v[j].x * v[j].x + v[j].y * v[j].y) + (v[j].z * v[j].z + v[j].w * v[j].w); }
        const float rstd = 1.f / sqrtf(wave_sum(s2) * (1.f / DM) + LN_EPS);
        f32x4* o = (f32x4*)(C.out() + (size_t)m * DM) + C.lane;
#pragma unroll
        for (int j = 0; j < 4; ++j) o[64 * j] = v[j] * rstd * gg[j] + bb[j];
    }
}

#define XB_TMO      128
#define XB_XCNT(j)  (256  + 64 * (j))
#define XB_XSUB(j)  (1280 + 64 * (j))
#define XB_XGEN(j)  (2304 + 64 * (j))
#define XB_TOP      3328
#define XB_TOPGEN   3392
#define XCD_BAR_WORDS 3456
#define XB_SPIN_CAP (1u << 18)
constexpr int CW_BAR = 4096;
constexpr int MISC_OFF = LDS_BYTES - 256;
__device__ __forceinline__ unsigned xb_ld(unsigned* p)              { return __hip_atomic_load(p, __ATOMIC_RELAXED, __HIP_MEMORY_SCOPE_AGENT); }
__device__ __forceinline__ unsigned xb_add(unsigned* p, unsigned v) { return __hip_atomic_fetch_add(p, v, __ATOMIC_RELAXED, __HIP_MEMORY_SCOPE_AGENT); }
__device__ __forceinline__ unsigned xb_xcc_id() { return (unsigned)__builtin_amdgcn_s_getreg((3 << 11) | 20) & 0xFu; }
#define XB_SPIN(cond, bar) do { unsigned _sp = 0; while (cond) { __builtin_amdgcn_s_sleep(1); \
    if ((++_sp & 255u) == 0u) { if (xb_ld(&(bar)[XB_TMO])) break; if (_sp > XB_SPIN_CAP) { atomicAdd(&(bar)[XB_TMO], 1u); break; } } } } while (0)
struct XcdBarrier { unsigned* bar; unsigned x; volatile LAS unsigned* st; };
__device__ __forceinline__ XcdBarrier xcd_barrier_post(unsigned* bar, volatile LAS unsigned* st) {
    XcdBarrier b; b.bar = bar; b.x = xb_xcc_id(); b.st = st;
    if (threadIdx.x == 0) (void)xb_add(&bar[XB_XCNT(b.x)], 1u);
    return b;
}
__device__ __forceinline__ void xcd_barrier_complete(unsigned* bar, unsigned x, unsigned& nloc, unsigned& nx) {
    const unsigned G = gridDim.x * gridDim.y * gridDim.z;
    unsigned sum, cnt, mine, sp = 0u;
    for (;;) {
        sum = 0u; cnt = 0u; mine = 0u;
#pragma unroll
        for (unsigned j = 0; j < 16; ++j) { const unsigned c = xb_ld(&bar[XB_XCNT(j)]); sum += c; cnt += (c > 0u) ? 1u : 0u; mine = (j == x) ? c : mine; }
        if (sum == G) break;
        __builtin_amdgcn_s_sleep(1);
        if ((++sp & 255u) == 0u) { if (xb_ld(&bar[XB_TMO])) break; if (sp > XB_SPIN_CAP) { atomicAdd(&bar[XB_TMO], 1u); break; } }
    }
    nloc = mine > 0u ? mine : 1u; nx = cnt > 0u ? cnt : 1u;
}
__device__ __forceinline__ void xcd_barrier(const XcdBarrier& b) {
    asm volatile("s_waitcnt vmcnt(0)" ::: "memory");
    __syncthreads();
    if (threadIdx.x == 0) {
        unsigned* bar = b.bar;
        __builtin_amdgcn_s_waitcnt(0);
        unsigned nloc = b.st[0], nx = b.st[1];
        if (nloc == 0u) { xcd_barrier_complete(bar, b.x, nloc, nx); b.st[0] = nloc; b.st[1] = nx; }
        const unsigned old = xb_add(&bar[XB_XSUB(b.x)], 1u);
        const unsigned gen = old / nloc;
        if (old + 1u == (gen + 1u) * nloc) {
            __builtin_amdgcn_fence(__ATOMIC_RELEASE, "agent");
            asm volatile("s_waitcnt vmcnt(0)" ::: "memory");
            const unsigned og = xb_add(&bar[XB_TOP], 1u);
            const unsigned tg = og / nx;
            if (og + 1u == (tg + 1u) * nx) xb_add(&bar[XB_TOPGEN], 1u);
            else XB_SPIN(xb_ld(&bar[XB_TOPGEN]) == tg, bar);
            __builtin_amdgcn_fence(__ATOMIC_ACQUIRE, "agent");
            xb_add(&bar[XB_XGEN(b.x)], 1u);
            asm volatile("s_waitcnt vmcnt(0)" ::: "memory");
        } else {
            XB_SPIN(xb_ld(&bar[XB_XGEN(b.x)]) == gen, bar);
            __builtin_amdgcn_fence(__ATOMIC_ACQUIRE, "agent");
            asm volatile("s_waitcnt vmcnt(0)" ::: "memory");
        }
    }
    __syncthreads();
}

constexpr int N_PHASES = 15;
template <int LO, int HI> __global__ void __launch_bounds__(NTHREADS, 2) fwd_kernel(Args args) {
    extern __shared__ __attribute__((aligned(16))) unsigned char lds_raw[];
    Ctx C;
    C.lds = (LAS unsigned char*)lds_raw;
    C.tid = threadIdx.x; C.lane = C.tid & 63; C.wave = __builtin_amdgcn_readfirstlane(C.tid >> 6); C.G = gridDim.x; C.bid = blockIdx.x;
    C.a = &args; C.ws = args.ws;
    const LAS MoeTab* tb = (const LAS MoeTab*)(C.lds + MOETAB_OFF);
    XcdBarrier bar; bar.bar = C.ctl() + CW_BAR; bar.x = 0; bar.st = nullptr;
    if constexpr (HI - LO > 1) {
        volatile LAS unsigned* misc = (volatile LAS unsigned*)(C.lds + MISC_OFF);
        if (C.tid < 64) misc[C.tid] = 0u;
        __syncthreads();
        bar = xcd_barrier_post(C.ctl() + CW_BAR, misc + 8);
    }
#define IN(k) (LO <= (k) && (k) < HI)
#define SEAM(k) do { if constexpr (IN(k) && IN((k) + 1)) xcd_barrier(bar); } while (0)
    if constexpr (IN(0)) phase_prep(C);
    SEAM(0);
#if FAST_INPROJ
    if constexpr (IN(1)) { ProbDense P{C.XN(), C.WIN(), NTOK / 256, NPROJ / 256, DM, C.G, C.bid}; EpiStoreBf16 E{C.PROJ(), NPROJ}; pg8::gemm_phase(C.lds, P, E); }
#else
    if constexpr (IN(1)) { SpecInProj sp{C.XN(), C.WIN(), C.PROJ()}; simple_gemm<1>(C, sp); }
#endif
    SEAM(1);
    if constexpr (IN(2)) phase_poolwin_simple(C);
    SEAM(2);
    if constexpr (IN(3)) { SpecPool sp{C.PWIN(), C.WPOOL(), C.YMIX(), C.b_pool(), C.pool_scale()}; simple_gemm<1>(C, sp); }
    SEAM(3);
    if constexpr (IN(4)) phase_conv_simple(C);
    SEAM(4);
    if constexpr (IN(5)) phase_dt_simple(C);
    SEAM(5);
    if constexpr (IN(6)) phase_states_simple(C);
    SEAM(6);
    if constexpr (IN(7)) phase_scan(C);
    SEAM(7);
    if constexpr (IN(8)) phase_y_simple(C);
    SEAM(8);
    if constexpr (IN(9)) phase_rms_simple(C);
    SEAM(9);
#if FAST_OUTPROJ
    if constexpr (IN(10)) { ProbDense P{C.YMIX(), C.WOUT(), NTOK / 256, DM / 256, DM, C.G, C.bid}; EpiResBf16 E{C.XN(), C.R1()}; pg8::gemm_phase(C.lds, P, E); }
#else
    if constexpr (IN(10)) { SpecOutProj sp{C.YMIX(), C.WOUT(), C.XN(), C.R1()}; simple_gemm<1>(C, sp); }
#endif
    SEAM(10);
    if constexpr (IN(11)) phase_ln1_router(C);
    SEAM(11);
#if FAST_MOE1
    if constexpr (IN(12)) { build_moetab(C); ProbMoe1 P{C.H1(), C.WGU(), C.LIST(), tb, C.G, C.bid}; EpiMoe1 E{C.HB(), C.LW(), tb}; pg8::gemm_phase(C.lds, P, E); }
#else
    if constexpr (IN(12)) { build_moetab(C); SpecMoe1 sp{C.H1(), C.WGU(), C.HB(), C.LIST(), C.LW(), tb}; simple_gemm<2>(C, sp); }
#endif
    SEAM(12);
#if FAST_MOE2
    if constexpr (IN(13)) { build_moetab(C); ProbMoe2 P{C.HB(), C.WD(), tb, C.G, C.bid}; EpiMoe2 E{C.H1(), C.R2(), C.LIST(), tb}; pg8::gemm_phase(C.lds, P, E); }
#else
    if constexpr (IN(13)) { build_moetab(C); SpecMoe2 sp{C.H1(), C.WD(), C.HB(), C.R2(), C.LIST(), tb}; simple_gemm<1>(C, sp); }
#endif
    SEAM(13);
    if constexpr (IN(14)) phase_ln2(C);
#undef IN
#undef SEAM
}

#ifndef ONE_LAUNCH
#define ONE_LAUNCH 1
#endif
template <int P, int Q> static void launch_phase(int grid, hipStream_t stream, const Args& a) {
    static bool attr = false;
    if (!attr) { (void)hipFuncSetAttribute((const void*)fwd_kernel<P, Q>, hipFuncAttributeMaxDynamicSharedMemorySize, LDS_BYTES); (void)hipGetLastError(); attr = true; }
    hipLaunchKernelGGL((fwd_kernel<P, Q>), dim3(grid), dim3(NTHREADS), LDS_BYTES, stream, a);
}

extern "C" void kernel_launch(void* const* d_in, const int* in_sizes, int n_in, void* d_out, int out_size, void* d_ws, size_t ws_size, hipStream_t stream) {
    static int grid = 0;
    if (grid == 0) {
        if (n_in != 25 || in_sizes[0] != NTOK * DM || out_size != NTOK * DM || ws_size < WS_END) { fprintf(stderr, "kernel_launch: unexpected shapes (n_in %d, in0 %d, out %d, ws %zu)\n", n_in, n_in > 0 ? in_sizes[0] : -1, out_size, ws_size); grid = -1; return; }
        int dev = 0, cus = 0;
        if (hipGetDevice(&dev) != hipSuccess || hipDeviceGetAttribute(&cus, hipDeviceAttributeMultiprocessorCount, dev) != hipSuccess) { grid = -1; return; }
        (void)hipGetLastError();
        grid = cus > 0 ? cus : 256;
    }
    if (grid < 0) return;
    (void)hipMemsetAsync((char*)d_ws + WS_CTL, 0, CTL_ZERO_BYTES, stream);
    Args a{};
    for (int i = 0; i < 25; ++i) a.in[i] = (const float*)d_in[i];
    a.out = (float*)d_out; a.ws = (unsigned char*)d_ws;
#if ONE_LAUNCH
    launch_phase<0, N_PHASES>(grid, stream, a);
#else
    launch_phase<0, 1>(grid, stream, a); launch_phase<1, 2>(grid, stream, a); launch_phase<2, 3>(grid, stream, a); launch_phase<3, 4>(grid, stream, a); launch_phase<4, 5>(grid, stream, a);
    launch_phase<5, 6>(grid, stream, a); launch_phase<6, 7>(grid, stream, a); launch_phase<7, 8>(grid, stream, a); launch_phase<8, 9>(grid, stream, a); launch_phase<9, 10>(grid, stream, a);
    launch_phase<10, 11>(grid, stream, a); launch_phase<11, 12>(grid, stream, a); launch_phase<12, 13>(grid, stream, a); launch_phase<13, 14>(grid, stream, a); launch_phase<14, 15>(grid, stream, a);
#endif
}
```

```cpp
#include <hip/hip_runtime.h>
#include <cstdio>
#include <cstdint>

#define GAS __attribute__((address_space(1)))
#define LAS __attribute__((address_space(3)))
typedef unsigned short bf16;
typedef float f32x4 __attribute__((ext_vector_type(4)));
typedef float f32x2 __attribute__((ext_vector_type(2)));
typedef unsigned u32x4 __attribute__((ext_vector_type(4)));
typedef unsigned u32x2 __attribute__((ext_vector_type(2)));

constexpr int NTOK = 32768, DM = 1024, SEQ = 2048, NBATCH = 16, NPROJ = 2048, DINP = 2056;
constexpr int NCHUNK = 16, CHUNK = 128, NHEAD = 8, HP = 64, NST = 128;
constexpr int NCLS = 24, LISTCAP = 32768, MAXT256 = 160;
constexpr float LN_EPS = 1e-5f, RMS_EPS = 1e-5f;
constexpr float ALPHA = 1.189207115002721f;

constexpr int PC_Z = 0, PC_X = 512, PC_B = 1024, PC_C = 1280, PC_U = 1536;

constexpr size_t MiB = 1u << 20;
constexpr size_t WS_CTL = 0, CTL_ZERO_BYTES = 1 * MiB;
constexpr size_t WS_WIN = 2 * MiB;
constexpr size_t WS_WOUT = 6 * MiB;
constexpr size_t WS_WPOOL = 8 * MiB;
constexpr size_t WS_WGU = 10 * MiB;
constexpr size_t WS_WD = 42 * MiB;
constexpr size_t WS_DTRAW = 58 * MiB;
constexpr size_t WS_DTV = 59 * MiB;
constexpr size_t WS_ACL = 60 * MiB;
constexpr size_t WS_CHD = 61 * MiB;
constexpr size_t WS_LIST = 62 * MiB;
constexpr size_t WS_LW = 65 * MiB;
constexpr size_t WS_XN = 72 * MiB;
constexpr size_t WS_PROJ = 136 * MiB;
constexpr size_t WS_YMIX = 264 * MiB;
constexpr size_t WS_STATES = 328 * MiB;
constexpr size_t WS_PREV = 392 * MiB;
constexpr size_t WS_XBCC = 424 * MiB;
constexpr size_t WS_R1 = WS_PROJ;
constexpr size_t WS_H1 = WS_PROJ + 64 * MiB;
constexpr size_t WS_HB = WS_STATES;
constexpr size_t WS_R2 = WS_XN;
constexpr size_t WS_PWIN = WS_STATES;
constexpr size_t WS_YG = WS_STATES;
constexpr size_t WS_END = 488 * MiB;
constexpr int CW_CNT = 1024;

#ifndef FAST_INPROJ
#define FAST_INPROJ 1
#endif
#ifndef FAST_OUTPROJ
#define FAST_OUTPROJ 1
#endif
#ifndef FAST_MOE1
#define FAST_MOE1 1
#endif
#ifndef FAST_MOE2
#define FAST_MOE2 1
#endif
#ifndef FAST_POOL
#define FAST_POOL 1
#endif
#ifndef FAST_STATES
#define FAST_STATES 1
#endif
#ifndef FAST_Y
#define FAST_Y 1
#endif
constexpr int LDS_BYTES = 147456;
constexpr int NTHREADS = 512, NWAVES = 8;

__device__ __forceinline__ unsigned f2bf(float f) { unsigned u = __builtin_bit_cast(unsigned, f); return (u + 0x7fffu + ((u >> 16) & 1u)) >> 16; }
__device__ __forceinline__ unsigned pk2(float lo, float hi) { return f2bf(lo) | (f2bf(hi) << 16); }
__device__ __forceinline__ float bf2f(bf16 h) { return __uint_as_float((unsigned)h << 16); }
__device__ __forceinline__ float bflo(unsigned w) { return __uint_as_float(w << 16); }
__device__ __forceinline__ float bfhi(unsigned w) { return __uint_as_float(w & 0xffff0000u); }
__device__ __forceinline__ float wave_sum(float v) {
#pragma unroll
    for (int o = 1; o < 64; o <<= 1) v += __shfl_xor(v, o);
    return v;
}
__device__ __forceinline__ float silu_f(float v) { return v / (1.0f + __expf(-v)); }
__device__ __forceinline__ void unpack8(const u32x4 v, float (&f)[8]) {
    f[0] = bflo(v.x); f[1] = bfhi(v.x); f[2] = bflo(v.y); f[3] = bfhi(v.y); f[4] = bflo(v.z); f[5] = bfhi(v.z); f[6] = bflo(v.w); f[7] = bfhi(v.w);
}

struct Args { const float* in[25]; float* out; unsigned char* ws; int ph_lo, ph_hi; };

struct Ctx {
    const Args* a; unsigned char* ws; LAS unsigned char* lds;
    int tid, lane, wave, G, bid;
    __device__ __forceinline__ const float* x() const { return a->in[0]; }
    __device__ __forceinline__ const float* ln0_g() const { return a->in[1]; }
    __device__ __forceinline__ const float* ln0_b() const { return a->in[2]; }
    __device__ __forceinline__ const float* w_in() const { return a->in[3]; }
    __device__ __forceinline__ const float* conv_w() const { return a->in[4]; }
    __device__ __forceinline__ const float* conv_b() const { return a->in[5]; }
    __device__ __forceinline__ const float* dt_bias() const { return a->in[6]; }
    __device__ __forceinline__ const float* a_log() const { return a->in[7]; }
    __device__ __forceinline__ const float* d_skip() const { return a->in[8]; }
    __device__ __forceinline__ const float* ssm_norm_g() const { return a->in[9]; }
    __device__ __forceinline__ const float* w_pool() const { return a->in[10]; }
    __device__ __forceinline__ const float* b_pool() const { return a->in[11]; }
    __device__ __forceinline__ const float* pool_scale() const { return a->in[12]; }
    __device__ __forceinline__ const float* w_out() const { return a->in[13]; }
    __device__ __forceinline__ const float* ln1_g() const { return a->in[14]; }
    __device__ __forceinline__ const float* ln1_b() const { return a->in[15]; }
    __device__ __forceinline__ const float* w_rg() const { return a->in[16]; }
    __device__ __forceinline__ const float* b_rg() const { return a->in[17]; }
    __device__ __forceinline__ const float* w_re() const { return a->in[18]; }
    __device__ __forceinline__ const float* b_re() const { return a->in[19]; }
    __device__ __forceinline__ const float* w_gate() const { return a->in[20]; }
    __device__ __forceinline__ const float* w_up() const { return a->in[21]; }
    __device__ __forceinline__ const float* w_down() const { return a->in[22]; }
    __device__ __forceinline__ const float* ln2_g() const { return a->in[23]; }
    __device__ __forceinline__ const float* ln2_b() const { return a->in[24]; }
    __device__ __forceinline__ float* out() const { return a->out; }
    __device__ __forceinline__ unsigned* ctl() const { return (unsigned*)(ws + WS_CTL); }
    __device__ __forceinline__ bf16* WIN() const { return (bf16*)(ws + WS_WIN); }
    __device__ __forceinline__ bf16* WOUT() const { return (bf16*)(ws + WS_WOUT); }
    __device__ __forceinline__ bf16* WPOOL() const { return (bf16*)(ws + WS_WPOOL); }
    __device__ __forceinline__ bf16* WGU() const { return (bf16*)(ws + WS_WGU); }
    __device__ __forceinline__ bf16* WD() const { return (bf16*)(ws + WS_WD); }
    __device__ __forceinline__ bf16* XN() const { return (bf16*)(ws + WS_XN); }
    __device__ __forceinline__ bf16* PROJ() const { return (bf16*)(ws + WS_PROJ); }
    __device__ __forceinline__ bf16* YMIX() const { return (bf16*)(ws + WS_YMIX); }
    __device__ __forceinline__ bf16* PREV() const { return (bf16*)(ws + WS_PREV); }
    __device__ __forceinline__ bf16* XBCC() const { return (bf16*)(ws + WS_XBCC); }
    __device__ __forceinline__ bf16* R1() const { return (bf16*)(ws + WS_R1); }
    __device__ __forceinline__ bf16* H1() const { return (bf16*)(ws + WS_H1); }
    __device__ __forceinline__ bf16* HB() const { return (bf16*)(ws + WS_HB); }
    __device__ __forceinline__ bf16* R2() const { return (bf16*)(ws + WS_R2); }
    __device__ __forceinline__ bf16* PWIN() const { return (bf16*)(ws + WS_PWIN); }
    __device__ __forceinline__ float* DTRAW() const { return (float*)(ws + WS_DTRAW); }
    __device__ __forceinline__ float* DTV() const { return (float*)(ws + WS_DTV); }
    __device__ __forceinline__ float* ACL() const { return (float*)(ws + WS_ACL); }
    __device__ __forceinline__ float* CHD() const { return (float*)(ws + WS_CHD); }
    __device__ __forceinline__ float* STATES() const { return (float*)(ws + WS_STATES); }
    __device__ __forceinline__ float* LW() const { return (float*)(ws + WS_LW); }
    __device__ __forceinline__ float* YG() const { return (float*)(ws + WS_YG); }
    __device__ __forceinline__ int* LIST() const { return (int*)(ws + WS_LIST); }
};

__device__ __forceinline__ void transpose_item(const float* src, int ld_src, bf16* dst, int ld_dst, LAS float* scr, int lane) {
#pragma unroll 8
    for (int i = 0; i < 32; ++i) { const int kk = 2 * i + (lane >> 5); scr[kk * 33 + (lane & 31)] = src[(size_t)kk * ld_src + (lane & 31)]; }
    asm volatile("s_waitcnt lgkmcnt(0)" ::: "memory");
    const int c = lane & 7;
#pragma unroll
    for (int j = 0; j < 4; ++j) { const int n = (lane >> 3) + 8 * j; const LAS float* s = scr + (8 * c) * 33 + n;
        u32x4 o; o.x = pk2(s[0 * 33], s[1 * 33]); o.y = pk2(s[2 * 33], s[3 * 33]); o.z = pk2(s[4 * 33], s[5 * 33]); o.w = pk2(s[6 * 33], s[7 * 33]);
        *(u32x4*)(dst + (size_t)n * ld_dst + 8 * c) = o; }
    asm volatile("s_waitcnt lgkmcnt(0)" ::: "memory");
}

__device__ __forceinline__ void phase_prep(const Ctx& C) {
    LAS float* scr = (LAS float*)(C.lds + C.wave * 8704);
    LAS float* wdt = (LAS float*)(C.lds + 8 * 8704);
    const int gw = C.bid * NWAVES + C.wave, NGW = C.G * NWAVES;
    for (int i = C.tid; i < 8 * 1024; i += NTHREADS) { const int k = i >> 3, n = i & 7; wdt[n * 1024 + k] = C.w_in()[(size_t)k * DINP + 1536 + n]; }
    constexpr int I_WIN = 16 * 64, I_WOUT = 16 * 32, I_WPOOL = 4 * 2 * 4, I_WGU = 16 * 16 * 32, I_WD = 16 * 8 * 32;
    constexpr int NITEMS = I_WIN + I_WOUT + I_WPOOL + I_WGU + I_WD;
    for (int it = gw; it < NITEMS; it += NGW) {
        int r = it;
        if (r < I_WIN) { const int kb = r / 64, nb = r % 64, n0 = nb * 32, n0s = n0 + (n0 >= 1536 ? 8 : 0);
            transpose_item(C.w_in() + (size_t)(kb * 64) * DINP + n0s, DINP, C.WIN() + (size_t)n0 * 1024 + kb * 64, 1024, scr, C.lane); continue; }
        r -= I_WIN;
        if (r < I_WOUT) { const int kb = r / 32, nb = r % 32;
            transpose_item(C.w_out() + (size_t)(kb * 64) * 1024 + nb * 32, 1024, C.WOUT() + (size_t)(nb * 32) * 1024 + kb * 64, 1024, scr, C.lane); continue; }
        r -= I_WOUT;
        if (r < I_WPOOL) { const int g = r / 8, kb = (r % 8) / 4, nb = r % 4;
            transpose_item(C.w_pool() + (size_t)g * 16384 + (size_t)(kb * 64) * 128 + nb * 32, 128, C.WPOOL() + (size_t)g * 16384 + (size_t)(nb * 32) * 128 + kb * 64, 128, scr, C.lane); continue; }
        r -= I_WPOOL;
        if (r < I_WGU) { const int e = r / 512, q = r % 512, kb = q / 32, nb = q % 32;
            const int row0 = nb * 32, t = row0 >> 8, half = (row0 >> 7) & 1, i0 = row0 & 127;
            const float* src = (half ? C.w_up() : C.w_gate()) + (size_t)e * 1024 * 512 + (size_t)(kb * 64) * 512 + 128 * t + i0;
            transpose_item(src, 512, C.WGU() + (size_t)e * 1048576 + (size_t)row0 * 1024 + kb * 64, 1024, scr, C.lane); continue; }
        r -= I_WGU;
        { const int e = r / 256, q = r % 256, kb = q / 32, nb = q % 32;
            transpose_item(C.w_down() + (size_t)e * 524288 + (size_t)(kb * 64) * 1024 + nb * 32, 1024, C.WD() + (size_t)e * 524288 + (size_t)(nb * 32) * 512 + kb * 64, 512, scr, C.lane); }
    }
    __syncthreads();
    f32x4 gg[4], bb[4];
#pragma unroll
    for (int j = 0; j < 4; ++j) { gg[j] = *(const f32x4*)(C.ln0_g() + 4 * C.lane + 256 * j); bb[j] = *(const f32x4*)(C.ln0_b() + 4 * C.lane + 256 * j); }
    for (int m = gw; m < NTOK; m += NGW) {
        const f32x4* xr = (const f32x4*)(C.x() + (size_t)m * DM) + C.lane;
        f32x4 v[4]; float s = 0.f;
#pragma unroll
        for (int j = 0; j < 4; ++j) { v[j] = xr[64 * j]; s += (v[j].x + v[j].y) + (v[j].z + v[j].w); }
        const float mean = wave_sum(s) * (1.f / DM); float s2 = 0.f;
#pragma unroll
        for (int j = 0; j < 4; ++j) { v[j] = v[j] - mean; s2 += (v[j].x * v[j].x + v[j].y * v[j].y) + (v[j].z * v[j].z + v[j].w * v[j].w); }
        const float rstd = 1.f / sqrtf(wave_sum(s2) * (1.f / DM) + LN_EPS);
        unsigned long long* o8 = (unsigned long long*)(C.XN() + (size_t)m * DM) + C.lane;
#pragma unroll
        for (int j = 0; j < 4; ++j) { v[j] = v[j] * rstd * gg[j] + bb[j];
            o8[64 * j] = (unsigned long long)pk2(v[j].x, v[j].y) | ((unsigned long long)pk2(v[j].z, v[j].w) << 32); }
        float d[8];
#pragma unroll
        for (int n = 0; n < 8; ++n) { float a = 0.f;
#pragma unroll
            for (int j = 0; j < 4; ++j) { const f32x4 w = *(const LAS f32x4*)(wdt + n * 1024 + 4 * C.lane + 256 * j); a += (v[j].x * w.x + v[j].y * w.y) + (v[j].z * w.z + v[j].w * w.w); }
            d[n] = wave_sum(a); }
        if (C.lane == 0) { *(f32x4*)(C.DTRAW() + (size_t)m * 8) = (f32x4){d[0], d[1], d[2], d[3]}; *(f32x4*)(C.DTRAW() + (size_t)m * 8 + 4) = (f32x4){d[4], d[5], d[6], d[7]}; }
    }
}

struct MoeTab { int ntiles; int cnt[NCLS]; int cls[MAXT256]; int row0[MAXT256]; };
constexpr int MOETAB_OFF = 140 * 1024;
__device__ __forceinline__ void class_experts(int c, int& elo, int& ehi) {
    const int g = c / 6, q = c % 6; const int il = q < 3 ? 0 : (q < 5 ? 1 : 2); const int ih = q < 3 ? q + 1 : (q < 5 ? q - 1 : 3);
    elo = g * 4 + il; ehi = g * 4 + ih;
}
__device__ __forceinline__ void build_moetab(const Ctx& C) {
    LAS MoeTab* tb = (LAS MoeTab*)(C.lds + MOETAB_OFF);
    if (C.tid == 0) {
        int nt = 0;
        for (int c = 0; c < NCLS; ++c) { int n = (int)__hip_atomic_load(C.ctl() + CW_CNT + c, __ATOMIC_RELAXED, __HIP_MEMORY_SCOPE_AGENT); if (n > LISTCAP) n = LISTCAP; tb->cnt[c] = n;
            for (int r = 0; r < n; r += 256) { if (nt < MAXT256) { tb->cls[nt] = c; tb->row0[nt] = r; ++nt; } } }
        tb->ntiles = nt;
    }
    __syncthreads();
}

template <int NBOP, class Spec> __device__ __forceinline__ void simple_gemm(const Ctx& C, const Spec& sp) {
    LAS float* As = (LAS float*)C.lds;
    LAS float* Bs = As + 16 * 132;
    const int tid = C.tid, ty = tid >> 4, tx = tid & 15;
    const int nmt = sp.n_mtiles(), nnt = sp.n_ntiles(), K = sp.K();
    for (int tile = C.bid; tile < nmt * nnt; tile += C.G) {
        const int mt = tile / nnt, nt = tile % nnt;
        float acc[NBOP][4][4];
#pragma unroll
        for (int o = 0; o < NBOP; ++o)
#pragma unroll
            for (int i = 0; i < 4; ++i)
#pragma unroll
                for (int j = 0; j < 4; ++j) acc[o][i][j] = 0.f;
        const bf16* ap = nullptr; const bf16* bp = nullptr; int bop = 0, bc = 0, bhf = 0;
        if (tid < 256) ap = sp.a_row(mt, nt, tid >> 1);
        else { const int idx = tid - 256; bop = idx >> 7; bc = (idx & 127) >> 1; bhf = idx & 1; }
        for (int k0 = 0; k0 < K; k0 += 16) {
            if (tid < 256) { const int r = tid >> 1, hf = tid & 1; float f[8];
                if (ap) { unpack8(*(const u32x4*)(ap + k0 + hf * 8), f); } else {
#pragma unroll
                    for (int i = 0; i < 8; ++i) f[i] = 0.f; }
#pragma unroll
                for (int i = 0; i < 8; ++i) As[(hf * 8 + i) * 132 + r] = f[i];
            } else if (bop < NBOP) { float f[8]; bp = sp.b_row(mt, nt, bop, bc, k0); unpack8(*(const u32x4*)(bp + bhf * 8), f);
#pragma unroll
                for (int i = 0; i < 8; ++i) Bs[(bop * 16 + bhf * 8 + i) * 68 + bc] = f[i];
            }
            __syncthreads();
#pragma unroll
            for (int k = 0; k < 16; ++k) { const f32x4 a = *(const LAS f32x4*)(As + k * 132 + ty * 4);
#pragma unroll
                for (int o = 0; o < NBOP; ++o) { const f32x4 b = *(const LAS f32x4*)(Bs + (o * 16 + k) * 68 + tx * 4);
                    acc[o][0][0] += a.x * b.x; acc[o][0][1] += a.x * b.y; acc[o][0][2] += a.x * b.z; acc[o][0][3] += a.x * b.w;
                    acc[o][1][0] += a.y * b.x; acc[o][1][1] += a.y * b.y; acc[o][1][2] += a.y * b.z; acc[o][1][3] += a.y * b.w;
                    acc[o][2][0] += a.z * b.x; acc[o][2][1] += a.z * b.y; acc[o][2][2] += a.z * b.z; acc[o][2][3] += a.z * b.w;
                    acc[o][3][0] += a.w * b.x; acc[o][3][1] += a.w * b.y; acc[o][3][2] += a.w * b.z; acc[o][3][3] += a.w * b.w; } }
            __syncthreads();
        }
        sp.epilogue(mt, nt, ty * 4, tx * 4, acc);
    }
}

struct SpecInProj {
    const bf16* XN; const bf16* W; bf16* O;
    __device__ int n_mtiles() const { return NTOK / 128; } __device__ int n_ntiles() const { return NPROJ / 64; } __device__ int K() const { return DM; }
    __device__ const bf16* a_row(int mt, int, int r) const { return XN + (size_t)(mt * 128 + r) * DM; }
    __device__ const bf16* b_row(int, int nt, int, int c, int k0) const { return W + (size_t)(nt * 64 + c) * DM + k0; }
    __device__ void epilogue(int mt, int nt, int r0, int c0, const float (&acc)[1][4][4]) const {
#pragma unroll
        for (int i = 0; i < 4; ++i) { u32x2 w; w.x = pk2(acc[0][i][0], acc[0][i][1]); w.y = pk2(acc[0][i][2], acc[0][i][3]);
            *(u32x2*)(O + (size_t)(mt * 128 + r0 + i) * NPROJ + nt * 64 + c0) = w; }
    }
};
struct SpecPool {
    const bf16* P; const bf16* W; bf16* O; const float* bias; const float* scale;
    __device__ int n_mtiles() const { return NTOK / 128; } __device__ int n_ntiles() const { return 8; } __device__ int K() const { return 128; }
    __device__ const bf16* a_row(int mt, int nt, int r) const { return P + (size_t)(mt * 128 + r) * 512 + (nt >> 1) * 128; }
    __device__ const bf16* b_row(int, int nt, int, int c, int k0) const { return W + (size_t)(nt >> 1) * 16384 + (size_t)((nt & 1) * 64 + c) * 128 + k0; }
    __device__ void epilogue(int mt, int nt, int r0, int c0, const float (&acc)[1][4][4]) const {
        const int col = nt * 64 + c0; const f32x4 b = *(const f32x4*)(bias + col), s = *(const f32x4*)(scale + col);
#pragma unroll
        for (int i = 0; i < 4; ++i) { u32x2 w; w.x = pk2((acc[0][i][0] + b.x) * s.x, (acc[0][i][1] + b.y) * s.y); w.y = pk2((acc[0][i][2] + b.z) * s.z, (acc[0][i][3] + b.w) * s.w);
            *(u32x2*)(O + (size_t)(mt * 128 + r0 + i) * DM + 512 + col) = w; }
    }
};
struct SpecOutProj {
    const bf16* Y; const bf16* W; const bf16* XN; bf16* O;
    __device__ int n_mtiles() const { return NTOK / 128; } __device__ int n_ntiles() const { return DM / 64; } __device__ int K() const { return DM; }
    __device__ const bf16* a_row(int mt, int, int r) const { return Y + (size_t)(mt * 128 + r) * DM; }
    __device__ const bf16* b_row(int, int nt, int, int c, int k0) const { return W + (size_t)(nt * 64 + c) * DM + k0; }
    __device__ void epilogue(int mt, int nt, int r0, int c0, const float (&acc)[1][4][4]) const {
#pragma unroll
        for (int i = 0; i < 4; ++i) { const size_t off = (size_t)(mt * 128 + r0 + i) * DM + nt * 64 + c0; const u32x2 xv = *(const u32x2*)(XN + off);
            u32x2 w; w.x = pk2(ALPHA * bflo(xv.x) + acc[0][i][0], ALPHA * bfhi(xv.x) + acc[0][i][1]); w.y = pk2(ALPHA * bflo(xv.y) + acc[0][i][2], ALPHA * bfhi(xv.y) + acc[0][i][3]);
            *(u32x2*)(O + off) = w; }
    }
};
struct SpecMoe1 {
    const bf16* H1; const bf16* WGU; bf16* HB; const int* LIST; const float* LW; const LAS MoeTab* tb;
    __device__ int n_mtiles() const { return tb->ntiles * 2; } __device__ int n_ntiles() const { return 16; } __device__ int K() const { return DM; }
    __device__ const bf16* a_row(int mt, int, int r) const { const int t = mt >> 1, c = tb->cls[t], rr = tb->row0[t] + (mt & 1) * 128 + r;
        if (rr >= tb->cnt[c]) return nullptr; return H1 + (size_t)LIST[c * LISTCAP + rr] * DM; }
    __device__ const bf16* b_row(int mt, int nt, int op, int c, int k0) const { const int cl = tb->cls[mt >> 1]; int elo, ehi; class_experts(cl, elo, ehi);
        const int hc = nt * 64 + c, slot = hc >> 9, hh = hc & 511, e = slot ? ehi : elo; return WGU + (size_t)e * 1048576 + (size_t)((hh >> 7) * 256 + op * 128 + (hh & 127)) * DM + k0; }
    __device__ void epilogue(int mt, int nt, int r0, int c0, const float (&acc)[2][4][4]) const {
        const int t = mt >> 1, c = tb->cls[t]; const int slot = (nt * 64) >> 9;
#pragma unroll
        for (int i = 0; i < 4; ++i) { const int rr = tb->row0[t] + (mt & 1) * 128 + r0 + i; const float w = rr < tb->cnt[c] ? LW[((size_t)c * LISTCAP + rr) * 2 + slot] : 0.f;
            float h[4];
#pragma unroll
            for (int j = 0; j < 4; ++j) h[j] = w * silu_f(acc[0][i][j]) * acc[1][i][j];
            u32x2 o; o.x = pk2(h[0], h[1]); o.y = pk2(h[2], h[3]);
            *(u32x2*)(HB + (size_t)(mt * 128 + r0 + i) * DM + nt * 64 + c0) = o; }
    }
};
struct SpecMoe2 {
    const bf16* H1; const bf16* WD; const bf16* HB; bf16* R2; const int* LIST; const LAS MoeTab* tb;
    __device__ int n_mtiles() const { return tb->ntiles * 2; } __device__ int n_ntiles() const { return 16; } __device__ int K() const { return DM; }
    __device__ const bf16* a_row(int mt, int, int r) const { return HB + (size_t)(mt * 128 + r) * DM; }
    __device__ const bf16* b_row(int mt, int nt, int, int c, int k0) const { const int cl = tb->cls[mt >> 1]; int elo, ehi; class_experts(cl, elo, ehi);
        const int e = k0 < 512 ? elo : ehi; return WD + (size_t)e * 524288 + (size_t)(nt * 64 + c) * 512 + (k0 & 511); }
    __device__ void epilogue(int mt, int nt, int r0, int c0, const float (&acc)[1][4][4]) const {
        const int t = mt >> 1, c = tb->cls[t];
#pragma unroll
        for (int i = 0; i < 4; ++i) { const int rr = tb->row0[t] + (mt & 1) * 128 + r0 + i; if (rr >= tb->cnt[c]) continue;
            const size_t off = (size_t)LIST[c * LISTCAP + rr] * DM + nt * 64 + c0; const u32x2 xv = *(const u32x2*)(H1 + off);
            u32x2 w; w.x = pk2(ALPHA * bflo(xv.x) + acc[0][i][0], ALPHA * bfhi(xv.x) + acc[0][i][1]); w.y = pk2(ALPHA * bflo(xv.y) + acc[0][i][2], ALPHA * bfhi(xv.y) + acc[0][i][3]);
            *(u32x2*)(R2 + off) = w; }
    }
};

namespace pg8 {
typedef short bf16x8 __attribute__((ext_vector_type(8)));
constexpr int BM = 256, BK = 64, HALF = 128, HTB = HALF * BK * 2, STAGE_BYTES = 8 * HTB, NXCD = 8, WGM = 8;
__host__ __device__ __forceinline__ int lds_byte(int r, int c) { const int st = (r >> 4) * 2 + (c >> 5), rr = r & 15, cc = c & 31, ob = rr * 64 + cc * 2; return st * 1024 + (ob ^ (((ob >> 9) & 1) << 5)); }
__host__ __device__ __forceinline__ void stage_rc(int b, int& R, int& C) { const int st = b / 1024, sb = b % 1024, swz = sb ^ (((sb >> 9) & 1) << 5); R = (st >> 1) * 16 + swz / 64; C = (st & 1) * 32 + (swz % 64) / 2; }
__host__ __device__ __forceinline__ int perm32(int rho) { const int n = rho >> 4, i = rho & 15; return 8 * (i >> 2) + 4 * n + (i & 3); }
struct Unit { int pm, pn, xa, xb; };
__device__ __forceinline__ bool order_next(int i, int G, int c, int nM, int nN, Unit& u) {
    const int nwg = nM * nN; const long L = (long)i * G + c; if (L >= nwg) return false;
    int wgid = (int)L; { const int q = nwg / NXCD, r = nwg % NXCD, xcd = wgid % NXCD, off = wgid / NXCD; wgid = (xcd < r ? xcd * (q + 1) : r * (q + 1) + (xcd - r) * q) + off; }
    const int nig = WGM * nN, gid = wgid / nig, fm = gid * WGM, gsz = (nM - fm) < WGM ? (nM - fm) : WGM;
    u.pm = fm + ((wgid % nig) % gsz); u.pn = (wgid % nig) / gsz; return true;
}
__device__ __forceinline__ unsigned cvt_pk_bf16(float lo, float hi) { unsigned r; asm volatile("v_cvt_pk_bf16_f32 %0, %1, %2" : "=v"(r) : "v"(lo), "v"(hi)); return r; }

template <class Prob, class Epi>
__device__ __forceinline__ void gemm_phase(LAS unsigned char* lds, const Prob& P, const Epi& E) {
    constexpr bool GA = Prob::GATHER;
    int tid = threadIdx.x; asm volatile("" : "+v"(tid));
    const int wid = __builtin_amdgcn_readfirstlane(tid >> 6), lane = tid & 63, wr = wid >> 2, wc = wid & 3, fr = lane & 15, fq = lane >> 4;
    const int nt = P.ktiles();
    const unsigned ldb = P.ldb_bytes();
    unsigned voffB[2], voffA[2];
#pragma unroll
    for (int i = 0; i < 2; ++i) { int R, Cc; stage_rc(tid * 16 + i * 8192, R, Cc); const int Rb = (R & ~31) + perm32(R & 31); voffB[i] = (unsigned)Rb * ldb + (unsigned)Cc * 2u;
        voffA[i] = GA ? 0u : P.a_voff_dense(R, Cc); }
    const unsigned hstepB = 128u * ldb;
    const unsigned ldsw = (unsigned)wid * 1024u;
    const int aoff = lds_byte(wr * 64 + fr, fq * 8), boff = lds_byte(wc * 32 + fr, fq * 8);
#define PG8_SA(b, h) (((b) * 2 + (h)) * HTB)
#define PG8_SB(b, h) ((4 + (b) * 2 + (h)) * HTB)
#define PG8_STAGE(bufoff, gbase, voff) do { _Pragma("unroll") for (int _i = 0; _i < 2; ++_i) \
        __builtin_amdgcn_global_load_lds((const unsigned*)((const char*)(gbase) + (voff)[_i]), (LAS unsigned*)(lds + (bufoff) + ldsw + _i * 8192), 16, 0, 0); } while (0)
#define PG8_LDA(dst, b, h) do { _Pragma("unroll") for (int m = 0; m < 4; ++m) _Pragma("unroll") for (int k = 0; k < 2; ++k) dst[m][k] = *(const LAS bf16x8*)(lds + PG8_SA(b, h) + aoff + m * 2048 + k * 1024); } while (0)
#define PG8_LDB(dst, b, h) do { _Pragma("unroll") for (int n = 0; n < 2; ++n) _Pragma("unroll") for (int k = 0; k < 2; ++k) dst[n][k] = *(const LAS bf16x8*)(lds + PG8_SB(b, h) + boff + n * 2048 + k * 1024); } while (0)
#define PG8_MMA(ai, bj, At, Bt) do { __builtin_amdgcn_s_setprio(1); _Pragma("unroll") for (int m = 0; m < 4; ++m) _Pragma("unroll") for (int n = 0; n < 2; ++n) _Pragma("unroll") for (int k = 0; k < 2; ++k) \
        acc[ai][bj][m][n] = __builtin_amdgcn_mfma_f32_16x16x32_bf16(Bt[n][k], At[m][k], acc[ai][bj][m][n], 0, 0, 0); __builtin_amdgcn_s_setprio(0); } while (0)
#define PG8_WAIT_V(n) asm volatile("s_waitcnt vmcnt(" #n ")" ::: "memory")
#define PG8_WAIT_L(n) asm volatile("s_waitcnt lgkmcnt(" #n ")" ::: "memory")
#define PG8_BAR __builtin_amdgcn_s_barrier()
#define PG8_SCHED __builtin_amdgcn_sched_barrier(0)
    Unit cur, nxt; int ui = 0;
    if (!P.next(0, cur)) return;
    f32x4 acc[2][2][4][2];
#pragma unroll
    for (int a = 0; a < 2; ++a)
#pragma unroll
        for (int b = 0; b < 2; ++b)
#pragma unroll
            for (int m = 0; m < 4; ++m)
#pragma unroll
                for (int n = 0; n < 2; ++n) acc[a][b][m][n] = (f32x4){0.f, 0.f, 0.f, 0.f};
    bf16x8 At[4][2], B0[2][2], B1[2][2];
    unsigned vc0[2], vc1[2], vn0[2], vn1[2];
    const char* cA0; const char* cA1; const char* nA0; const char* nA1;
    if constexpr (GA) { cA0 = cA1 = nA0 = nA1 = P.a_base();
#pragma unroll
        for (int i = 0; i < 2; ++i) { int R, Cc; stage_rc(tid * 16 + i * 8192, R, Cc); vc0[i] = P.a_voff(cur, 0, R, Cc); vc1[i] = P.a_voff(cur, 1, R, Cc); vn0[i] = vc0[i]; vn1[i] = vc1[i]; }
    } else { cA0 = P.a_half(cur, 0); cA1 = P.a_half(cur, 1); nA0 = cA0; nA1 = cA1;
#pragma unroll
        for (int i = 0; i < 2; ++i) { vc0[i] = vc1[i] = vn0[i] = vn1[i] = voffA[i]; } }
    const size_t kstep = (size_t)(BK * 2);
    {
        const char* cB0 = P.b_tile(cur, 0); const char* cB1 = P.b_tile(cur, 1);
        PG8_STAGE(PG8_SB(0, 0), cB0, voffB); PG8_STAGE(PG8_SB(0, 1), cB0 + hstepB, voffB); PG8_STAGE(PG8_SA(0, 0), cA0, vc0); PG8_STAGE(PG8_SA(0, 1), cA1, vc1);
        if (wr == 1) PG8_BAR;
        PG8_WAIT_V(2); PG8_BAR;
        PG8_STAGE(PG8_SB(1, 0), cB1, voffB); PG8_STAGE(PG8_SA(1, 0), cA0 + kstep, vc0); PG8_STAGE(PG8_SB(1, 1), cB1 + hstepB, voffB);
        PG8_WAIT_V(6); PG8_BAR;
    }
    for (;;) {
        const bool has_next = P.next(ui + 1, nxt);
        if (!has_next) nxt = cur;
        if constexpr (!GA) { nA0 = P.a_half(nxt, 0); nA1 = P.a_half(nxt, 1); }
        for (int t = 0; t < nt; t += 2) {
            const bool last = (t == nt - 2);
            if constexpr (GA) { if (last) {
#pragma unroll
                for (int i = 0; i < 2; ++i) { int R, Cc; stage_rc(tid * 16 + i * 8192, R, Cc); vn0[i] = P.a_voff(nxt, 0, R, Cc); vn1[i] = P.a_voff(nxt, 1, R, Cc); } } }
            const char* a11 = cA1 + (size_t)(t + 1) * kstep;
            const char* a20 = last ? nA0 : cA0 + (size_t)(t + 2) * kstep; const char* a21 = last ? nA1 : cA1 + (size_t)(t + 2) * kstep;
            const char* a30 = a20 + kstep;
            const char* b2 = last ? P.b_tile(nxt, 0) : P.b_tile(cur, t + 2); const char* b3 = last ? P.b_tile(nxt, 1) : P.b_tile(cur, t + 3);
            PG8_LDB(B0, 0, 0); PG8_LDB(B1, 0, 1); PG8_SCHED; PG8_LDA(At, 0, 0); PG8_STAGE(PG8_SA(1, 1), a11, vc1);
            if constexpr (GA) { if (last) {
#pragma unroll
                for (int i = 0; i < 2; ++i) { vc0[i] = vn0[i]; vc1[i] = vn1[i]; } } }
            PG8_WAIT_V(8); PG8_WAIT_L(0); PG8_BAR; PG8_MMA(0, 0, At, B0); PG8_MMA(0, 1, At, B1); PG8_BAR; PG8_SCHED;
            PG8_LDA(At, 0, 1); PG8_STAGE(PG8_SB(0, 0), b2, voffB); PG8_STAGE(PG8_SB(0, 1), b2 + hstepB, voffB); PG8_STAGE(PG8_SA(0, 0), a20, vc0);
            PG8_WAIT_V(8); PG8_WAIT_L(0); PG8_BAR; PG8_MMA(1, 0, At, B0); PG8_MMA(1, 1, At, B1); PG8_BAR; PG8_SCHED;
            PG8_LDB(B0, 1, 0); PG8_LDB(B1, 1, 1); PG8_SCHED; PG8_LDA(At, 1, 0); PG8_STAGE(PG8_SA(0, 1), a21, vc1);
            PG8_WAIT_V(8); PG8_WAIT_L(0); PG8_BAR; PG8_MMA(0, 0, At, B0); PG8_MMA(0, 1, At, B1); PG8_BAR; PG8_SCHED;
            PG8_LDA(At, 1, 1); PG8_STAGE(PG8_SB(1, 0), b3, voffB); PG8_STAGE(PG8_SB(1, 1), b3 + hstepB, voffB); PG8_STAGE(PG8_SA(1, 0), a30, vc0);
            PG8_WAIT_V(8); PG8_WAIT_L(0); PG8_BAR; PG8_MMA(1, 0, At, B0); PG8_MMA(1, 1, At, B1); PG8_BAR; PG8_SCHED;
        }
        if (wr == 0) PG8_BAR;
        E(acc, cur, wr, wc, fr, fq);
        if (!has_next) break;
#pragma unroll
        for (int a = 0; a < 2; ++a)
#pragma unroll
            for (int b = 0; b < 2; ++b)
#pragma unroll
                for (int m = 0; m < 4; ++m)
#pragma unroll
                    for (int n = 0; n < 2; ++n) acc[a][b][m][n] = (f32x4){0.f, 0.f, 0.f, 0.f};
        cur = nxt; ++ui; cA0 = nA0; cA1 = nA1;
        if (wr == 1) PG8_BAR;
    }
    PG8_WAIT_V(0);
    PG8_BAR;
#undef PG8_SA
#undef PG8_SB
#undef PG8_STAGE
#undef PG8_LDA
#undef PG8_LDB
#undef PG8_MMA
#undef PG8_WAIT_V
#undef PG8_WAIT_L
#undef PG8_BAR
#undef PG8_SCHED
}
}

struct ProbDense {
    static constexpr bool GATHER = false;
    const bf16* A; const bf16* Bt; int nM, nN, K, G, c;
    __device__ __forceinline__ bool next(int i, pg8::Unit& u) const { return pg8::order_next(i, G, c, nM, nN, u); }
    __device__ __forceinline__ int ktiles() const { return K / 64; }
    __device__ __forceinline__ unsigned ldb_bytes() const { return (unsigned)K * 2u; }
    __device__ __forceinline__ unsigned a_voff_dense(int R, int Cc) const { return ((unsigned)R * (unsigned)K + (unsigned)Cc) * 2u; }
    __device__ __forceinline__ const char* a_half(const pg8::Unit& u, int h) const { return (const char*)A + (size_t)(u.pm * 256 + h * 128) * K * 2; }
    __device__ __forceinline__ const char* a_base() const { return (const char*)A; }
    __device__ __forceinline__ unsigned a_voff(const pg8::Unit&, int, int, int) const { return 0u; }
    __device__ __forceinline__ const char* b_tile(const pg8::Unit& u, int kt) const { return (const char*)Bt + ((size_t)u.pn * 256 * K + (size_t)kt * 64) * 2; }
};
struct EpiStoreBf16 {
    bf16* O; int ldc;
    __device__ __forceinline__ void operator()(const f32x4 (&acc)[2][2][4][2], const pg8::Unit& u, int wr, int wc, int fr, int fq) const {
        const int row0 = u.pm * 256 + wr * 64 + fr, col0 = u.pn * 256 + wc * 32 + 8 * fq;
#pragma unroll
        for (int ai = 0; ai < 2; ++ai)
#pragma unroll
            for (int m = 0; m < 4; ++m) { bf16* rowp = O + (size_t)(row0 + ai * 128 + m * 16) * ldc + col0;
#pragma unroll
                for (int bj = 0; bj < 2; ++bj) { const f32x4 v0 = acc[ai][bj][m][0], v1 = acc[ai][bj][m][1];
                    u32x4 w; w.x = pg8::cvt_pk_bf16(v0[0], v0[1]); w.y = pg8::cvt_pk_bf16(v0[2], v0[3]); w.z = pg8::cvt_pk_bf16(v1[0], v1[1]); w.w = pg8::cvt_pk_bf16(v1[2], v1[3]);
                    *(u32x4*)(rowp + bj * 128) = w; } }
    }
};
struct EpiResBf16 {
    const bf16* X; bf16* O;
    __device__ __forceinline__ void operator()(const f32x4 (&acc)[2][2][4][2], const pg8::Unit& u, int wr, int wc, int fr, int fq) const {
        const int row0 = u.pm * 256 + wr * 64 + fr, col0 = u.pn * 256 + wc * 32 + 8 * fq;
#pragma unroll
        for (int ai = 0; ai < 2; ++ai)
#pragma unroll
            for (int m = 0; m < 4; ++m) { const size_t off = (size_t)(row0 + ai * 128 + m * 16) * DM + col0;
#pragma unroll
                for (int bj = 0; bj < 2; ++bj) { const f32x4 v0 = acc[ai][bj][m][0], v1 = acc[ai][bj][m][1]; const u32x4 xv = *(const u32x4*)(X + off + bj * 128);
                    u32x4 w; w.x = pg8::cvt_pk_bf16(ALPHA * bflo(xv.x) + v0[0], ALPHA * bfhi(xv.x) + v0[1]); w.y = pg8::cvt_pk_bf16(ALPHA * bflo(xv.y) + v0[2], ALPHA * bfhi(xv.y) + v0[3]);
                    w.z = pg8::cvt_pk_bf16(ALPHA * bflo(xv.z) + v1[0], ALPHA * bfhi(xv.z) + v1[1]); w.w = pg8::cvt_pk_bf16(ALPHA * bflo(xv.w) + v1[2], ALPHA * bfhi(xv.w) + v1[3]);
                    *(u32x4*)(O + off + bj * 128) = w; } }
    }
};

struct ProbMoe1 {
    static constexpr bool GATHER = true;
    const bf16* H1; const bf16* WGU; const int* LIST; const LAS MoeTab* tb; int G, c;
    __device__ __forceinline__ bool next(int i, pg8::Unit& u) const { if (!pg8::order_next(i, G, c, tb->ntiles, 8, u)) return false;
        const int cl = tb->cls[u.pm]; int elo, ehi; class_experts(cl, elo, ehi); u.xa = elo | (ehi << 8) | (cl << 16); u.xb = tb->row0[u.pm]; return true; }
    __device__ __forceinline__ int ktiles() const { return 16; }
    __device__ __forceinline__ unsigned ldb_bytes() const { return 2048u; }
    __device__ __forceinline__ unsigned a_voff_dense(int, int) const { return 0u; }
    __device__ __forceinline__ const char* a_half(const pg8::Unit&, int) const { return (const char*)H1; }
    __device__ __forceinline__ const char* a_base() const { return (const char*)H1; }
    __device__ __forceinline__ unsigned a_voff(const pg8::Unit& u, int h, int R, int Cc) const { const int cl = u.xa >> 16; int rr = u.xb + h * 128 + R; if (rr >= tb->cnt[cl]) rr = u.xb;
        const unsigned tok = (unsigned)LIST[cl * LISTCAP + rr]; return (tok * 1024u + (unsigned)Cc) * 2u; }
    __device__ __forceinline__ const char* b_tile(const pg8::Unit& u, int kt) const { const int e = (u.pn < 4) ? (u.xa & 255) : ((u.xa >> 8) & 255);
        return (const char*)WGU + ((size_t)e * 1048576 + (size_t)(u.pn & 3) * 262144 + (size_t)kt * 64) * 2; }
};
struct EpiMoe1 {
    bf16* HB; const float* LW; const LAS MoeTab* tb;
    __device__ __forceinline__ void operator()(const f32x4 (&acc)[2][2][4][2], const pg8::Unit& u, int wr, int wc, int fr, int fq) const {
        const int cl = u.xa >> 16, cnt = tb->cnt[cl], slot = u.pn >> 2; const int col0 = slot * 512 + (u.pn & 3) * 128 + wc * 32 + 8 * fq;
#pragma unroll
        for (int ai = 0; ai < 2; ++ai)
#pragma unroll
            for (int m = 0; m < 4; ++m) { const int r = ai * 128 + wr * 64 + m * 16 + fr, rr = u.xb + r; const float w = rr < cnt ? LW[((size_t)cl * LISTCAP + rr) * 2 + slot] : 0.f;
                const f32x4 g0 = acc[ai][0][m][0], g1 = acc[ai][0][m][1], u0 = acc[ai][1][m][0], u1 = acc[ai][1][m][1];
                u32x4 o; o.x = pg8::cvt_pk_bf16(w * silu_f(g0[0]) * u0[0], w * silu_f(g0[1]) * u0[1]); o.y = pg8::cvt_pk_bf16(w * silu_f(g0[2]) * u0[2], w * silu_f(g0[3]) * u0[3]);
                o.z = pg8::cvt_pk_bf16(w * silu_f(g1[0]) * u1[0], w * silu_f(g1[1]) * u1[1]); o.w = pg8::cvt_pk_bf16(w * silu_f(g1[2]) * u1[2], w * silu_f(g1[3]) * u1[3]);
                *(u32x4*)(HB + (size_t)(u.pm * 256 + r) * DM + col0) = o; }
    }
};
struct ProbMoe2 {
    static constexpr bool GATHER = false;
    const bf16* HB; const bf16* WD; const LAS MoeTab* tb; int G, c;
    __device__ __forceinline__ bool next(int i, pg8::Unit& u) const { if (!pg8::order_next(i, G, c, tb->ntiles, 4, u)) return false;
        const int cl = tb->cls[u.pm]; int elo, ehi; class_experts(cl, elo, ehi); u.xa = elo | (ehi << 8) | (cl << 16); u.xb = tb->row0[u.pm]; return true; }
    __device__ __forceinline__ int ktiles() const { return 16; }
    __device__ __forceinline__ unsigned ldb_bytes() const { return 1024u; }
    __device__ __forceinline__ unsigned a_voff_dense(int R, int Cc) const { return ((unsigned)R * 1024u + (unsigned)Cc) * 2u; }
    __device__ __forceinline__ const char* a_half(const pg8::Unit& u, int h) const { return (const char*)HB + (size_t)(u.pm * 256 + h * 128) * 2048; }
    __device__ __forceinline__ const char* a_base() const { return (const char*)HB; }
    __device__ __forceinline__ unsigned a_voff(const pg8::Unit&, int, int, int) const { return 0u; }
    __device__ __forceinline__ const char* b_tile(const pg8::Unit& u, int kt) const { const int e = (kt < 8) ? (u.xa & 255) : ((u.xa >> 8) & 255);
        return (const char*)WD + ((size_t)e * 524288 + (size_t)u.pn * 131072 + (size_t)(kt & 7) * 64) * 2; }
};
struct EpiMoe2 {
    const bf16* H1; bf16* R2; const int* LIST; const LAS MoeTab* tb;
    __device__ __forceinline__ void operator()(const f32x4 (&acc)[2][2][4][2], const pg8::Unit& u, int wr, int wc, int fr, int fq) const {
        const int cl = u.xa >> 16, cnt = tb->cnt[cl]; const int col0 = u.pn * 256 + wc * 32 + 8 * fq;
#pragma unroll
        for (int ai = 0; ai < 2; ++ai)
#pragma unroll
            for (int m = 0; m < 4; ++m) { const int r = ai * 128 + wr * 64 + m * 16 + fr, rr = u.xb + r; if (rr >= cnt) continue;
                const size_t off = (size_t)LIST[cl * LISTCAP + rr] * DM + col0;
#pragma unroll
                for (int bj = 0; bj < 2; ++bj) { const f32x4 v0 = acc[ai][bj][m][0], v1 = acc[ai][bj][m][1]; const u32x4 xv = *(const u32x4*)(H1 + off + bj * 128);
                    u32x4 w; w.x = pg8::cvt_pk_bf16(ALPHA * bflo(xv.x) + v0[0], ALPHA * bfhi(xv.x) + v0[1]); w.y = pg8::cvt_pk_bf16(ALPHA * bflo(xv.y) + v0[2], ALPHA * bfhi(xv.y) + v0[3]);
                    w.z = pg8::cvt_pk_bf16(ALPHA * bflo(xv.z) + v1[0], ALPHA * bfhi(xv.z) + v1[1]); w.w = pg8::cvt_pk_bf16(ALPHA * bflo(xv.w) + v1[2], ALPHA * bfhi(xv.w) + v1[3]);
                    *(u32x4*)(R2 + off + bj * 128) = w; } }
    }
};

__device__ __forceinline__ void phase_poolwin_simple(const Ctx& C) {
    const int gt = C.bid * NTHREADS + C.tid, NGT = C.G * NTHREADS;
    for (int task = gt; task < NTOK * 64; task += NGT) {
        const int tok = task >> 6, c8 = (task & 63) * 8, g = c8 >> 7, w = 2 << g, t = tok & (SEQ - 1);
        float s[8], u0[8];
#pragma unroll
        for (int i = 0; i < 8; ++i) s[i] = 0.f;
        for (int d = 0; d < w; ++d) { if (t - d < 0) break; float f[8]; unpack8(*(const u32x4*)(C.PROJ() + (size_t)(tok - d) * NPROJ + PC_U + c8), f);
#pragma unroll
            for (int i = 0; i < 8; ++i) { s[i] += f[i]; if (d == 0) u0[i] = f[i]; } }
        const float inv = 1.0f / (float)((t + 1) < w ? (t + 1) : w);
        u32x4 o; o.x = pk2(s[0] * inv - u0[0], s[1] * inv - u0[1]); o.y = pk2(s[2] * inv - u0[2], s[3] * inv - u0[3]); o.z = pk2(s[4] * inv - u0[4], s[5] * inv - u0[5]); o.w = pk2(s[6] * inv - u0[6], s[7] * inv - u0[7]);
        *(u32x4*)(C.PWIN() + (size_t)tok * 512 + c8) = o;
    }
}
__device__ __forceinline__ void phase_conv_simple(const Ctx& C) {
    const int gt = C.bid * NTHREADS + C.tid, NGT = C.G * NTHREADS;
    for (int task = gt; task < NTOK * 128; task += NGT) {
        const int tok = task >> 7, c8 = (task & 127) * 8, t = tok & (SEQ - 1);
        float a[8];
        { const f32x4 b0 = *(const f32x4*)(C.conv_b() + c8), b1 = *(const f32x4*)(C.conv_b() + c8 + 4); a[0] = b0.x; a[1] = b0.y; a[2] = b0.z; a[3] = b0.w; a[4] = b1.x; a[5] = b1.y; a[6] = b1.z; a[7] = b1.w; }
#pragma unroll
        for (int k = 0; k < 4; ++k) { const int d = 3 - k; if (t - d < 0) continue; float f[8]; unpack8(*(const u32x4*)(C.PROJ() + (size_t)(tok - d) * NPROJ + PC_X + c8), f);
            const f32x4 w0 = *(const f32x4*)(C.conv_w() + k * 1024 + c8), w1 = *(const f32x4*)(C.conv_w() + k * 1024 + c8 + 4);
            a[0] += w0.x * f[0]; a[1] += w0.y * f[1]; a[2] += w0.z * f[2]; a[3] += w0.w * f[3]; a[4] += w1.x * f[4]; a[5] += w1.y * f[5]; a[6] += w1.z * f[6]; a[7] += w1.w * f[7]; }
        u32x4 o; o.x = pk2(silu_f(a[0]), silu_f(a[1])); o.y = pk2(silu_f(a[2]), silu_f(a[3])); o.z = pk2(silu_f(a[4]), silu_f(a[5])); o.w = pk2(silu_f(a[6]), silu_f(a[7]));
        *(u32x4*)(C.XBCC() + (size_t)tok * 1024 + c8) = o;
    }
}
__device__ __forceinline__ void phase_dt_simple(const Ctx& C) {
    const int gt = C.bid * NTHREADS + C.tid;
    if (gt < NBATCH * NCHUNK * NHEAD) {
        const int h = gt & 7, bc = gt >> 3; const float bias = C.dt_bias()[h], A = -__expf(C.a_log()[h]); float acc = 0.f;
        for (int l = 0; l < CHUNK; ++l) { const size_t idx = (size_t)(bc * CHUNK + l) * 8 + h; const float v = C.DTRAW()[idx] + bias; const float dt = v > 20.f ? v : log1pf(__expf(v));
            acc += dt * A; C.DTV()[idx] = dt; C.ACL()[idx] = acc; }
        C.CHD()[gt] = __expf(acc);
    }
}
__device__ __forceinline__ void phase_states_simple(const Ctx& C) {
    LAS float* wl = (LAS float*)C.lds;
    for (int item = C.bid; item < NBATCH * NCHUNK * NHEAD; item += C.G) {
        const int h = item & 7, bc = item >> 3, g = h >> 2, tok0 = bc * CHUNK;
        __syncthreads();
        if (C.tid < CHUNK) { const float last = C.ACL()[(size_t)(tok0 + CHUNK - 1) * 8 + h]; const size_t idx = (size_t)(tok0 + C.tid) * 8 + h; wl[C.tid] = C.DTV()[idx] * __expf(last - C.ACL()[idx]); }
        __syncthreads();
        const int p = C.tid >> 3, n0 = (C.tid & 7) * 16;
        float acc[16];
#pragma unroll
        for (int i = 0; i < 16; ++i) acc[i] = 0.f;
        for (int l = 0; l < CHUNK; ++l) { const bf16* row = C.XBCC() + (size_t)(tok0 + l) * 1024; const float xv = bf2f(row[h * 64 + p]) * wl[l];
            float f[8]; unpack8(*(const u32x4*)(row + 512 + g * 128 + n0), f);
#pragma unroll
            for (int i = 0; i < 8; ++i) acc[i] += xv * f[i];
            unpack8(*(const u32x4*)(row + 512 + g * 128 + n0 + 8), f);
#pragma unroll
            for (int i = 0; i < 8; ++i) acc[8 + i] += xv * f[i]; }
        float* o = C.STATES() + (size_t)item * 8192 + p * 128 + n0;
#pragma unroll
        for (int i = 0; i < 4; ++i) *(f32x4*)(o + 4 * i) = (f32x4){acc[4 * i], acc[4 * i + 1], acc[4 * i + 2], acc[4 * i + 3]};
    }
}
__device__ __forceinline__ void phase_scan(const Ctx& C) {
    const int gt = C.bid * NTHREADS + C.tid, NGT = C.G * NTHREADS;
    for (int task = gt; task < NBATCH * NHEAD * 2048; task += NGT) {
        const int e4 = task & 2047, bh = task >> 11, b = bh >> 3, h = bh & 7;
        f32x4 run = (f32x4){0.f, 0.f, 0.f, 0.f};
        f32x4 st[NCHUNK]; float dec[NCHUNK];
#pragma unroll
        for (int c = 0; c < NCHUNK; ++c) { const size_t item = (size_t)((b * NCHUNK + c) * 8 + h); st[c] = *(const f32x4*)(C.STATES() + item * 8192 + e4 * 4); dec[c] = C.CHD()[item]; }
#pragma unroll
        for (int c = 0; c < NCHUNK; ++c) { const size_t item = (size_t)((b * NCHUNK + c) * 8 + h);
            u32x2 o; o.x = pk2(run.x, run.y); o.y = pk2(run.z, run.w); *(u32x2*)(C.PREV() + item * 8192 + e4 * 4) = o;
            run = run * dec[c] + st[c]; }
    }
}
__device__ __forceinline__ void phase_y_simple(const Ctx& C) {
    LAS float* S = (LAS float*)C.lds;
    LAS float* acl = S + 128 * 129;
    LAS float* dtl = acl + 512;
    for (int item = C.bid; item < NBATCH * NCHUNK * 2; item += C.G) {
        const int g = item & 1, bc = item >> 1, tok0 = bc * CHUNK;
        __syncthreads();
        { const int l = C.tid & 127, j = C.tid >> 7; const size_t idx = (size_t)(tok0 + l) * 8 + g * 4 + j; acl[j * 128 + l] = C.ACL()[idx]; dtl[j * 128 + l] = C.DTV()[idx]; }
        { const int l = C.tid >> 2, s0 = (C.tid & 3) * 32; const bf16* crow = C.XBCC() + (size_t)(tok0 + l) * 1024 + 768 + g * 128;
            for (int s = s0; s < s0 + 32; ++s) { float a = 0.f;
                if (s <= l) { const bf16* brow = C.XBCC() + (size_t)(tok0 + s) * 1024 + 512 + g * 128;
                    for (int n = 0; n < 128; n += 8) { float cf[8], bf[8]; unpack8(*(const u32x4*)(crow + n), cf); unpack8(*(const u32x4*)(brow + n), bf);
#pragma unroll
                        for (int i = 0; i < 8; ++i) a += cf[i] * bf[i]; } }
                S[l * 129 + s] = a; } }
        __syncthreads();
        for (int tk = C.tid; tk < 128 * 4 * 8; tk += NTHREADS) {
            const int pc = tk & 7, j = (tk >> 3) & 3, l = tk >> 5, h = g * 4 + j, ch = h * 64 + pc * 8;
            float y[8];
#pragma unroll
            for (int i = 0; i < 8; ++i) y[i] = 0.f;
            const float al = acl[j * 128 + l];
            for (int s = 0; s <= l; ++s) { const float gsc = S[l * 129 + s] * __expf(al - acl[j * 128 + s]) * dtl[j * 128 + s];
                float f[8]; unpack8(*(const u32x4*)(C.XBCC() + (size_t)(tok0 + s) * 1024 + ch), f);
#pragma unroll
                for (int i = 0; i < 8; ++i) y[i] += gsc * f[i]; }
            const float el = __expf(al); const bf16* crow = C.XBCC() + (size_t)(tok0 + l) * 1024 + 768 + g * 128;
            const bf16* pv = C.PREV() + (size_t)(bc * 8 + h) * 8192 + (size_t)(pc * 8) * 128;
            for (int n = 0; n < 128; n += 8) { float cf[8]; unpack8(*(const u32x4*)(crow + n), cf);
#pragma unroll
                for (int i = 0; i < 8; ++i) { float pf[8]; unpack8(*(const u32x4*)(pv + i * 128 + n), pf); float a = 0.f;
#pragma unroll
                    for (int q = 0; q < 8; ++q) a += cf[q] * pf[q];
                    y[i] += el * a; } }
            float xf[8], zf[8]; unpack8(*(const u32x4*)(C.XBCC() + (size_t)(tok0 + l) * 1024 + ch), xf); unpack8(*(const u32x4*)(C.PROJ() + (size_t)(tok0 + l) * NPROJ + PC_Z + ch), zf);
            const float dsk = C.d_skip()[h];
            float* o = C.YG() + (size_t)(tok0 + l) * 512 + ch;
            f32x4 o0, o1;
            o0.x = (y[0] + dsk * xf[0]) * silu_f(zf[0]); o0.y = (y[1] + dsk * xf[1]) * silu_f(zf[1]); o0.z = (y[2] + dsk * xf[2]) * silu_f(zf[2]); o0.w = (y[3] + dsk * xf[3]) * silu_f(zf[3]);
            o1.x = (y[4] + dsk * xf[4]) * silu_f(zf[4]); o1.y = (y[5] + dsk * xf[5]) * silu_f(zf[5]); o1.z = (y[6] + dsk * xf[6]) * silu_f(zf[6]); o1.w = (y[7] + dsk * xf[7]) * silu_f(zf[7]);
            *(f32x4*)o = o0; *(f32x4*)(o + 4) = o1;
        }
    }
}
__device__ __forceinline__ void phase_rms_simple(const Ctx& C) {
    const int gw = C.bid * NWAVES + C.wave, NGW = C.G * NWAVES;
    for (int task = gw; task < NTOK * 2; task += NGW) {
        const int tok = task >> 1, g = task & 1; const f32x4 v = *(const f32x4*)(C.YG() + (size_t)tok * 512 + g * 256 + 4 * C.lane);
        const float ss = wave_sum((v.x * v.x + v.y * v.y) + (v.z * v.z + v.w * v.w)); const float r = 1.0f / sqrtf(ss * (1.f / 256.f) + RMS_EPS);
        const f32x4 ng = *(const f32x4*)(C.ssm_norm_g() + g * 256 + 4 * C.lane);
        u32x2 o; o.x = pk2(v.x * r * ng.x, v.y * r * ng.y); o.y = pk2(v.z * r * ng.z, v.w * r * ng.w);
        *(u32x2*)(C.YMIX() + (size_t)tok * DM + g * 256 + 4 * C.lane) = o;
    }
}

typedef short bf16x8v __attribute__((ext_vector_type(8)));
typedef short bf16x4v __attribute__((ext_vector_type(4)));
#define MFMA16(a, b, c) __builtin_amdgcn_mfma_f32_16x16x32_bf16((a), (b), (c), 0, 0, 0)
__device__ __forceinline__ int swz(int row, int q) { return row * 256 + ((q ^ (row & 15)) << 4); }

struct ConvIn { u32x4 raw[11]; f32x4 w[4][2]; f32x4 b[2]; };
__device__ __forceinline__ void conv_load(const Ctx& C, ConvIn& ci, int tokb, int ch8, bool zero3) {
    const bf16* base = C.PROJ() + (size_t)tokb * NPROJ + PC_X + ch8;
#pragma unroll
    for (int r = 0; r < 11; ++r) { if (r < 3 && zero3) ci.raw[r] = (u32x4){0u, 0u, 0u, 0u}; else ci.raw[r] = *(const u32x4*)(base + (ptrdiff_t)(r - 3) * NPROJ); }
#pragma unroll
    for (int k = 0; k < 4; ++k) { ci.w[k][0] = *(const f32x4*)(C.conv_w() + k * 1024 + ch8); ci.w[k][1] = *(const f32x4*)(C.conv_w() + k * 1024 + ch8 + 4); }
    ci.b[0] = *(const f32x4*)(C.conv_b() + ch8); ci.b[1] = *(const f32x4*)(C.conv_b() + ch8 + 4);
}
template <int TT, int CC> __device__ __forceinline__ float conv_out(const ConvIn& ci) {
    float v = ci.b[CC >> 2][CC & 3];
#pragma unroll
    for (int k = 0; k < 4; ++k) { const unsigned wd = ci.raw[TT + k][CC >> 1]; const float xv = (CC & 1) ? bfhi(wd) : bflo(wd); v += ci.w[k][CC >> 2][CC & 3] * xv; }
    return silu_f(v);
}
__device__ __forceinline__ void conv_store_nat(const ConvIn& ci, LAS unsigned char* tile, int tl0, int qc) {
#define CS_ROW(TT) { u32x4 o; o.x = pk2(conv_out<TT, 0>(ci), conv_out<TT, 1>(ci)); o.y = pk2(conv_out<TT, 2>(ci), conv_out<TT, 3>(ci)); o.z = pk2(conv_out<TT, 4>(ci), conv_out<TT, 5>(ci)); o.w = pk2(conv_out<TT, 6>(ci), conv_out<TT, 7>(ci)); \
        *(LAS u32x4*)(tile + swz(tl0 + TT, qc)) = o; }
    CS_ROW(0) CS_ROW(1) CS_ROW(2) CS_ROW(3) CS_ROW(4) CS_ROW(5) CS_ROW(6) CS_ROW(7)
#undef CS_ROW
}
template <bool SCALE> __device__ __forceinline__ void conv_store_tr(const ConvIn& ci, LAS unsigned char* tile, int row0, int qt, const float (&sc)[8]) {
#define CS_COL(CC) { float v0 = conv_out<0, CC>(ci), v1 = conv_out<1, CC>(ci), v2 = conv_out<2, CC>(ci), v3 = conv_out<3, CC>(ci), v4 = conv_out<4, CC>(ci), v5 = conv_out<5, CC>(ci), v6 = conv_out<6, CC>(ci), v7 = conv_out<7, CC>(ci); \
        if (SCALE) { v0 *= sc[0]; v1 *= sc[1]; v2 *= sc[2]; v3 *= sc[3]; v4 *= sc[4]; v5 *= sc[5]; v6 *= sc[6]; v7 *= sc[7]; } \
        u32x4 o; o.x = pk2(v0, v1); o.y = pk2(v2, v3); o.z = pk2(v4, v5); o.w = pk2(v6, v7); *(LAS u32x4*)(tile + swz(row0 + CC, qt)) = o; }
    CS_COL(0) CS_COL(1) CS_COL(2) CS_COL(3) CS_COL(4) CS_COL(5) CS_COL(6) CS_COL(7)
#undef CS_COL
}
__device__ __forceinline__ float dt_scan(const Ctx& C, int tok0, int h, int lane, float& dt0, float& dt1, float& ac0, float& ac1) {
    const float bias = C.dt_bias()[h], A = -__expf(C.a_log()[h]);
    const float r0 = C.DTRAW()[(size_t)(tok0 + 2 * lane) * 8 + h] + bias, r1 = C.DTRAW()[(size_t)(tok0 + 2 * lane + 1) * 8 + h] + bias;
    dt0 = r0 > 20.f ? r0 : log1pf(__expf(r0)); dt1 = r1 > 20.f ? r1 : log1pf(__expf(r1));
    const float a0 = dt0 * A, a1 = dt1 * A; float x = a0 + a1;
#pragma unroll
    for (int o = 1; o < 64; o <<= 1) { const float v = __shfl_up(x, o); if (lane >= o) x += v; }
    ac1 = x; ac0 = x - a1;
    return __shfl(x, 63);
}

constexpr int SSD_XT = 0, SSD_BM = 65536, SSD_CM = 98304, SSD_TAB = 131072;

__device__ __forceinline__ void phase_states_fast(const Ctx& C) {
    LAS unsigned char* XT = C.lds + SSD_XT;
    LAS unsigned char* BT = C.lds + SSD_BM;
    LAS float* wtab = (LAS float*)(C.lds + SSD_TAB);
    const int lane_in = C.lane, w = C.wave;
    for (int item = C.bid; item < NBATCH * NCHUNK * 2; item += C.G) {
        const int g = item & 1, bc = item >> 1, tok0 = bc * CHUNK; const bool seq0 = (bc & (NCHUNK - 1)) == 0;
        int lane = lane_in; asm volatile("" : "+v"(lane));
        const int fr = lane & 15, fq = lane >> 4;
        __syncthreads();
        if (w < 4) { float d0, d1, a0, a1; const int h = g * 4 + w; const float tot = dt_scan(C, tok0, h, lane, d0, d1, a0, a1);
            wtab[w * 128 + 2 * lane] = d0 * __expf(tot - a0); wtab[w * 128 + 2 * lane + 1] = d1 * __expf(tot - a1);
            if (lane == 0) C.CHD()[bc * 8 + h] = __expf(tot); }
        __syncthreads();
        for (int q = C.tid; q < 768; q += NTHREADS) {
            const int tg = q / 48, cgp = q % 48; ConvIn ci;
            if (cgp < 32) { const int ch8 = g * 256 + cgp * 8; conv_load(C, ci, tok0 + tg * 8, ch8, seq0 && tg == 0);
                float sc[8]; const int j = cgp >> 3;
#pragma unroll
                for (int i = 0; i < 8; ++i) sc[i] = wtab[j * 128 + tg * 8 + i];
                conv_store_tr<true>(ci, XT, cgp * 8, tg, sc);
            } else { const int nb = (cgp - 32) * 8, ch8 = 512 + g * 128 + nb; conv_load(C, ci, tok0 + tg * 8, ch8, seq0 && tg == 0);
                float sc[8];
#pragma unroll
                for (int i = 0; i < 8; ++i) sc[i] = 1.f;
                conv_store_tr<false>(ci, BT, nb, tg, sc); }
        }
        __syncthreads();
        f32x4 acc[8][2];
#pragma unroll
        for (int a = 0; a < 8; ++a) { acc[a][0] = (f32x4){0.f, 0.f, 0.f, 0.f}; acc[a][1] = (f32x4){0.f, 0.f, 0.f, 0.f}; }
#pragma unroll
        for (int ks = 0; ks < 4; ++ks) {
            const bf16x8v b0 = *(const LAS bf16x8v*)(XT + swz(32 * w + fr, 4 * ks + fq)), b1 = *(const LAS bf16x8v*)(XT + swz(32 * w + 16 + fr, 4 * ks + fq));
#pragma unroll
            for (int a = 0; a < 8; ++a) { const bf16x8v af = *(const LAS bf16x8v*)(BT + swz(16 * a + fr, 4 * ks + fq));
                acc[a][0] = MFMA16(af, b0, acc[a][0]); acc[a][1] = MFMA16(af, b1, acc[a][1]); }
        }
        float* st = C.STATES() + ((size_t)bc * 8 + g * 4) * 8192;
#pragma unroll
        for (int t = 0; t < 2; ++t) { const int ch = 32 * w + 16 * t + fr;
#pragma unroll
            for (int a = 0; a < 8; ++a) *(f32x4*)(st + (size_t)ch * 128 + 16 * a + 4 * fq) = acc[a][t]; }
    }
}

__device__ __forceinline__ void phase_y_fast(const Ctx& C) {
    LAS unsigned char* XT = C.lds + SSD_XT;
    LAS unsigned char* BM = C.lds + SSD_BM;
    LAS unsigned char* CM = C.lds + SSD_CM;
    LAS unsigned char* PV = C.lds + SSD_BM;
    LAS float* acl = (LAS float*)(C.lds + SSD_TAB);
    LAS float* dtl = acl + 512;
    const int lane_in = C.lane, w = C.wave;
    for (int item = C.bid; item < NBATCH * NCHUNK * 2; item += C.G) {
        const int g = item & 1, bc = item >> 1, tok0 = bc * CHUNK; const bool seq0 = (bc & (NCHUNK - 1)) == 0;
        int lane = lane_in; asm volatile("" : "+v"(lane));
        const int fr = lane & 15, fq = lane >> 4;
        u32x4 pv[8];
        { const u32x4* src = (const u32x4*)(C.PREV() + ((size_t)bc * 8 + g * 4) * 8192);
#pragma unroll
            for (int i = 0; i < 8; ++i) pv[i] = src[C.tid + NTHREADS * i]; }
        __syncthreads();
        if (w < 4) { float d0, d1, a0, a1; (void)dt_scan(C, tok0, g * 4 + w, lane, d0, d1, a0, a1);
            acl[w * 128 + 2 * lane] = a0; acl[w * 128 + 2 * lane + 1] = a1; dtl[w * 128 + 2 * lane] = d0; dtl[w * 128 + 2 * lane + 1] = d1; }
        for (int q = C.tid; q < 1024; q += NTHREADS) {
            const int tg = q >> 6, cgp = q & 63; ConvIn ci; float sc[8];
#pragma unroll
            for (int i = 0; i < 8; ++i) sc[i] = 1.f;
            if (cgp < 32) { conv_load(C, ci, tok0 + tg * 8, g * 256 + cgp * 8, seq0 && tg == 0); conv_store_tr<false>(ci, XT, cgp * 8, tg, sc); }
            else if (cgp < 48) { conv_load(C, ci, tok0 + tg * 8, 512 + g * 128 + (cgp - 32) * 8, seq0 && tg == 0); conv_store_nat(ci, BM, tg * 8, cgp - 32); }
            else { conv_load(C, ci, tok0 + tg * 8, 768 + g * 128 + (cgp - 48) * 8, seq0 && tg == 0); conv_store_nat(ci, CM, tg * 8, cgp - 48); }
        }
        __syncthreads();
        bf16x8v cf[4];
#pragma unroll
        for (int ks = 0; ks < 4; ++ks) cf[ks] = *(const LAS bf16x8v*)(CM + swz(16 * w + fr, 4 * ks + fq));
        f32x4 S[8];
#pragma unroll
        for (int st = 0; st < 8; ++st) { S[st] = (f32x4){0.f, 0.f, 0.f, 0.f};
            if (st <= w) {
#pragma unroll
                for (int ks = 0; ks < 4; ++ks) { const bf16x8v af = *(const LAS bf16x8v*)(BM + swz(16 * st + fr, 4 * ks + fq)); S[st] = MFMA16(af, cf[ks], S[st]); } } }
        __syncthreads();
#pragma unroll
        for (int i = 0; i < 8; ++i) { const int idx = C.tid + NTHREADS * i; *(LAS u32x4*)(PV + swz(idx >> 4, idx & 15)) = pv[i]; }
        __syncthreads();
        const int l = 16 * w + fr;
        f32x4 Y[4][4];
#pragma unroll
        for (int j = 0; j < 4; ++j) {
            const float al = acl[j * 128 + l], el = __expf(al), dsk = C.d_skip()[g * 4 + j];
#pragma unroll
            for (int pt = 0; pt < 4; ++pt) { f32x4 y = (f32x4){0.f, 0.f, 0.f, 0.f};
#pragma unroll
                for (int ks = 0; ks < 4; ++ks) { const bf16x8v af = *(const LAS bf16x8v*)(PV + swz(j * 64 + 16 * pt + fr, 4 * ks + fq)); y = MFMA16(af, cf[ks], y); }
                Y[j][pt] = y * el; }
#pragma unroll
            for (int blk = 0; blk < 4; ++blk) {
                if (2 * blk <= w) {
                    const int s0 = 32 * blk + 4 * fq;
                    const f32x4 as0 = *(const LAS f32x4*)(acl + j * 128 + s0), as1 = *(const LAS f32x4*)(acl + j * 128 + s0 + 16);
                    const f32x4 ds0 = *(const LAS f32x4*)(dtl + j * 128 + s0), ds1 = *(const LAS f32x4*)(dtl + j * 128 + s0 + 16);
                    float gv[8];
#pragma unroll
                    for (int i = 0; i < 4; ++i) { const int sa = s0 + i, sb = s0 + 16 + i;
                        float fa = sa <= l ? S[2 * blk][i] * __expf(al - as0[i]) * ds0[i] : 0.f; if (sa == l) fa += dsk;
                        float fb = sb <= l ? S[2 * blk + 1][i] * __expf(al - as1[i]) * ds1[i] : 0.f; if (sb == l) fb += dsk;
                        gv[i] = fa; gv[4 + i] = fb; }
                    u32x4 gp; gp.x = pk2(gv[0], gv[1]); gp.y = pk2(gv[2], gv[3]); gp.z = pk2(gv[4], gv[5]); gp.w = pk2(gv[6], gv[7]);
                    const bf16x8v gf = __builtin_bit_cast(bf16x8v, gp);
#pragma unroll
                    for (int pt = 0; pt < 4; ++pt) { const int row = j * 64 + 16 * pt + fr;
                        const u32x2 x0 = *(const LAS u32x2*)(XT + swz(row, 4 * blk + (fq >> 1)) + (fq & 1) * 8), x1 = *(const LAS u32x2*)(XT + swz(row, 4 * blk + 2 + (fq >> 1)) + (fq & 1) * 8);
                        u32x4 xa; xa.x = x0.x; xa.y = x0.y; xa.z = x1.x; xa.w = x1.y;
                        Y[j][pt] = MFMA16(__builtin_bit_cast(bf16x8v, xa), gf, Y[j][pt]); }
                }
            }
        }
        u32x2 zz[4][4];
        { const bf16* zrow = C.PROJ() + (size_t)(tok0 + l) * NPROJ + PC_Z + g * 256 + 4 * fq;
#pragma unroll
            for (int j = 0; j < 4; ++j)
#pragma unroll
                for (int pt = 0; pt < 4; ++pt) zz[j][pt] = *(const u32x2*)(zrow + j * 64 + 16 * pt); }
        float ss = 0.f;
#pragma unroll
        for (int j = 0; j < 4; ++j)
#pragma unroll
            for (int pt = 0; pt < 4; ++pt) { const u32x2 zv = zz[j][pt]; f32x4 y = Y[j][pt];
                y[0] *= silu_f(bflo(zv.x)); y[1] *= silu_f(bfhi(zv.x)); y[2] *= silu_f(bflo(zv.y)); y[3] *= silu_f(bfhi(zv.y));
                ss += (y[0] * y[0] + y[1] * y[1]) + (y[2] * y[2] + y[3] * y[3]); Y[j][pt] = y; }
        ss += __shfl_xor(ss, 16); ss += __shfl_xor(ss, 32);
        const float rinv = 1.0f / sqrtf(ss * (1.f / 256.f) + RMS_EPS);
        bf16* orow = C.YMIX() + (size_t)(tok0 + l) * DM + g * 256 + 4 * fq; const float* ng = C.ssm_norm_g() + g * 256 + 4 * fq;
        asm volatile("" : "+v"(ng));
#pragma unroll
        for (int j = 0; j < 4; ++j)
#pragma unroll
            for (int pt = 0; pt < 4; ++pt) { const f32x4 nv = *(const f32x4*)(ng + j * 64 + 16 * pt); const f32x4 y = Y[j][pt];
                u32x2 o; o.x = pk2(y[0] * rinv * nv[0], y[1] * rinv * nv[1]); o.y = pk2(y[2] * rinv * nv[2], y[3] * rinv * nv[3]);
                *(u32x2*)(orow + j * 64 + 16 * pt) = o; }
    }
}

__device__ __forceinline__ void phase_pool_fast(const Ctx& C) {
    LAS unsigned char* PM = C.lds;
    LAS unsigned char* WT = C.lds + 32768;
    const int lane = C.lane, w = C.wave, fr = lane & 15, fq = lane >> 4;
    const int g = C.bid & 3, win = 2 << g;
    { const u32x4* src = (const u32x4*)(C.WPOOL() + (size_t)g * 16384);
#pragma unroll
        for (int i = 0; i < 4; ++i) { const int idx = C.tid + NTHREADS * i; *(LAS u32x4*)(WT + swz(idx >> 4, idx & 15)) = src[idx]; } }
    for (int tile = C.bid >> 2; tile < NTOK / 128; tile += (C.G >> 2)) {
        const int tok0 = tile * 128;
        __syncthreads();
        if (C.tid < 256) { const int tg = C.tid >> 4, cq = C.tid & 15; const int tokb = tok0 + tg * 8, tpos = tokb & (SEQ - 1);
            const bf16* up = C.PROJ() + (size_t)tokb * NPROJ + PC_U + g * 128 + cq * 8;
            float s[8];
#pragma unroll
            for (int i = 0; i < 8; ++i) s[i] = 0.f;
            for (int d = 1; d < win; ++d) { if (tpos - d < 0) break; float f[8]; unpack8(*(const u32x4*)(up - (ptrdiff_t)d * NPROJ), f);
#pragma unroll
                for (int i = 0; i < 8; ++i) s[i] += f[i]; }
#pragma unroll
            for (int tt = 0; tt < 8; ++tt) { float f[8]; unpack8(*(const u32x4*)(up + (size_t)tt * NPROJ), f);
                const int t = tpos + tt; const float inv = 1.0f / (float)((t + 1) < win ? (t + 1) : win);
                float o[8];
#pragma unroll
                for (int i = 0; i < 8; ++i) { s[i] += f[i]; o[i] = s[i] * inv - f[i]; }
                u32x4 ov; ov.x = pk2(o[0], o[1]); ov.y = pk2(o[2], o[3]); ov.z = pk2(o[4], o[5]); ov.w = pk2(o[6], o[7]);
                *(LAS u32x4*)(PM + swz(tg * 8 + tt, cq)) = ov;
                if (t - (win - 1) >= 0) { float r[8]; unpack8(*(const u32x4*)(up + ((ptrdiff_t)tt - (win - 1)) * NPROJ), r);
#pragma unroll
                    for (int i = 0; i < 8; ++i) s[i] -= r[i]; } }
        }
        __syncthreads();
        f32x4 acc[8];
#pragma unroll
        for (int a = 0; a < 8; ++a) acc[a] = (f32x4){0.f, 0.f, 0.f, 0.f};
#pragma unroll
        for (int ks = 0; ks < 4; ++ks) { const bf16x8v bfr = *(const LAS bf16x8v*)(PM + swz(16 * w + fr, 4 * ks + fq));
#pragma unroll
            for (int a = 0; a < 8; ++a) { const bf16x8v af = *(const LAS bf16x8v*)(WT + swz(16 * a + fr, 4 * ks + fq)); acc[a] = MFMA16(af, bfr, acc[a]); } }
        bf16* orow = C.YMIX() + (size_t)(tok0 + 16 * w + fr) * DM + 512 + g * 128 + 4 * fq; const float* bp = C.b_pool() + g * 128 + 4 * fq; const float* sp = C.pool_scale() + g * 128 + 4 * fq;
#pragma unroll
        for (int a = 0; a < 8; ++a) { const f32x4 b = *(const f32x4*)(bp + 16 * a), sc = *(const f32x4*)(sp + 16 * a); const f32x4 v = acc[a];
            u32x2 o; o.x = pk2((v[0] + b[0]) * sc[0], (v[1] + b[1]) * sc[1]); o.y = pk2((v[2] + b[2]) * sc[2], (v[3] + b[3]) * sc[3]);
            *(u32x2*)(orow + 16 * a) = o; }
    }
}

__device__ __forceinline__ void phase_ln1_router(const Ctx& C) {
    LAS float* wr = (LAS float*)C.lds;
    LAS int* rcls = (LAS int*)(C.lds + 20 * 4096);
    LAS float* rw = (LAS float*)(C.lds + 20 * 4096 + 512);
    LAS int* rpos = (LAS int*)(C.lds + 20 * 4096 + 512 + 1024);
    LAS int* lcnt = (LAS int*)(C.lds + 20 * 4096 + 512 + 1024 + 512);
    LAS int* lbase = lcnt + 32;
    for (int i = C.tid; i < 1024 * 4; i += NTHREADS) { const int k = i >> 2, n = i & 3; wr[n * 1024 + k] = C.w_rg()[i]; }
    for (int i = C.tid; i < 1024 * 16; i += NTHREADS) { const int k = i >> 4, n = i & 15; wr[(4 + n) * 1024 + k] = C.w_re()[i]; }
    f32x4 gg[4], bb[4];
#pragma unroll
    for (int j = 0; j < 4; ++j) { gg[j] = *(const f32x4*)(C.ln1_g() + 4 * C.lane + 256 * j); bb[j] = *(const f32x4*)(C.ln1_b() + 4 * C.lane + 256 * j); }
    float brg[4], bre[16];
#pragma unroll
    for (int i = 0; i < 4; ++i) brg[i] = C.b_rg()[i];
#pragma unroll
    for (int i = 0; i < 16; ++i) bre[i] = C.b_re()[i];
    for (int rb = C.bid; rb < NTOK / 128; rb += C.G) {
        __syncthreads();
        if (C.tid < 32) lcnt[C.tid] = 0;
        for (int rr = 0; rr < 16; ++rr) {
            const int r = C.wave * 16 + rr, m = rb * 128 + r;
            const u32x2* xr = (const u32x2*)(C.R1() + (size_t)m * DM) + C.lane;
            f32x4 v[4]; float s = 0.f;
#pragma unroll
            for (int j = 0; j < 4; ++j) { const u32x2 w = xr[64 * j]; v[j] = (f32x4){bflo(w.x), bfhi(w.x), bflo(w.y), bfhi(w.y)}; s += (v[j].x + v[j].y) + (v[j].z + v[j].w); }
            const float mean = wave_sum(s) * (1.f / DM); float s2 = 0.f;
#pragma unroll
            for (int j = 0; j < 4; ++j) { v[j] = v[j] - mean; s2 += (v[j].x * v[j].x + v[j].y * v[j].y) + (v[j].z * v[j].z + v[j].w * v[j].w); }
            const float rstd = 1.f / sqrtf(wave_sum(s2) * (1.f / DM) + LN_EPS);
            u32x2* o8 = (u32x2*)(C.H1() + (size_t)m * DM) + C.lane;
#pragma unroll
            for (int j = 0; j < 4; ++j) { v[j] = v[j] * rstd * gg[j] + bb[j]; u32x2 o; o.x = pk2(v[j].x, v[j].y); o.y = pk2(v[j].z, v[j].w); o8[64 * j] = o; }
            float lg[20];
#pragma unroll
            for (int n = 0; n < 20; ++n) { float a = 0.f;
#pragma unroll
                for (int j = 0; j < 4; ++j) { const f32x4 w = *(const LAS f32x4*)(wr + n * 1024 + 4 * C.lane + 256 * j); a += (v[j].x * w.x + v[j].y * w.y) + (v[j].z * w.z + v[j].w * w.w); }
                lg[n] = wave_sum(a); }
            float g0 = lg[0] + brg[0], g1 = lg[1] + brg[1], g2 = lg[2] + brg[2], g3 = lg[3] + brg[3];
            int gi = 0; float gm = g0; if (g1 > gm) { gm = g1; gi = 1; } if (g2 > gm) { gm = g2; gi = 2; } if (g3 > gm) { gm = g3; gi = 3; }
            const float gwt = 1.0f / (__expf(g0 - gm) + __expf(g1 - gm) + __expf(g2 - gm) + __expf(g3 - gm));
            float e[4];
#pragma unroll
            for (int i = 0; i < 4; ++i) { const float a0 = lg[4 + i] + bre[i], a1 = lg[8 + i] + bre[4 + i], a2 = lg[12 + i] + bre[8 + i], a3 = lg[16 + i] + bre[12 + i]; e[i] = gi == 0 ? a0 : (gi == 1 ? a1 : (gi == 2 ? a2 : a3)); }
            int i1 = 0; float v1 = e[0]; if (e[1] > v1) { v1 = e[1]; i1 = 1; } if (e[2] > v1) { v1 = e[2]; i1 = 2; } if (e[3] > v1) { v1 = e[3]; i1 = 3; }
            int i2 = -1; float v2 = -3.0e38f;
#pragma unroll
            for (int i = 0; i < 4; ++i) if (i != i1 && e[i] > v2) { v2 = e[i]; i2 = i; }
            const float ex = __expf(v2 - v1), p1 = 1.0f / (1.0f + ex), p2 = ex * p1;
            const int il = i1 < i2 ? i1 : i2, ih = i1 < i2 ? i2 : i1; const float wl = (i1 < i2 ? p1 : p2) * gwt, wh = (i1 < i2 ? p2 : p1) * gwt;
            const int q = il == 0 ? ih - 1 : (il == 1 ? ih + 1 : 5);
            if (C.lane == 0) { rcls[r] = gi * 6 + q; rw[r * 2] = wl; rw[r * 2 + 1] = wh; }
        }
        __syncthreads();
        if (C.tid < 128) rpos[C.tid] = atomicAdd((int*)&lcnt[rcls[C.tid]], 1);
        __syncthreads();
        if (C.tid < NCLS) lbase[C.tid] = lcnt[C.tid] > 0 ? (int)__hip_atomic_fetch_add(C.ctl() + CW_CNT + C.tid, (unsigned)lcnt[C.tid], __ATOMIC_RELAXED, __HIP_MEMORY_SCOPE_AGENT) : 0;
        __syncthreads();
        if (C.tid < 128) { const int c = rcls[C.tid], pos = lbase[c] + rpos[C.tid];
            if (pos < LISTCAP) { C.LIST()[c * LISTCAP + pos] = rb * 128 + C.tid; C.LW()[((size_t)c * LISTCAP + pos) * 2] = rw[C.tid * 2]; C.LW()[((size_t)c * LISTCAP + pos) * 2 + 1] = rw[C.tid * 2 + 1]; } }
    }
}

__device__ __forceinline__ void phase_ln2(const Ctx& C) {
    const int gw = C.bid * NWAVES + C.wave, NGW = C.G * NWAVES;
    f32x4 gg[4], bb[4];
#pragma unroll
    for (int j = 0; j < 4; ++j) { gg[j] = *(const f32x4*)(C.ln2_g() + 4 * C.lane + 256 * j); bb[j] = *(const f32x4*)(C.ln2_b() + 4 * C.lane + 256 * j); }
    for (int m = gw; m < NTOK; m += NGW) {
        const u32x2* xr = (const u32x2*)(C.R2() + (size_t)m * DM) + C.lane;
        f32x4 v[4]; float s = 0.f;
#pragma unroll
        for (int j = 0; j < 4; ++j) { const u32x2 w = xr[64 * j]; v[j] = (f32x4){bflo(w.x), bfhi(w.x), bflo(w.y), bfhi(w.y)}; s += (v[j].x + v[j].y) + (v[j].z + v[j].w); }
        const float mean = wave_sum(s) * (1.f / DM); float s2 = 0.f;
#pragma unroll
        for (int j = 0; j < 4; ++j) { v[j] = v[j] - mean; s2 += (v[j].x * v[j].x + v[j].y * v[j].y) + (v[j].z * v[j].z + v[j].w * v[j].w); }
        const float rstd = 1.f / sqrtf(wave_sum(s2) * (1.f / DM) + LN_EPS);
        f32x4* o = (f32x4*)(C.out() + (size_t)m * DM) + C.lane;
#pragma unroll
        for (int j = 0; j < 4; ++j) o[64 * j] = v[j] * rstd * gg[j] + bb[j];
    }
}

#define XB_TMO      128
#define XB_XCNT(j)  (256  + 64 * (j))
#define XB_XSUB(j)  (1280 + 64 * (j))
#define XB_XGEN(j)  (2304 + 64 * (j))
#define XB_TOP      3328
#define XB_TOPGEN   3392
#define XCD_BAR_WORDS 3456
#define XB_SPIN_CAP (1u << 18)
constexpr int CW_BAR = 4096;
constexpr int MISC_OFF = LDS_BYTES - 256;
__device__ __forceinline__ unsigned xb_ld(unsigned* p)              { return __hip_atomic_load(p, __ATOMIC_RELAXED, __HIP_MEMORY_SCOPE_AGENT); }
__device__ __forceinline__ unsigned xb_add(unsigned* p, unsigned v) { return __hip_atomic_fetch_add(p, v, __ATOMIC_RELAXED, __HIP_MEMORY_SCOPE_AGENT); }
__device__ __forceinline__ unsigned xb_xcc_id() { return (unsigned)__builtin_amdgcn_s_getreg((3 << 11) | 20) & 0xFu; }
#define XB_SPIN(cond, bar) do { unsigned _sp = 0; while (cond) { __builtin_amdgcn_s_sleep(1); \
    if ((++_sp & 255u) == 0u) { if (xb_ld(&(bar)[XB_TMO])) break; if (_sp > XB_SPIN_CAP) { atomicAdd(&(bar)[XB_TMO], 1u); break; } } } } while (0)
struct XcdBarrier { unsigned* bar; unsigned x; volatile LAS unsigned* st; };
__device__ __forceinline__ XcdBarrier xcd_barrier_post(unsigned* bar, volatile LAS unsigned* st) {
    XcdBarrier b; b.bar = bar; b.x = xb_xcc_id(); b.st = st;
    if (threadIdx.x == 0) (void)xb_add(&bar[XB_XCNT(b.x)], 1u);
    return b;
}
__device__ __forceinline__ void xcd_barrier_complete(unsigned* bar, unsigned x, unsigned& nloc, unsigned& nx) {
    const unsigned G = gridDim.x * gridDim.y * gridDim.z;
    unsigned sum, cnt, mine, sp = 0u;
    for (;;) {
        sum = 0u; cnt = 0u; mine = 0u;
#pragma unroll
        for (unsigned j = 0; j < 16; ++j) { const unsigned c = xb_ld(&bar[XB_XCNT(j)]); sum += c; cnt += (c > 0u) ? 1u : 0u; mine = (j == x) ? c : mine; }
        if (sum == G) break;
        __builtin_amdgcn_s_sleep(1);
        if ((++sp & 255u) == 0u) { if (xb_ld(&bar[XB_TMO])) break; if (sp > XB_SPIN_CAP) { atomicAdd(&bar[XB_TMO], 1u); break; } }
    }
    nloc = mine > 0u ? mine : 1u; nx = cnt > 0u ? cnt : 1u;
}
__device__ __forceinline__ void xcd_barrier(const XcdBarrier& b) {
    asm volatile("s_waitcnt vmcnt(0)" ::: "memory");
    __syncthreads();
    if (threadIdx.x == 0) {
        unsigned* bar = b.bar;
        __builtin_amdgcn_s_waitcnt(0);
        unsigned nloc = b.st[0], nx = b.st[1];
        if (nloc == 0u) { xcd_barrier_complete(bar, b.x, nloc, nx); b.st[0] = nloc; b.st[1] = nx; }
        const unsigned old = xb_add(&bar[XB_XSUB(b.x)], 1u);
        const unsigned gen = old / nloc;
        if (old + 1u == (gen + 1u) * nloc) {
            __builtin_amdgcn_fence(__ATOMIC_RELEASE, "agent");
            asm volatile("s_waitcnt vmcnt(0)" ::: "memory");
            const unsigned og = xb_add(&bar[XB_TOP], 1u);
            const unsigned tg = og / nx;
            if (og + 1u == (tg + 1u) * nx) xb_add(&bar[XB_TOPGEN], 1u);
            else XB_SPIN(xb_ld(&bar[XB_TOPGEN]) == tg, bar);
            __builtin_amdgcn_fence(__ATOMIC_ACQUIRE, "agent");
            xb_add(&bar[XB_XGEN(b.x)], 1u);
            asm volatile("s_waitcnt vmcnt(0)" ::: "memory");
        } else {
            XB_SPIN(xb_ld(&bar[XB_XGEN(b.x)]) == gen, bar);
            __builtin_amdgcn_fence(__ATOMIC_ACQUIRE, "agent");
            asm volatile("s_waitcnt vmcnt(0)" ::: "memory");
        }
    }
    __syncthreads();
}

constexpr int N_PHASES = 15;
template <int LO, int HI> __global__ void __launch_bounds__(NTHREADS, 2) fwd_kernel(Args args) {
    extern __shared__ __attribute__((aligned(16))) unsigned char lds_raw[];
    Ctx C;
    C.lds = (LAS unsigned char*)lds_raw;
    C.tid = threadIdx.x; C.lane = C.tid & 63; C.wave = __builtin_amdgcn_readfirstlane(C.tid >> 6); C.G = gridDim.x; C.bid = blockIdx.x;
    C.a = &args; C.ws = args.ws;
    const LAS MoeTab* tb = (const LAS MoeTab*)(C.lds + MOETAB_OFF);
    XcdBarrier bar; bar.bar = C.ctl() + CW_BAR; bar.x = 0; bar.st = nullptr;
    if constexpr (HI - LO > 1) {
        volatile LAS unsigned* misc = (volatile LAS unsigned*)(C.lds + MISC_OFF);
        if (C.tid < 64) misc[C.tid] = 0u;
        __syncthreads();
        bar = xcd_barrier_post(C.ctl() + CW_BAR, misc + 8);
    }
#define IN(k) (LO <= (k) && (k) < HI)
#define SEAM(k) do { if constexpr (IN(k) && IN((k) + 1)) xcd_barrier(bar); } while (0)
    if constexpr (IN(0)) phase_prep(C);
    SEAM(0);
#if FAST_INPROJ
    if constexpr (IN(1)) { ProbDense P{C.XN(), C.WIN(), NTOK / 256, NPROJ / 256, DM, C.G, C.bid}; EpiStoreBf16 E{C.PROJ(), NPROJ}; pg8::gemm_phase(C.lds, P, E); }
#else
    if constexpr (IN(1)) { SpecInProj sp{C.XN(), C.WIN(), C.PROJ()}; simple_gemm<1>(C, sp); }
#endif
    SEAM(1);
#if !FAST_POOL
    if constexpr (IN(2)) phase_poolwin_simple(C);
#endif
    SEAM(2);
#if FAST_POOL
    if constexpr (IN(3)) phase_pool_fast(C);
#else
    if constexpr (IN(3)) { SpecPool sp{C.PWIN(), C.WPOOL(), C.YMIX(), C.b_pool(), C.pool_scale()}; simple_gemm<1>(C, sp); }
#endif
    SEAM(3);
#if !(FAST_STATES && FAST_Y)
    if constexpr (IN(4)) phase_conv_simple(C);
#endif
    SEAM(4);
#if !(FAST_STATES && FAST_Y)
    if constexpr (IN(5)) phase_dt_simple(C);
#endif
    SEAM(5);
#if FAST_STATES
    if constexpr (IN(6)) phase_states_fast(C);
#else
    if constexpr (IN(6)) phase_states_simple(C);
#endif
    SEAM(6);
    if constexpr (IN(7)) phase_scan(C);
    SEAM(7);
#if FAST_Y
    if constexpr (IN(8)) phase_y_fast(C);
#else
    if constexpr (IN(8)) phase_y_simple(C);
#endif
    SEAM(8);
#if !FAST_Y
    if constexpr (IN(9)) phase_rms_simple(C);
#endif
    SEAM(9);
#if FAST_OUTPROJ
    if constexpr (IN(10)) { ProbDense P{C.YMIX(), C.WOUT(), NTOK / 256, DM / 256, DM, C.G, C.bid}; EpiResBf16 E{C.XN(), C.R1()}; pg8::gemm_phase(C.lds, P, E); }
#else
    if constexpr (IN(10)) { SpecOutProj sp{C.YMIX(), C.WOUT(), C.XN(), C.R1()}; simple_gemm<1>(C, sp); }
#endif
    SEAM(10);
    if constexpr (IN(11)) phase_ln1_router(C);
    SEAM(11);
#if FAST_MOE1
    if constexpr (IN(12)) { build_moetab(C); ProbMoe1 P{C.H1(), C.WGU(), C.LIST(), tb, C.G, C.bid}; EpiMoe1 E{C.HB(), C.LW(), tb}; pg8::gemm_phase(C.lds, P, E); }
#else
    if constexpr (IN(12)) { build_moetab(C); SpecMoe1 sp{C.H1(), C.WGU(), C.HB(), C.LIST(), C.LW(), tb}; simple_gemm<2>(C, sp); }
#endif
    SEAM(12);
#if FAST_MOE2
    if constexpr (IN(13)) { build_moetab(C); ProbMoe2 P{C.HB(), C.WD(), tb, C.G, C.bid}; EpiMoe2 E{C.H1(), C.R2(), C.LIST(), tb}; pg8::gemm_phase(C.lds, P, E); }
#else
    if constexpr (IN(13)) { build_moetab(C); SpecMoe2 sp{C.H1(), C.WD(), C.HB(), C.R2(), C.LIST(), tb}; simple_gemm<1>(C, sp); }
#endif
    SEAM(13);
    if constexpr (IN(14)) phase_ln2(C);
#undef IN
#undef SEAM
}

#ifndef ONE_LAUNCH
#define ONE_LAUNCH 1
#endif
template <int P, int Q> static void launch_phase(int grid, hipStream_t stream, const Args& a) {
    static bool attr = false;
    if (!attr) { (void)hipFuncSetAttribute((const void*)fwd_kernel<P, Q>, hipFuncAttributeMaxDynamicSharedMemorySize, LDS_BYTES); (void)hipGetLastError(); attr = true; }
    hipLaunchKernelGGL((fwd_kernel<P, Q>), dim3(grid), dim3(NTHREADS), LDS_BYTES, stream, a);
}

extern "C" void kernel_launch(void* const* d_in, const int* in_sizes, int n_in, void* d_out, int out_size, void* d_ws, size_t ws_size, hipStream_t stream) {
    static int grid = 0;
    if (grid == 0) {
        if (n_in != 25 || in_sizes[0] != NTOK * DM || out_size != NTOK * DM || ws_size < WS_END) { fprintf(stderr, "kernel_launch: unexpected shapes (n_in %d, in0 %d, out %d, ws %zu)\n", n_in, n_in > 0 ? in_sizes[0] : -1, out_size, ws_size); grid = -1; return; }
        int dev = 0, cus = 0;
        if (hipGetDevice(&dev) != hipSuccess || hipDeviceGetAttribute(&cus, hipDeviceAttributeMultiprocessorCount, dev) != hipSuccess) { grid = -1; return; }
        (void)hipGetLastError();
        grid = cus > 0 ? cus : 256;
    }
    if (grid < 0) return;
    (void)hipMemsetAsync((char*)d_ws + WS_CTL, 0, CTL_ZERO_BYTES, stream);
    Args a{};
    for (int i = 0; i < 25; ++i) a.in[i] = (const float*)d_in[i];
    a.out = (float*)d_out; a.ws = (unsigned char*)d_ws;
#if ONE_LAUNCH
    launch_phase<0, N_PHASES>(grid, stream, a);
#else
    launch_phase<0, 1>(grid, stream, a); launch_phase<1, 2>(grid, stream, a); launch_phase<2, 3>(grid, stream, a); launch_phase<3, 4>(grid, stream, a); launch_phase<4, 5>(grid, stream, a);
    launch_phase<5, 6>(grid, stream, a); launch_phase<6, 7>(grid, stream, a); launch_phase<7, 8>(grid, stream, a); launch_phase<8, 9>(grid, stream, a); launch_phase<9, 10>(grid, stream, a);
    launch_phase<10, 11>(grid, stream, a); launch_phase<11, 12>(grid, stream, a); launch_phase<12, 13>(grid, stream, a); launch_phase<13, 14>(grid, stream, a); launch_phase<14, 15>(grid, stream, a);
#endif
}
```

```cpp
#include <hip/hip_runtime.h>
#include <cstdio>
#include <cstdint>

#define GAS __attribute__((address_space(1)))
#define LAS __attribute__((address_space(3)))
typedef unsigned short bf16;
typedef float f32x4 __attribute__((ext_vector_type(4)));
typedef float f32x2 __attribute__((ext_vector_type(2)));
typedef unsigned u32x4 __attribute__((ext_vector_type(4)));
typedef unsigned u32x2 __attribute__((ext_vector_type(2)));

constexpr int NTOK = 32768, DM = 1024, SEQ = 2048, NBATCH = 16, NPROJ = 2048, DINP = 2056;
constexpr int NCHUNK = 16, CHUNK = 128, NHEAD = 8, HP = 64, NST = 128;
constexpr int NCLS = 24, LISTCAP = 32768, MAXT256 = 160;
constexpr float LN_EPS = 1e-5f, RMS_EPS = 1e-5f;
constexpr float ALPHA = 1.189207115002721f;

constexpr int PC_Z = 0, PC_X = 512, PC_B = 1024, PC_C = 1280, PC_U = 1536;

constexpr size_t MiB = 1u << 20;
constexpr size_t WS_CTL = 0, CTL_ZERO_BYTES = 1 * MiB;
constexpr size_t WS_WIN = 2 * MiB;
constexpr size_t WS_WOUT = 6 * MiB;
constexpr size_t WS_WPOOL = 8 * MiB;
constexpr size_t WS_WGU = 10 * MiB;
constexpr size_t WS_WD = 42 * MiB;
constexpr size_t WS_DTRAW = 58 * MiB;
constexpr size_t WS_DTV = 59 * MiB;
constexpr size_t WS_ACL = 60 * MiB;
constexpr size_t WS_CHD = 61 * MiB;
constexpr size_t WS_LIST = 62 * MiB;
constexpr size_t WS_LW = 65 * MiB;
constexpr size_t WS_XN = 72 * MiB;
constexpr size_t WS_PROJ = 136 * MiB;
constexpr size_t WS_YMIX = 264 * MiB;
constexpr size_t WS_STATES = 328 * MiB;
constexpr size_t WS_PREV = 392 * MiB;
constexpr size_t WS_XBCC = 424 * MiB;
constexpr size_t WS_R1 = WS_PROJ;
constexpr size_t WS_H1 = WS_PROJ + 64 * MiB;
constexpr size_t WS_HB = WS_STATES;
constexpr size_t WS_R2 = WS_XN;
constexpr size_t WS_PWIN = WS_STATES;
constexpr size_t WS_YG = WS_STATES;
constexpr size_t WS_END = 488 * MiB;
constexpr int CW_CNT = 1024;

constexpr int LDS_BYTES = 147456;
constexpr int NTHREADS = 512, NWAVES = 8;

__device__ __forceinline__ unsigned f2bf(float f) { unsigned u = __builtin_bit_cast(unsigned, f); return (u + 0x7fffu + ((u >> 16) & 1u)) >> 16; }
__device__ __forceinline__ unsigned pk2(float lo, float hi) { unsigned r; asm("v_cvt_pk_bf16_f32 %0, %1, %2" : "=v"(r) : "v"(lo), "v"(hi)); return r; }
__device__ __forceinline__ float bf2f(bf16 h) { return __uint_as_float((unsigned)h << 16); }
__device__ __forceinline__ float bflo(unsigned w) { return __uint_as_float(w << 16); }
__device__ __forceinline__ float bfhi(unsigned w) { return __uint_as_float(w & 0xffff0000u); }
__device__ __forceinline__ float wave_sum(float v) {
#pragma unroll
    for (int o = 1; o < 64; o <<= 1) v += __shfl_xor(v, o);
    return v;
}
__device__ __forceinline__ float silu_f(float v) { return v * __builtin_amdgcn_rcpf(1.0f + __builtin_amdgcn_exp2f(-1.4426950408889634f * v)); }
__device__ __forceinline__ void unpack8(const u32x4 v, float (&f)[8]) {
    f[0] = bflo(v.x); f[1] = bfhi(v.x); f[2] = bflo(v.y); f[3] = bfhi(v.y); f[4] = bflo(v.z); f[5] = bfhi(v.z); f[6] = bflo(v.w); f[7] = bfhi(v.w);
}

struct Args { const float* in[25]; float* out; unsigned char* ws; int ph_lo, ph_hi; };

struct Ctx {
    const Args* a; unsigned char* ws; LAS unsigned char* lds;
    int tid, lane, wave, G, bid;
    __device__ __forceinline__ const float* x() const { return a->in[0]; }
    __device__ __forceinline__ const float* ln0_g() const { return a->in[1]; }
    __device__ __forceinline__ const float* ln0_b() const { return a->in[2]; }
    __device__ __forceinline__ const float* w_in() const { return a->in[3]; }
    __device__ __forceinline__ const float* conv_w() const { return a->in[4]; }
    __device__ __forceinline__ const float* conv_b() const { return a->in[5]; }
    __device__ __forceinline__ const float* dt_bias() const { return a->in[6]; }
    __device__ __forceinline__ const float* a_log() const { return a->in[7]; }
    __device__ __forceinline__ const float* d_skip() const { return a->in[8]; }
    __device__ __forceinline__ const float* ssm_norm_g() const { return a->in[9]; }
    __device__ __forceinline__ const float* w_pool() const { return a->in[10]; }
    __device__ __forceinline__ const float* b_pool() const { return a->in[11]; }
    __device__ __forceinline__ const float* pool_scale() const { return a->in[12]; }
    __device__ __forceinline__ const float* w_out() const { return a->in[13]; }
    __device__ __forceinline__ const float* ln1_g() const { return a->in[14]; }
    __device__ __forceinline__ const float* ln1_b() const { return a->in[15]; }
    __device__ __forceinline__ const float* w_rg() const { return a->in[16]; }
    __device__ __forceinline__ const float* b_rg() const { return a->in[17]; }
    __device__ __forceinline__ const float* w_re() const { return a->in[18]; }
    __device__ __forceinline__ const float* b_re() const { return a->in[19]; }
    __device__ __forceinline__ const float* w_gate() const { return a->in[20]; }
    __device__ __forceinline__ const float* w_up() const { return a->in[21]; }
    __device__ __forceinline__ const float* w_down() const { return a->in[22]; }
    __device__ __forceinline__ const float* ln2_g() const { return a->in[23]; }
    __device__ __forceinline__ const float* ln2_b() const { return a->in[24]; }
    __device__ __forceinline__ float* out() const { return a->out; }
    __device__ __forceinline__ unsigned* ctl() const { return (unsigned*)(ws + WS_CTL); }
    __device__ __forceinline__ bf16* WIN() const { return (bf16*)(ws + WS_WIN); }
    __device__ __forceinline__ bf16* WOUT() const { return (bf16*)(ws + WS_WOUT); }
    __device__ __forceinline__ bf16* WPOOL() const { return (bf16*)(ws + WS_WPOOL); }
    __device__ __forceinline__ bf16* WGU() const { return (bf16*)(ws + WS_WGU); }
    __device__ __forceinline__ bf16* WD() const { return (bf16*)(ws + WS_WD); }
    __device__ __forceinline__ bf16* XN() const { return (bf16*)(ws + WS_XN); }
    __device__ __forceinline__ bf16* PROJ() const { return (bf16*)(ws + WS_PROJ); }
    __device__ __forceinline__ bf16* YMIX() const { return (bf16*)(ws + WS_YMIX); }
    __device__ __forceinline__ bf16* PREV() const { return (bf16*)(ws + WS_PREV); }
    __device__ __forceinline__ bf16* XBCC() const { return (bf16*)(ws + WS_XBCC); }
    __device__ __forceinline__ bf16* R1() const { return (bf16*)(ws + WS_R1); }
    __device__ __forceinline__ bf16* H1() const { return (bf16*)(ws + WS_H1); }
    __device__ __forceinline__ bf16* HB() const { return (bf16*)(ws + WS_HB); }
    __device__ __forceinline__ bf16* R2() const { return (bf16*)(ws + WS_R2); }
    __device__ __forceinline__ bf16* PWIN() const { return (bf16*)(ws + WS_PWIN); }
    __device__ __forceinline__ float* DTRAW() const { return (float*)(ws + WS_DTRAW); }
    __device__ __forceinline__ float* DTV() const { return (float*)(ws + WS_DTV); }
    __device__ __forceinline__ float* ACL() const { return (float*)(ws + WS_ACL); }
    __device__ __forceinline__ float* CHD() const { return (float*)(ws + WS_CHD); }
    __device__ __forceinline__ float* STATES() const { return (float*)(ws + WS_STATES); }
    __device__ __forceinline__ float* LW() const { return (float*)(ws + WS_LW); }
    __device__ __forceinline__ float* YG() const { return (float*)(ws + WS_YG); }
    __device__ __forceinline__ int* LIST() const { return (int*)(ws + WS_LIST); }
};

struct TrItem { const float* src; bf16* dst; int ld_src, ld_dst; };
__device__ __forceinline__ void tr_load(const TrItem& t, int lane, f32x4 (&v)[8]) {
    const float* p = t.src + (size_t)(lane >> 3) * t.ld_src + 4 * (lane & 7);
#pragma unroll
    for (int i = 0; i < 8; ++i) v[i] = *(const f32x4*)(p + (size_t)(8 * i) * t.ld_src);
}
__device__ __forceinline__ void tr_store(const TrItem& t, int lane, const f32x4 (&v)[8], LAS float* scr) {
    const int r = lane >> 3, c4 = lane & 7;
#pragma unroll
    for (int i = 0; i < 8; ++i) { LAS float* d = scr + (8 * i + r) * 33 + 4 * c4; d[0] = v[i][0]; d[1] = v[i][1]; d[2] = v[i][2]; d[3] = v[i][3]; }
    asm volatile("s_waitcnt lgkmcnt(0)" ::: "memory");
    const int c = lane & 7;
#pragma unroll
    for (int j = 0; j < 4; ++j) { const int n = (lane >> 3) + 8 * j; const LAS float* s = scr + (8 * c) * 33 + n;
        u32x4 o; o.x = pk2(s[0 * 33], s[1 * 33]); o.y = pk2(s[2 * 33], s[3 * 33]); o.z = pk2(s[4 * 33], s[5 * 33]); o.w = pk2(s[6 * 33], s[7 * 33]);
        *(u32x4*)(t.dst + (size_t)n * t.ld_dst + 8 * c) = o; }
    asm volatile("s_waitcnt lgkmcnt(0)" ::: "memory");
}
constexpr int I_WIN = 16 * 64, I_WOUT = 16 * 32, I_WPOOL = 4 * 2 * 4, I_WGU = 16 * 16 * 32, I_WD = 16 * 8 * 32;
constexpr int TR_NITEMS = I_WIN + I_WOUT + I_WPOOL + I_WGU + I_WD;
__device__ __forceinline__ TrItem tr_decode(const Ctx& C, int it) {
    TrItem t; int r = it;
    if (r < I_WIN) { const int kb = r / 64, nb = r % 64, n0 = nb * 32, n0s = n0 + (n0 >= 1536 ? 8 : 0);
        t.src = C.w_in() + (size_t)(kb * 64) * DINP + n0s; t.ld_src = DINP; t.dst = C.WIN() + (size_t)n0 * 1024 + kb * 64; t.ld_dst = 1024; return t; }
    r -= I_WIN;
    if (r < I_WOUT) { const int kb = r / 32, nb = r % 32;
        t.src = C.w_out() + (size_t)(kb * 64) * 1024 + nb * 32; t.ld_src = 1024; t.dst = C.WOUT() + (size_t)(nb * 32) * 1024 + kb * 64; t.ld_dst = 1024; return t; }
    r -= I_WOUT;
    if (r < I_WPOOL) { const int g = r / 8, kb = (r % 8) / 4, nb = r % 4;
        t.src = C.w_pool() + (size_t)g * 16384 + (size_t)(kb * 64) * 128 + nb * 32; t.ld_src = 128; t.dst = C.WPOOL() + (size_t)g * 16384 + (size_t)(nb * 32) * 128 + kb * 64; t.ld_dst = 128; return t; }
    r -= I_WPOOL;
    if (r < I_WGU) { const int e = r / 512, q = r % 512, kb = q / 32, nb = q % 32;
        const int row0 = nb * 32, tt = row0 >> 8, half = (row0 >> 7) & 1, i0 = row0 & 127;
        t.src = (half ? C.w_up() : C.w_gate()) + (size_t)e * 1024 * 512 + (size_t)(kb * 64) * 512 + 128 * tt + i0; t.ld_src = 512;
        t.dst = C.WGU() + (size_t)e * 1048576 + (size_t)row0 * 1024 + kb * 64; t.ld_dst = 1024; return t; }
    r -= I_WGU;
    { const int e = r / 256, q = r % 256, kb = q / 32, nb = q % 32;
        t.src = C.w_down() + (size_t)e * 524288 + (size_t)(kb * 64) * 1024 + nb * 32; t.ld_src = 1024; t.dst = C.WD() + (size_t)e * 524288 + (size_t)(nb * 32) * 512 + kb * 64; t.ld_dst = 512; return t; }
}

__device__ __forceinline__ void phase_prep(const Ctx& C) {
    LAS float* scr = (LAS float*)(C.lds + C.wave * 8704);
    LAS float* wdt = (LAS float*)(C.lds + 8 * 8704);
    const int gw = C.bid * NWAVES + C.wave, NGW = C.G * NWAVES;
    for (int i = C.tid; i < 8 * 1024; i += NTHREADS) { const int k = i >> 3, n = i & 7; wdt[n * 1024 + k] = C.w_in()[(size_t)k * DINP + 1536 + n]; }
    {
        f32x4 va[8], vb[8]; TrItem ta, tb2; int it = gw;
        if (it < TR_NITEMS) { ta = tr_decode(C, it); tr_load(ta, C.lane, va); }
        while (it < TR_NITEMS) {
            const int n1 = it + NGW; if (n1 < TR_NITEMS) { tb2 = tr_decode(C, n1); tr_load(tb2, C.lane, vb); }
            tr_store(ta, C.lane, va, scr);
            const int n2 = n1 + NGW; if (n1 >= TR_NITEMS) break;
            if (n2 < TR_NITEMS) { ta = tr_decode(C, n2); tr_load(ta, C.lane, va); }
            tr_store(tb2, C.lane, vb, scr);
            it = n2;
        }
    }
    __syncthreads();
    f32x4 gg[4], bb[4];
#pragma unroll
    for (int j = 0; j < 4; ++j) { gg[j] = *(const f32x4*)(C.ln0_g() + 4 * C.lane + 256 * j); bb[j] = *(const f32x4*)(C.ln0_b() + 4 * C.lane + 256 * j); }
    for (int m0 = gw; m0 < NTOK; m0 += 4 * NGW) {
        f32x4 vv[4][4];
#pragma unroll
        for (int b = 0; b < 4; ++b) { const int m = m0 + b * NGW; if (m < NTOK) { const f32x4* xr = (const f32x4*)(C.x() + (size_t)m * DM) + C.lane;
#pragma unroll
                for (int j = 0; j < 4; ++j) vv[b][j] = xr[64 * j]; } }
#pragma unroll
        for (int b = 0; b < 4; ++b) { const int m = m0 + b * NGW; if (m >= NTOK) break;
            f32x4 v[4]; float s = 0.f;
#pragma unroll
            for (int j = 0; j < 4; ++j) { v[j] = vv[b][j]; s += (v[j].x + v[j].y) + (v[j].z + v[j].w); }
            const float mean = wave_sum(s) * (1.f / DM); float s2 = 0.f;
#pragma unroll
            for (int j = 0; j < 4; ++j) { v[j] = v[j] - mean; s2 += (v[j].x * v[j].x + v[j].y * v[j].y) + (v[j].z * v[j].z + v[j].w * v[j].w); }
            const float rstd = 1.f / sqrtf(wave_sum(s2) * (1.f / DM) + LN_EPS);
            unsigned long long* o8 = (unsigned long long*)(C.XN() + (size_t)m * DM) + C.lane;
#pragma unroll
            for (int j = 0; j < 4; ++j) { v[j] = v[j] * rstd * gg[j] + bb[j];
                o8[64 * j] = (unsigned long long)pk2(v[j].x, v[j].y) | ((unsigned long long)pk2(v[j].z, v[j].w) << 32); }
            float d[8]; const LAS float* wd = wdt + 4 * C.lane; asm volatile("" : "+v"(wd));
#pragma unroll
            for (int n = 0; n < 8; ++n) { float a = 0.f;
#pragma unroll
                for (int j = 0; j < 4; ++j) { const f32x4 w = *(const LAS f32x4*)(wd + n * 1024 + 256 * j); a += (v[j].x * w.x + v[j].y * w.y) + (v[j].z * w.z + v[j].w * w.w); }
                d[n] = wave_sum(a); }
            if (C.lane == 0) { *(f32x4*)(C.DTRAW() + (size_t)m * 8) = (f32x4){d[0], d[1], d[2], d[3]}; *(f32x4*)(C.DTRAW() + (size_t)m * 8 + 4) = (f32x4){d[4], d[5], d[6], d[7]}; }
        }
    }
}

struct MoeTab { int ntiles; int cnt[NCLS]; int cls[MAXT256]; int row0[MAXT256]; };
constexpr int MOETAB_OFF = 140 * 1024;
__device__ __forceinline__ void class_experts(int c, int& elo, int& ehi) {
    const int g = c / 6, q = c % 6; const int il = q < 3 ? 0 : (q < 5 ? 1 : 2); const int ih = q < 3 ? q + 1 : (q < 5 ? q - 1 : 3);
    elo = g * 4 + il; ehi = g * 4 + ih;
}
__device__ __forceinline__ void build_moetab(const Ctx& C) {
    LAS MoeTab* tb = (LAS MoeTab*)(C.lds + MOETAB_OFF);
    if (C.tid == 0) {
        int nt = 0;
        for (int c = 0; c < NCLS; ++c) { int n = (int)__hip_atomic_load(C.ctl() + CW_CNT + c, __ATOMIC_RELAXED, __HIP_MEMORY_SCOPE_AGENT); if (n > LISTCAP) n = LISTCAP; tb->cnt[c] = n;
            for (int r = 0; r < n; r += 256) { if (nt < MAXT256) { tb->cls[nt] = c; tb->row0[nt] = r; ++nt; } } }
        tb->ntiles = nt;
    }
    __syncthreads();
}

namespace pg8 {
typedef short bf16x8 __attribute__((ext_vector_type(8)));
constexpr int BM = 256, BK = 64, HALF = 128, HTB = HALF * BK * 2, STAGE_BYTES = 8 * HTB, NXCD = 8, WGM = 8;
__host__ __device__ __forceinline__ int lds_byte(int r, int c) { const int st = (r >> 4) * 2 + (c >> 5), rr = r & 15, cc = c & 31, ob = rr * 64 + cc * 2; return st * 1024 + (ob ^ (((ob >> 9) & 1) << 5)); }
__host__ __device__ __forceinline__ void stage_rc(int b, int& R, int& C) { const int st = b / 1024, sb = b % 1024, swz = sb ^ (((sb >> 9) & 1) << 5); R = (st >> 1) * 16 + swz / 64; C = (st & 1) * 32 + (swz % 64) / 2; }
__host__ __device__ __forceinline__ int perm32(int rho) { const int n = rho >> 4, i = rho & 15; return 8 * (i >> 2) + 4 * n + (i & 3); }
struct Unit { int pm, pn, xa, xb; };
__device__ __forceinline__ bool order_next(int i, int G, int c, int nM, int nN, Unit& u) {
    const int nwg = nM * nN; const long L = (long)i * G + c; if (L >= nwg) return false;
    int wgid = (int)L; { const int q = nwg / NXCD, r = nwg % NXCD, xcd = wgid % NXCD, off = wgid / NXCD; wgid = (xcd < r ? xcd * (q + 1) : r * (q + 1) + (xcd - r) * q) + off; }
    const int nig = WGM * nN, gid = wgid / nig, fm = gid * WGM, gsz = (nM - fm) < WGM ? (nM - fm) : WGM;
    u.pm = fm + ((wgid % nig) % gsz); u.pn = (wgid % nig) / gsz; return true;
}
__device__ __forceinline__ unsigned cvt_pk_bf16(float lo, float hi) { unsigned r; asm volatile("v_cvt_pk_bf16_f32 %0, %1, %2" : "=v"(r) : "v"(lo), "v"(hi)); return r; }

template <class Prob, class Epi>
__device__ __forceinline__ void gemm_phase(LAS unsigned char* lds, const Prob& P, const Epi& E) {
    constexpr bool GA = Prob::GATHER;
    int tid = threadIdx.x; asm volatile("" : "+v"(tid));
    const int wid = __builtin_amdgcn_readfirstlane(tid >> 6), lane = tid & 63, wr = wid >> 2, wc = wid & 3, fr = lane & 15, fq = lane >> 4;
    const int nt = P.ktiles();
    const unsigned ldb = P.ldb_bytes();
    unsigned voffB[2], voffA[2];
#pragma unroll
    for (int i = 0; i < 2; ++i) { int R, Cc; stage_rc(tid * 16 + i * 8192, R, Cc); const int Rb = (R & ~31) + perm32(R & 31); voffB[i] = (unsigned)Rb * ldb + (unsigned)Cc * 2u;
        voffA[i] = GA ? 0u : P.a_voff_dense(R, Cc); }
    const unsigned hstepB = 128u * ldb;
    const unsigned ldsw = (unsigned)wid * 1024u;
    const int aoff = lds_byte(wr * 64 + fr, fq * 8), boff = lds_byte(wc * 32 + fr, fq * 8);
#define PG8_SA(b, h) (((b) * 2 + (h)) * HTB)
#define PG8_SB(b, h) ((4 + (b) * 2 + (h)) * HTB)
#define PG8_STAGE(bufoff, gbase, voff) do { _Pragma("unroll") for (int _i = 0; _i < 2; ++_i) \
        __builtin_amdgcn_global_load_lds((const unsigned*)((const char*)(gbase) + (voff)[_i]), (LAS unsigned*)(lds + (bufoff) + ldsw + _i * 8192), 16, 0, 0); } while (0)
#define PG8_LDA(dst, b, h) do { _Pragma("unroll") for (int m = 0; m < 4; ++m) _Pragma("unroll") for (int k = 0; k < 2; ++k) dst[m][k] = *(const LAS bf16x8*)(lds + PG8_SA(b, h) + aoff + m * 2048 + k * 1024); } while (0)
#define PG8_LDB(dst, b, h) do { _Pragma("unroll") for (int n = 0; n < 2; ++n) _Pragma("unroll") for (int k = 0; k < 2; ++k) dst[n][k] = *(const LAS bf16x8*)(lds + PG8_SB(b, h) + boff + n * 2048 + k * 1024); } while (0)
#define PG8_MMA(ai, bj, At, Bt) do { __builtin_amdgcn_s_setprio(1); _Pragma("unroll") for (int m = 0; m < 4; ++m) _Pragma("unroll") for (int n = 0; n < 2; ++n) _Pragma("unroll") for (int k = 0; k < 2; ++k) \
        acc[ai][bj][m][n] = __builtin_amdgcn_mfma_f32_16x16x32_bf16(Bt[n][k], At[m][k], acc[ai][bj][m][n], 0, 0, 0); __builtin_amdgcn_s_setprio(0); } while (0)
#define PG8_WAIT_V(n) asm volatile("s_waitcnt vmcnt(" #n ")" ::: "memory")
#define PG8_WAIT_L(n) asm volatile("s_waitcnt lgkmcnt(" #n ")" ::: "memory")
#define PG8_BAR __builtin_amdgcn_s_barrier()
#define PG8_SCHED __builtin_amdgcn_sched_barrier(0)
    Unit cur, nxt; int ui = 0;
    if (!P.next(0, cur)) return;
    f32x4 acc[2][2][4][2];
#pragma unroll
    for (int a = 0; a < 2; ++a)
#pragma unroll
        for (int b = 0; b < 2; ++b)
#pragma unroll
            for (int m = 0; m < 4; ++m)
#pragma unroll
                for (int n = 0; n < 2; ++n) acc[a][b][m][n] = (f32x4){0.f, 0.f, 0.f, 0.f};
    bf16x8 At[4][2], B0[2][2], B1[2][2];
    unsigned vc0[2], vc1[2], vn0[2], vn1[2];
    const char* cA0; const char* cA1; const char* nA0; const char* nA1;
    if constexpr (GA) { cA0 = cA1 = nA0 = nA1 = P.a_base();
#pragma unroll
        for (int i = 0; i < 2; ++i) { int R, Cc; stage_rc(tid * 16 + i * 8192, R, Cc); vc0[i] = P.a_voff(cur, 0, R, Cc); vc1[i] = P.a_voff(cur, 1, R, Cc); vn0[i] = vc0[i]; vn1[i] = vc1[i]; }
    } else { cA0 = P.a_half(cur, 0); cA1 = P.a_half(cur, 1); nA0 = cA0; nA1 = cA1;
#pragma unroll
        for (int i = 0; i < 2; ++i) { vc0[i] = vc1[i] = vn0[i] = vn1[i] = voffA[i]; } }
    const size_t kstep = (size_t)(BK * 2);
    {
        const char* cB0 = P.b_tile(cur, 0); const char* cB1 = P.b_tile(cur, 1);
        PG8_STAGE(PG8_SB(0, 0), cB0, voffB); PG8_STAGE(PG8_SB(0, 1), cB0 + hstepB, voffB); PG8_STAGE(PG8_SA(0, 0), cA0, vc0); PG8_STAGE(PG8_SA(0, 1), cA1, vc1);
        if (wr == 1) PG8_BAR;
        PG8_WAIT_V(2); PG8_BAR;
        PG8_STAGE(PG8_SB(1, 0), cB1, voffB); PG8_STAGE(PG8_SA(1, 0), cA0 + kstep, vc0); PG8_STAGE(PG8_SB(1, 1), cB1 + hstepB, voffB);
        PG8_WAIT_V(6); PG8_BAR;
    }
    for (;;) {
        const bool has_next = P.next(ui + 1, nxt);
        if (!has_next) nxt = cur;
        if constexpr (!GA) { nA0 = P.a_half(nxt, 0); nA1 = P.a_half(nxt, 1); }
        for (int t = 0; t < nt; t += 2) {
            const bool last = (t == nt - 2);
            if constexpr (GA) { if (last) {
#pragma unroll
                for (int i = 0; i < 2; ++i) { int R, Cc; stage_rc(tid * 16 + i * 8192, R, Cc); vn0[i] = P.a_voff(nxt, 0, R, Cc); vn1[i] = P.a_voff(nxt, 1, R, Cc); } } }
            const char* a11 = cA1 + (size_t)(t + 1) * kstep;
            const char* a20 = last ? nA0 : cA0 + (size_t)(t + 2) * kstep; const char* a21 = last ? nA1 : cA1 + (size_t)(t + 2) * kstep;
            const char* a30 = a20 + kstep;
            const char* b2 = last ? P.b_tile(nxt, 0) : P.b_tile(cur, t + 2); const char* b3 = last ? P.b_tile(nxt, 1) : P.b_tile(cur, t + 3);
            PG8_LDB(B0, 0, 0); PG8_LDB(B1, 0, 1); PG8_SCHED; PG8_LDA(At, 0, 0); PG8_STAGE(PG8_SA(1, 1), a11, vc1);
            if constexpr (GA) { if (last) {
#pragma unroll
                for (int i = 0; i < 2; ++i) { vc0[i] = vn0[i]; vc1[i] = vn1[i]; } } }
            PG8_WAIT_V(8); PG8_WAIT_L(0); PG8_BAR; PG8_MMA(0, 0, At, B0); PG8_MMA(0, 1, At, B1); PG8_BAR; PG8_SCHED;
            PG8_LDA(At, 0, 1); PG8_STAGE(PG8_SB(0, 0), b2, voffB); PG8_STAGE(PG8_SB(0, 1), b2 + hstepB, voffB); PG8_STAGE(PG8_SA(0, 0), a20, vc0);
            PG8_WAIT_V(8); PG8_WAIT_L(0); PG8_BAR; PG8_MMA(1, 0, At, B0); PG8_MMA(1, 1, At, B1); PG8_BAR; PG8_SCHED;
            PG8_LDB(B0, 1, 0); PG8_LDB(B1, 1, 1); PG8_SCHED; PG8_LDA(At, 1, 0); PG8_STAGE(PG8_SA(0, 1), a21, vc1);
            PG8_WAIT_V(8); PG8_WAIT_L(0); PG8_BAR; PG8_MMA(0, 0, At, B0); PG8_MMA(0, 1, At, B1); PG8_BAR; PG8_SCHED;
            PG8_LDA(At, 1, 1); PG8_STAGE(PG8_SB(1, 0), b3, voffB); PG8_STAGE(PG8_SB(1, 1), b3 + hstepB, voffB); PG8_STAGE(PG8_SA(1, 0), a30, vc0);
            PG8_WAIT_V(8); PG8_WAIT_L(0); PG8_BAR; PG8_MMA(1, 0, At, B0); PG8_MMA(1, 1, At, B1); PG8_BAR; PG8_SCHED;
        }
        if (wr == 0) PG8_BAR;
        E(acc, cur, wr, wc, fr, fq);
        if (!has_next) break;
#pragma unroll
        for (int a = 0; a < 2; ++a)
#pragma unroll
            for (int b = 0; b < 2; ++b)
#pragma unroll
                for (int m = 0; m < 4; ++m)
#pragma unroll
                    for (int n = 0; n < 2; ++n) acc[a][b][m][n] = (f32x4){0.f, 0.f, 0.f, 0.f};
        cur = nxt; ++ui; cA0 = nA0; cA1 = nA1;
        if (wr == 1) PG8_BAR;
    }
    PG8_WAIT_V(0);
    PG8_BAR;
#undef PG8_SA
#undef PG8_SB
#undef PG8_STAGE
#undef PG8_LDA
#undef PG8_LDB
#undef PG8_MMA
#undef PG8_WAIT_V
#undef PG8_WAIT_L
#undef PG8_BAR
#undef PG8_SCHED
}
}

struct ProbDense {
    static constexpr bool GATHER = false;
    const bf16* A; const bf16* Bt; int nM, nN, K, G, c;
    __device__ __forceinline__ bool next(int i, pg8::Unit& u) const { return pg8::order_next(i, G, c, nM, nN, u); }
    __device__ __forceinline__ int ktiles() const { return K / 64; }
    __device__ __forceinline__ unsigned ldb_bytes() const { return (unsigned)K * 2u; }
    __device__ __forceinline__ unsigned a_voff_dense(int R, int Cc) const { return ((unsigned)R * (unsigned)K + (unsigned)Cc) * 2u; }
    __device__ __forceinline__ const char* a_half(const pg8::Unit& u, int h) const { return (const char*)A + (size_t)(u.pm * 256 + h * 128) * K * 2; }
    __device__ __forceinline__ const char* a_base() const { return (const char*)A; }
    __device__ __forceinline__ unsigned a_voff(const pg8::Unit&, int, int, int) const { return 0u; }
    __device__ __forceinline__ const char* b_tile(const pg8::Unit& u, int kt) const { return (const char*)Bt + ((size_t)u.pn * 256 * K + (size_t)kt * 64) * 2; }
};
struct EpiStoreBf16 {
    bf16* O; int ldc;
    __device__ __forceinline__ void operator()(const f32x4 (&acc)[2][2][4][2], const pg8::Unit& u, int wr, int wc, int fr, int fq) const {
        const int row0 = u.pm * 256 + wr * 64 + fr, col0 = u.pn * 256 + wc * 32 + 8 * fq;
#pragma unroll
        for (int ai = 0; ai < 2; ++ai)
#pragma unroll
            for (int m = 0; m < 4; ++m) { bf16* rowp = O + (size_t)(row0 + ai * 128 + m * 16) * ldc + col0;
#pragma unroll
                for (int bj = 0; bj < 2; ++bj) { const f32x4 v0 = acc[ai][bj][m][0], v1 = acc[ai][bj][m][1];
                    u32x4 w; w.x = pg8::cvt_pk_bf16(v0[0], v0[1]); w.y = pg8::cvt_pk_bf16(v0[2], v0[3]); w.z = pg8::cvt_pk_bf16(v1[0], v1[1]); w.w = pg8::cvt_pk_bf16(v1[2], v1[3]);
                    *(u32x4*)(rowp + bj * 128) = w; } }
    }
};
struct EpiResBf16 {
    const bf16* X; bf16* O;
    __device__ __forceinline__ void operator()(const f32x4 (&acc)[2][2][4][2], const pg8::Unit& u, int wr, int wc, int fr, int fq) const {
        const int row0 = u.pm * 256 + wr * 64 + fr, col0 = u.pn * 256 + wc * 32 + 8 * fq;
#pragma unroll
        for (int ai = 0; ai < 2; ++ai)
#pragma unroll
            for (int m = 0; m < 4; ++m) { const size_t off = (size_t)(row0 + ai * 128 + m * 16) * DM + col0;
#pragma unroll
                for (int bj = 0; bj < 2; ++bj) { const f32x4 v0 = acc[ai][bj][m][0], v1 = acc[ai][bj][m][1]; const u32x4 xv = *(const u32x4*)(X + off + bj * 128);
                    u32x4 w; w.x = pg8::cvt_pk_bf16(ALPHA * bflo(xv.x) + v0[0], ALPHA * bfhi(xv.x) + v0[1]); w.y = pg8::cvt_pk_bf16(ALPHA * bflo(xv.y) + v0[2], ALPHA * bfhi(xv.y) + v0[3]);
                    w.z = pg8::cvt_pk_bf16(ALPHA * bflo(xv.z) + v1[0], ALPHA * bfhi(xv.z) + v1[1]); w.w = pg8::cvt_pk_bf16(ALPHA * bflo(xv.w) + v1[2], ALPHA * bfhi(xv.w) + v1[3]);
                    *(u32x4*)(O + off + bj * 128) = w; } }
    }
};

struct ProbMoe1 {
    static constexpr bool GATHER = true;
    const bf16* H1; const bf16* WGU; const int* LIST; const LAS MoeTab* tb; int G, c;
    __device__ __forceinline__ bool next(int i, pg8::Unit& u) const { if (!pg8::order_next(i, G, c, tb->ntiles, 8, u)) return false;
        const int cl = tb->cls[u.pm]; int elo, ehi; class_experts(cl, elo, ehi); u.xa = elo | (ehi << 8) | (cl << 16); u.xb = tb->row0[u.pm]; return true; }
    __device__ __forceinline__ int ktiles() const { return 16; }
    __device__ __forceinline__ unsigned ldb_bytes() const { return 2048u; }
    __device__ __forceinline__ unsigned a_voff_dense(int, int) const { return 0u; }
    __device__ __forceinline__ const char* a_half(const pg8::Unit&, int) const { return (const char*)H1; }
    __device__ __forceinline__ const char* a_base() const { return (const char*)H1; }
    __device__ __forceinline__ unsigned a_voff(const pg8::Unit& u, int h, int R, int Cc) const { const int cl = u.xa >> 16; int rr = u.xb + h * 128 + R; if (rr >= tb->cnt[cl]) rr = u.xb;
        const unsigned tok = (unsigned)LIST[cl * LISTCAP + rr]; return (tok * 1024u + (unsigned)Cc) * 2u; }
    __device__ __forceinline__ const char* b_tile(const pg8::Unit& u, int kt) const { const int e = (u.pn < 4) ? (u.xa & 255) : ((u.xa >> 8) & 255);
        return (const char*)WGU + ((size_t)e * 1048576 + (size_t)(u.pn & 3) * 262144 + (size_t)kt * 64) * 2; }
};
struct EpiMoe1 {
    bf16* HB; const float* LW; const LAS MoeTab* tb;
    __device__ __forceinline__ void operator()(const f32x4 (&acc)[2][2][4][2], const pg8::Unit& u, int wr, int wc, int fr, int fq) const {
        const int cl = u.xa >> 16, cnt = tb->cnt[cl], slot = u.pn >> 2; const int col0 = slot * 512 + (u.pn & 3) * 128 + wc * 32 + 8 * fq;
#pragma unroll
        for (int ai = 0; ai < 2; ++ai)
#pragma unroll
            for (int m = 0; m < 4; ++m) { const int r = ai * 128 + wr * 64 + m * 16 + fr, rr = u.xb + r; const float w = rr < cnt ? LW[((size_t)cl * LISTCAP + rr) * 2 + slot] : 0.f;
                const f32x4 g0 = acc[ai][0][m][0], g1 = acc[ai][0][m][1], u0 = acc[ai][1][m][0], u1 = acc[ai][1][m][1];
                u32x4 o; o.x = pg8::cvt_pk_bf16(w * silu_f(g0[0]) * u0[0], w * silu_f(g0[1]) * u0[1]); o.y = pg8::cvt_pk_bf16(w * silu_f(g0[2]) * u0[2], w * silu_f(g0[3]) * u0[3]);
                o.z = pg8::cvt_pk_bf16(w * silu_f(g1[0]) * u1[0], w * silu_f(g1[1]) * u1[1]); o.w = pg8::cvt_pk_bf16(w * silu_f(g1[2]) * u1[2], w * silu_f(g1[3]) * u1[3]);
                *(u32x4*)(HB + (size_t)(u.pm * 256 + r) * DM + col0) = o; }
    }
};
struct ProbMoe2 {
    static constexpr bool GATHER = false;
    const bf16* HB; const bf16* WD; const LAS MoeTab* tb; int G, c;
    __device__ __forceinline__ bool next(int i, pg8::Unit& u) const { if (!pg8::order_next(i, G, c, tb->ntiles, 4, u)) return false;
        const int cl = tb->cls[u.pm]; int elo, ehi; class_experts(cl, elo, ehi); u.xa = elo | (ehi << 8) | (cl << 16); u.xb = tb->row0[u.pm]; return true; }
    __device__ __forceinline__ int ktiles() const { return 16; }
    __device__ __forceinline__ unsigned ldb_bytes() const { return 1024u; }
    __device__ __forceinline__ unsigned a_voff_dense(int R, int Cc) const { return ((unsigned)R * 1024u + (unsigned)Cc) * 2u; }
    __device__ __forceinline__ const char* a_half(const pg8::Unit& u, int h) const { return (const char*)HB + (size_t)(u.pm * 256 + h * 128) * 2048; }
    __device__ __forceinline__ const char* a_base() const { return (const char*)HB; }
    __device__ __forceinline__ unsigned a_voff(const pg8::Unit&, int, int, int) const { return 0u; }
    __device__ __forceinline__ const char* b_tile(const pg8::Unit& u, int kt) const { const int e = (kt < 8) ? (u.xa & 255) : ((u.xa >> 8) & 255);
        return (const char*)WD + ((size_t)e * 524288 + (size_t)u.pn * 131072 + (size_t)(kt & 7) * 64) * 2; }
};
struct EpiMoe2 {
    const bf16* H1; bf16* R2; const int* LIST; const LAS MoeTab* tb;
    __device__ __forceinline__ void operator()(const f32x4 (&acc)[2][2][4][2], const pg8::Unit& u, int wr, int wc, int fr, int fq) const {
        const int cl = u.xa >> 16, cnt = tb->cnt[cl]; const int col0 = u.pn * 256 + wc * 32 + 8 * fq;
#pragma unroll
        for (int ai = 0; ai < 2; ++ai)
#pragma unroll
            for (int m = 0; m < 4; ++m) { const int r = ai * 128 + wr * 64 + m * 16 + fr, rr = u.xb + r; if (rr >= cnt) continue;
                const size_t off = (size_t)LIST[cl * LISTCAP + rr] * DM + col0;
#pragma unroll
                for (int bj = 0; bj < 2; ++bj) { const f32x4 v0 = acc[ai][bj][m][0], v1 = acc[ai][bj][m][1]; const u32x4 xv = *(const u32x4*)(H1 + off + bj * 128);
                    u32x4 w; w.x = pg8::cvt_pk_bf16(ALPHA * bflo(xv.x) + v0[0], ALPHA * bfhi(xv.x) + v0[1]); w.y = pg8::cvt_pk_bf16(ALPHA * bflo(xv.y) + v0[2], ALPHA * bfhi(xv.y) + v0[3]);
                    w.z = pg8::cvt_pk_bf16(ALPHA * bflo(xv.z) + v1[0], ALPHA * bfhi(xv.z) + v1[1]); w.w = pg8::cvt_pk_bf16(ALPHA * bflo(xv.w) + v1[2], ALPHA * bfhi(xv.w) + v1[3]);
                    *(u32x4*)(R2 + off + bj * 128) = w; } }
    }
};

__device__ __forceinline__ void phase_scan(const Ctx& C) {
    const int gt = C.bid * NTHREADS + C.tid, NGT = C.G * NTHREADS;
    for (int task = gt; task < NBATCH * NHEAD * 2048; task += NGT) {
        const int e4 = task & 2047, bh = task >> 11, b = bh >> 3, h = bh & 7;
        f32x4 run = (f32x4){0.f, 0.f, 0.f, 0.f};
        f32x4 st[NCHUNK]; float dec[NCHUNK];
#pragma unroll
        for (int c = 0; c < NCHUNK; ++c) { const size_t item = (size_t)((b * NCHUNK + c) * 8 + h); st[c] = *(const f32x4*)(C.STATES() + item * 8192 + e4 * 4); dec[c] = C.CHD()[item]; }
#pragma unroll
        for (int c = 0; c < NCHUNK; ++c) { const size_t item = (size_t)((b * NCHUNK + c) * 8 + h);
            u32x2 o; o.x = pk2(run.x, run.y); o.y = pk2(run.z, run.w); *(u32x2*)(C.PREV() + item * 8192 + e4 * 4) = o;
            run = run * dec[c] + st[c]; }
    }
}
typedef short bf16x8v __attribute__((ext_vector_type(8)));
typedef short bf16x4v __attribute__((ext_vector_type(4)));
#define MFMA16(a, b, c) __builtin_amdgcn_mfma_f32_16x16x32_bf16((a), (b), (c), 0, 0, 0)
__device__ __forceinline__ int swz(int row, int q) { return row * 256 + ((q ^ (row & 15)) << 4); }
__device__ __forceinline__ int swz2(int row, int q) { return row * 256 + ((q ^ ((row ^ (row >> 4)) & 15)) << 4); }

struct ConvIn { u32x4 raw[11]; f32x4 w[4][2]; f32x4 b[2]; };
__device__ __forceinline__ void conv_load(const Ctx& C, ConvIn& ci, int tokb, int ch8, bool zero3) {
    const bf16* base = C.PROJ() + (size_t)tokb * NPROJ + PC_X + ch8;
#pragma unroll
    for (int r = 0; r < 11; ++r) { if (r < 3 && zero3) ci.raw[r] = (u32x4){0u, 0u, 0u, 0u}; else ci.raw[r] = *(const u32x4*)(base + (ptrdiff_t)(r - 3) * NPROJ); }
#pragma unroll
    for (int k = 0; k < 4; ++k) { ci.w[k][0] = *(const f32x4*)(C.conv_w() + k * 1024 + ch8); ci.w[k][1] = *(const f32x4*)(C.conv_w() + k * 1024 + ch8 + 4); }
    ci.b[0] = *(const f32x4*)(C.conv_b() + ch8); ci.b[1] = *(const f32x4*)(C.conv_b() + ch8 + 4);
}
template <int CC> __device__ __forceinline__ void conv_chan(const ConvIn& ci, float (&o)[8]) {
    float x[11];
#pragma unroll
    for (int r = 0; r < 11; ++r) { const unsigned wd = ci.raw[r][CC >> 1]; x[r] = (CC & 1) ? bfhi(wd) : bflo(wd); }
    const float w0 = ci.w[0][CC >> 2][CC & 3], w1 = ci.w[1][CC >> 2][CC & 3], w2 = ci.w[2][CC >> 2][CC & 3], w3 = ci.w[3][CC >> 2][CC & 3], bb = ci.b[CC >> 2][CC & 3];
#pragma unroll
    for (int t = 0; t < 8; ++t) o[t] = silu_f(bb + w0 * x[t] + w1 * x[t + 1] + w2 * x[t + 2] + w3 * x[t + 3]);
}
__device__ __forceinline__ void conv_store_nat(const ConvIn& ci, LAS unsigned char* tile, int tl0, int qc) {
    unsigned pw[8][4];
#define CS_PAIR(P) { float oa[8], ob[8]; conv_chan<2 * P>(ci, oa); conv_chan<2 * P + 1>(ci, ob); _Pragma("unroll") for (int t = 0; t < 8; ++t) pw[t][P] = pk2(oa[t], ob[t]); }
    CS_PAIR(0) CS_PAIR(1) CS_PAIR(2) CS_PAIR(3)
#undef CS_PAIR
#pragma unroll
    for (int t = 0; t < 8; ++t) { u32x4 o; o.x = pw[t][0]; o.y = pw[t][1]; o.z = pw[t][2]; o.w = pw[t][3]; *(LAS u32x4*)(tile + swz(tl0 + t, qc)) = o; }
}
template <bool SCALE> __device__ __forceinline__ void conv_store_tr(const ConvIn& ci, LAS unsigned char* tile, int row0, int qt, const float (&sc)[8]) {
#define CS_COL(CC) { float v[8]; conv_chan<CC>(ci, v); if (SCALE) { _Pragma("unroll") for (int t = 0; t < 8; ++t) v[t] *= sc[t]; } \
        u32x4 o; o.x = pk2(v[0], v[1]); o.y = pk2(v[2], v[3]); o.z = pk2(v[4], v[5]); o.w = pk2(v[6], v[7]); *(LAS u32x4*)(tile + swz2(row0 + CC, qt)) = o; }
    CS_COL(0) CS_COL(1) CS_COL(2) CS_COL(3) CS_COL(4) CS_COL(5) CS_COL(6) CS_COL(7)
#undef CS_COL
}
__device__ __forceinline__ float dt_scan(const Ctx& C, int tok0, int h, int lane, float& dt0, float& dt1, float& ac0, float& ac1) {
    const float bias = C.dt_bias()[h], A = -__expf(C.a_log()[h]);
    const float r0 = C.DTRAW()[(size_t)(tok0 + 2 * lane) * 8 + h] + bias, r1 = C.DTRAW()[(size_t)(tok0 + 2 * lane + 1) * 8 + h] + bias;
    dt0 = r0 > 20.f ? r0 : log1pf(__expf(r0)); dt1 = r1 > 20.f ? r1 : log1pf(__expf(r1));
    const float a0 = dt0 * A, a1 = dt1 * A; float x = a0 + a1;
#pragma unroll
    for (int o = 1; o < 64; o <<= 1) { const float v = __shfl_up(x, o); if (lane >= o) x += v; }
    ac1 = x; ac0 = x - a1;
    return __shfl(x, 63);
}

constexpr int SSD_XT = 0, SSD_BM = 65536, SSD_CM = 98304, SSD_TAB = 131072;

__device__ __forceinline__ void phase_states_fast(const Ctx& C) {
    LAS unsigned char* XT = C.lds + SSD_XT;
    LAS unsigned char* BT = C.lds + SSD_BM;
    LAS float* wtab = (LAS float*)(C.lds + SSD_TAB);
    const int lane_in = C.lane, w = C.wave;
    for (int item = C.bid; item < NBATCH * NCHUNK * 2; item += C.G) {
        const int g = item & 1, bc = item >> 1, tok0 = bc * CHUNK; const bool seq0 = (bc & (NCHUNK - 1)) == 0;
        int lane = lane_in; asm volatile("" : "+v"(lane));
        const int fr = lane & 15, fq = lane >> 4;
        __syncthreads();
        if (w < 4) { float d0, d1, a0, a1; const int h = g * 4 + w; const float tot = dt_scan(C, tok0, h, lane, d0, d1, a0, a1);
            wtab[w * 128 + 2 * lane] = d0 * __expf(tot - a0); wtab[w * 128 + 2 * lane + 1] = d1 * __expf(tot - a1);
            if (lane == 0) C.CHD()[bc * 8 + h] = __expf(tot); }
        __syncthreads();
        { const int cgp = lane & 31, tg = 2 * w + (lane >> 5); ConvIn ci; conv_load(C, ci, tok0 + tg * 8, g * 256 + cgp * 8, seq0 && tg == 0);
            float sc[8]; const int j = cgp >> 3;
#pragma unroll
            for (int i = 0; i < 8; ++i) sc[i] = wtab[j * 128 + tg * 8 + i];
            conv_store_tr<true>(ci, XT, cgp * 8, tg, sc); }
        if (w < 4) { const int cq = lane & 15, tg = 4 * w + (lane >> 4); ConvIn ci; conv_load(C, ci, tok0 + tg * 8, 512 + g * 128 + cq * 8, seq0 && tg == 0);
            float sc[8];
#pragma unroll
            for (int i = 0; i < 8; ++i) sc[i] = 1.f;
            conv_store_tr<false>(ci, BT, cq * 8, tg, sc); }
        __syncthreads();
        f32x4 acc[8][2];
#pragma unroll
        for (int a = 0; a < 8; ++a) { acc[a][0] = (f32x4){0.f, 0.f, 0.f, 0.f}; acc[a][1] = (f32x4){0.f, 0.f, 0.f, 0.f}; }
#pragma unroll
        for (int ks = 0; ks < 4; ++ks) {
            const bf16x8v b0 = *(const LAS bf16x8v*)(XT + swz2(32 * w + fr, 4 * ks + fq)), b1 = *(const LAS bf16x8v*)(XT + swz2(32 * w + 16 + fr, 4 * ks + fq));
#pragma unroll
            for (int a = 0; a < 8; ++a) { const bf16x8v af = *(const LAS bf16x8v*)(BT + swz2(16 * a + fr, 4 * ks + fq));
                acc[a][0] = MFMA16(af, b0, acc[a][0]); acc[a][1] = MFMA16(af, b1, acc[a][1]); }
        }
        float* st = C.STATES() + ((size_t)bc * 8 + g * 4) * 8192;
#pragma unroll
        for (int t = 0; t < 2; ++t) { const int ch = 32 * w + 16 * t + fr;
#pragma unroll
            for (int a = 0; a < 8; ++a) *(f32x4*)(st + (size_t)ch * 128 + 16 * a + 4 * fq) = acc[a][t]; }
    }
}

__device__ __forceinline__ void phase_y_fast(const Ctx& C) {
    LAS unsigned char* XT = C.lds + SSD_XT;
    LAS unsigned char* BM = C.lds + SSD_BM;
    LAS unsigned char* CM = C.lds + SSD_CM;
    LAS unsigned char* PV = C.lds + SSD_BM;
    LAS float* acl = (LAS float*)(C.lds + SSD_TAB);
    LAS float* dtl = acl + 512;
    const int lane_in = C.lane, w = C.wave;
    for (int item = C.bid; item < NBATCH * NCHUNK * 2; item += C.G) {
        const int g = item & 1, bc = item >> 1, tok0 = bc * CHUNK; const bool seq0 = (bc & (NCHUNK - 1)) == 0;
        int lane = lane_in; asm volatile("" : "+v"(lane));
        const int fr = lane & 15, fq = lane >> 4;
        u32x4 pv[8];
        { const u32x4* src = (const u32x4*)(C.PREV() + ((size_t)bc * 8 + g * 4) * 8192);
#pragma unroll
            for (int i = 0; i < 8; ++i) pv[i] = src[C.tid + NTHREADS * i]; }
        __syncthreads();
        if (w < 4) { float d0, d1, a0, a1; (void)dt_scan(C, tok0, g * 4 + w, lane, d0, d1, a0, a1);
            acl[w * 128 + 2 * lane] = a0; acl[w * 128 + 2 * lane + 1] = a1; dtl[w * 128 + 2 * lane] = d0; dtl[w * 128 + 2 * lane + 1] = d1; }
        { const int cgp = lane & 31, tg = 2 * w + (lane >> 5); ConvIn ci; float sc[8];
#pragma unroll
            for (int i = 0; i < 8; ++i) sc[i] = 1.f;
            conv_load(C, ci, tok0 + tg * 8, g * 256 + cgp * 8, seq0 && tg == 0); conv_store_tr<false>(ci, XT, cgp * 8, tg, sc); }
        { const int cq = lane & 15, tg = 4 * (w & 3) + (lane >> 4); ConvIn ci;
            conv_load(C, ci, tok0 + tg * 8, (w < 4 ? 512 : 768) + g * 128 + cq * 8, seq0 && tg == 0); conv_store_nat(ci, w < 4 ? BM : CM, tg * 8, cq); }
        __syncthreads();
        bf16x8v cf[4];
#pragma unroll
        for (int ks = 0; ks < 4; ++ks) cf[ks] = *(const LAS bf16x8v*)(CM + swz(16 * w + fr, 4 * ks + fq));
        f32x4 S[8];
#pragma unroll
        for (int st = 0; st < 8; ++st) { S[st] = (f32x4){0.f, 0.f, 0.f, 0.f};
            if (st <= w) {
#pragma unroll
                for (int ks = 0; ks < 4; ++ks) { const bf16x8v af = *(const LAS bf16x8v*)(BM + swz(16 * st + fr, 4 * ks + fq)); S[st] = MFMA16(af, cf[ks], S[st]); } } }
        __syncthreads();
#pragma unroll
        for (int i = 0; i < 8; ++i) { const int idx = C.tid + NTHREADS * i; *(LAS u32x4*)(PV + swz(idx >> 4, idx & 15)) = pv[i]; }
        __syncthreads();
        const int l = 16 * w + fr;
        f32x4 Y[4][4];
#pragma unroll
        for (int j = 0; j < 4; ++j) {
            const float al = acl[j * 128 + l], el = __expf(al), dsk = C.d_skip()[g * 4 + j];
#pragma unroll
            for (int pt = 0; pt < 4; ++pt) { f32x4 y = (f32x4){0.f, 0.f, 0.f, 0.f};
#pragma unroll
                for (int ks = 0; ks < 4; ++ks) { const bf16x8v af = *(const LAS bf16x8v*)(PV + swz(j * 64 + 16 * pt + fr, 4 * ks + fq)); y = MFMA16(af, cf[ks], y); }
                Y[j][pt] = y * el; }
#pragma unroll
            for (int blk = 0; blk < 4; ++blk) {
                if (2 * blk <= w) {
                    const int s0 = 32 * blk + 4 * fq;
                    const f32x4 as0 = *(const LAS f32x4*)(acl + j * 128 + s0), as1 = *(const LAS f32x4*)(acl + j * 128 + s0 + 16);
                    const f32x4 ds0 = *(const LAS f32x4*)(dtl + j * 128 + s0), ds1 = *(const LAS f32x4*)(dtl + j * 128 + s0 + 16);
                    float gv[8];
#pragma unroll
                    for (int i = 0; i < 4; ++i) { const int sa = s0 + i, sb = s0 + 16 + i;
                        float fa = sa <= l ? S[2 * blk][i] * __expf(al - as0[i]) * ds0[i] : 0.f; if (sa == l) fa += dsk;
                        float fb = sb <= l ? S[2 * blk + 1][i] * __expf(al - as1[i]) * ds1[i] : 0.f; if (sb == l) fb += dsk;
                        gv[i] = fa; gv[4 + i] = fb; }
                    u32x4 gp; gp.x = pk2(gv[0], gv[1]); gp.y = pk2(gv[2], gv[3]); gp.z = pk2(gv[4], gv[5]); gp.w = pk2(gv[6], gv[7]);
                    const bf16x8v gf = __builtin_bit_cast(bf16x8v, gp);
#pragma unroll
                    for (int pt = 0; pt < 4; ++pt) { const int row = j * 64 + 16 * pt + fr;
                        const u32x2 x0 = *(const LAS u32x2*)(XT + swz2(row, 4 * blk + (fq >> 1)) + (fq & 1) * 8), x1 = *(const LAS u32x2*)(XT + swz2(row, 4 * blk + 2 + (fq >> 1)) + (fq & 1) * 8);
                        u32x4 xa; xa.x = x0.x; xa.y = x0.y; xa.z = x1.x; xa.w = x1.y;
                        Y[j][pt] = MFMA16(__builtin_bit_cast(bf16x8v, xa), gf, Y[j][pt]); }
                }
            }
        }
        u32x2 zz[4][4];
        { const bf16* zrow = C.PROJ() + (size_t)(tok0 + l) * NPROJ + PC_Z + g * 256 + 4 * fq;
#pragma unroll
            for (int j = 0; j < 4; ++j)
#pragma unroll
                for (int pt = 0; pt < 4; ++pt) zz[j][pt] = *(const u32x2*)(zrow + j * 64 + 16 * pt); }
        float ss = 0.f;
#pragma unroll
        for (int j = 0; j < 4; ++j)
#pragma unroll
            for (int pt = 0; pt < 4; ++pt) { const u32x2 zv = zz[j][pt]; f32x4 y = Y[j][pt];
                y[0] *= silu_f(bflo(zv.x)); y[1] *= silu_f(bfhi(zv.x)); y[2] *= silu_f(bflo(zv.y)); y[3] *= silu_f(bfhi(zv.y));
                ss += (y[0] * y[0] + y[1] * y[1]) + (y[2] * y[2] + y[3] * y[3]); Y[j][pt] = y; }
        ss += __shfl_xor(ss, 16); ss += __shfl_xor(ss, 32);
        const float rinv = 1.0f / sqrtf(ss * (1.f / 256.f) + RMS_EPS);
        bf16* orow = C.YMIX() + (size_t)(tok0 + l) * DM + g * 256 + 4 * fq; const float* ng = C.ssm_norm_g() + g * 256 + 4 * fq;
        asm volatile("" : "+v"(ng));
#pragma unroll
        for (int j = 0; j < 4; ++j)
#pragma unroll
            for (int pt = 0; pt < 4; ++pt) { const f32x4 nv = *(const f32x4*)(ng + j * 64 + 16 * pt); const f32x4 y = Y[j][pt];
                u32x2 o; o.x = pk2(y[0] * rinv * nv[0], y[1] * rinv * nv[1]); o.y = pk2(y[2] * rinv * nv[2], y[3] * rinv * nv[3]);
                *(u32x2*)(orow + j * 64 + 16 * pt) = o; }
    }
}

__device__ __forceinline__ void phase_pool_fast(const Ctx& C) {
    LAS unsigned char* PM = C.lds;
    LAS unsigned char* WT = C.lds + 32768;
    const int lane = C.lane, w = C.wave, fr = lane & 15, fq = lane >> 4;
    const int g = C.bid & 3, win = 2 << g;
    { const u32x4* src = (const u32x4*)(C.WPOOL() + (size_t)g * 16384);
#pragma unroll
        for (int i = 0; i < 4; ++i) { const int idx = C.tid + NTHREADS * i; *(LAS u32x4*)(WT + swz(idx >> 4, idx & 15)) = src[idx]; } }
    for (int tile = C.bid >> 2; tile < NTOK / 128; tile += (C.G >> 2)) {
        const int tok0 = tile * 128;
        __syncthreads();
        if (C.tid < 256) { const int tg = C.tid >> 4, cq = C.tid & 15; const int tokb = tok0 + tg * 8, tpos = tokb & (SEQ - 1);
            const bf16* up = C.PROJ() + (size_t)tokb * NPROJ + PC_U + g * 128 + cq * 8;
            float s[8];
#pragma unroll
            for (int i = 0; i < 8; ++i) s[i] = 0.f;
            for (int d = 1; d < win; ++d) { if (tpos - d < 0) break; float f[8]; unpack8(*(const u32x4*)(up - (ptrdiff_t)d * NPROJ), f);
#pragma unroll
                for (int i = 0; i < 8; ++i) s[i] += f[i]; }
#pragma unroll
            for (int tt = 0; tt < 8; ++tt) { float f[8]; unpack8(*(const u32x4*)(up + (size_t)tt * NPROJ), f);
                const int t = tpos + tt; const float inv = 1.0f / (float)((t + 1) < win ? (t + 1) : win);
                float o[8];
#pragma unroll
                for (int i = 0; i < 8; ++i) { s[i] += f[i]; o[i] = s[i] * inv - f[i]; }
                u32x4 ov; ov.x = pk2(o[0], o[1]); ov.y = pk2(o[2], o[3]); ov.z = pk2(o[4], o[5]); ov.w = pk2(o[6], o[7]);
                *(LAS u32x4*)(PM + swz(tg * 8 + tt, cq)) = ov;
                if (t - (win - 1) >= 0) { float r[8]; unpack8(*(const u32x4*)(up + ((ptrdiff_t)tt - (win - 1)) * NPROJ), r);
#pragma unroll
                    for (int i = 0; i < 8; ++i) s[i] -= r[i]; } }
        }
        __syncthreads();
        f32x4 acc[8];
#pragma unroll
        for (int a = 0; a < 8; ++a) acc[a] = (f32x4){0.f, 0.f, 0.f, 0.f};
#pragma unroll
        for (int ks = 0; ks < 4; ++ks) { const bf16x8v bfr = *(const LAS bf16x8v*)(PM + swz(16 * w + fr, 4 * ks + fq));
#pragma unroll
            for (int a = 0; a < 8; ++a) { const bf16x8v af = *(const LAS bf16x8v*)(WT + swz(16 * a + fr, 4 * ks + fq)); acc[a] = MFMA16(af, bfr, acc[a]); } }
        bf16* orow = C.YMIX() + (size_t)(tok0 + 16 * w + fr) * DM + 512 + g * 128 + 4 * fq; const float* bp = C.b_pool() + g * 128 + 4 * fq; const float* sp = C.pool_scale() + g * 128 + 4 * fq;
#pragma unroll
        for (int a = 0; a < 8; ++a) { const f32x4 b = *(const f32x4*)(bp + 16 * a), sc = *(const f32x4*)(sp + 16 * a); const f32x4 v = acc[a];
            u32x2 o; o.x = pk2((v[0] + b[0]) * sc[0], (v[1] + b[1]) * sc[1]); o.y = pk2((v[2] + b[2]) * sc[2], (v[3] + b[3]) * sc[3]);
            *(u32x2*)(orow + 16 * a) = o; }
    }
}

__device__ __forceinline__ void phase_ln1_router(const Ctx& C, bool commit = true) {
    LAS float* wr = (LAS float*)C.lds;
    LAS int* rcls = (LAS int*)(C.lds + 20 * 4096);
    LAS float* rw = (LAS float*)(C.lds + 20 * 4096 + 512);
    LAS int* rpos = (LAS int*)(C.lds + 20 * 4096 + 512 + 1024);
    LAS int* lcnt = (LAS int*)(C.lds + 20 * 4096 + 512 + 1024 + 512);
    LAS int* lbase = lcnt + 32;
    for (int i = C.tid; i < 1024 * 4; i += NTHREADS) { const int k = i >> 2, n = i & 3; wr[n * 1024 + k] = C.w_rg()[i]; }
    for (int i = C.tid; i < 1024 * 16; i += NTHREADS) { const int k = i >> 4, n = i & 15; wr[(4 + n) * 1024 + k] = C.w_re()[i]; }
    f32x4 gg[4], bb[4];
#pragma unroll
    for (int j = 0; j < 4; ++j) { gg[j] = *(const f32x4*)(C.ln1_g() + 4 * C.lane + 256 * j); bb[j] = *(const f32x4*)(C.ln1_b() + 4 * C.lane + 256 * j); }
    float brg[4], bre[16];
#pragma unroll
    for (int i = 0; i < 4; ++i) brg[i] = C.b_rg()[i];
#pragma unroll
    for (int i = 0; i < 16; ++i) bre[i] = C.b_re()[i];
    for (int rb = C.bid; rb < NTOK / 128; rb += C.G) {
        __syncthreads();
        if (C.tid < 32) lcnt[C.tid] = 0;
        for (int rr = 0; rr < 16; ++rr) {
            const int r = C.wave * 16 + rr, m = rb * 128 + r;
            const u32x2* xr = (const u32x2*)(C.R1() + (size_t)m * DM) + C.lane;
            f32x4 v[4]; float s = 0.f;
#pragma unroll
            for (int j = 0; j < 4; ++j) { const u32x2 w = xr[64 * j]; v[j] = (f32x4){bflo(w.x), bfhi(w.x), bflo(w.y), bfhi(w.y)}; s += (v[j].x + v[j].y) + (v[j].z + v[j].w); }
            const float mean = wave_sum(s) * (1.f / DM); float s2 = 0.f;
#pragma unroll
            for (int j = 0; j < 4; ++j) { v[j] = v[j] - mean; s2 += (v[j].x * v[j].x + v[j].y * v[j].y) + (v[j].z * v[j].z + v[j].w * v[j].w); }
            const float rstd = 1.f / sqrtf(wave_sum(s2) * (1.f / DM) + LN_EPS);
            u32x2* o8 = (u32x2*)(C.H1() + (size_t)m * DM) + C.lane;
#pragma unroll
            for (int j = 0; j < 4; ++j) { v[j] = v[j] * rstd * gg[j] + bb[j]; u32x2 o; o.x = pk2(v[j].x, v[j].y); o.y = pk2(v[j].z, v[j].w); o8[64 * j] = o; }
            float lg[20];
#pragma unroll
            for (int n = 0; n < 20; ++n) { float a = 0.f;
#pragma unroll
                for (int j = 0; j < 4; ++j) { const f32x4 w = *(const LAS f32x4*)(wr + n * 1024 + 4 * C.lane + 256 * j); a += (v[j].x * w.x + v[j].y * w.y) + (v[j].z * w.z + v[j].w * w.w); }
                lg[n] = wave_sum(a); }
            float g0 = lg[0] + brg[0], g1 = lg[1] + brg[1], g2 = lg[2] + brg[2], g3 = lg[3] + brg[3];
            int gi = 0; float gm = g0; if (g1 > gm) { gm = g1; gi = 1; } if (g2 > gm) { gm = g2; gi = 2; } if (g3 > gm) { gm = g3; gi = 3; }
            const float gwt = 1.0f / (__expf(g0 - gm) + __expf(g1 - gm) + __expf(g2 - gm) + __expf(g3 - gm));
            float e[4];
#pragma unroll
            for (int i = 0; i < 4; ++i) { const float a0 = lg[4 + i] + bre[i], a1 = lg[8 + i] + bre[4 + i], a2 = lg[12 + i] + bre[8 + i], a3 = lg[16 + i] + bre[12 + i]; e[i] = gi == 0 ? a0 : (gi == 1 ? a1 : (gi == 2 ? a2 : a3)); }
            int i1 = 0; float v1 = e[0]; if (e[1] > v1) { v1 = e[1]; i1 = 1; } if (e[2] > v1) { v1 = e[2]; i1 = 2; } if (e[3] > v1) { v1 = e[3]; i1 = 3; }
            int i2 = -1; float v2 = -3.0e38f;
#pragma unroll
            for (int i = 0; i < 4; ++i) if (i != i1 && e[i] > v2) { v2 = e[i]; i2 = i; }
            const float ex = __expf(v2 - v1), p1 = 1.0f / (1.0f + ex), p2 = ex * p1;
            const int il = i1 < i2 ? i1 : i2, ih = i1 < i2 ? i2 : i1; const float wl = (i1 < i2 ? p1 : p2) * gwt, wh = (i1 < i2 ? p2 : p1) * gwt;
            const int q = il == 0 ? ih - 1 : (il == 1 ? ih + 1 : 5);
            if (C.lane == 0) { rcls[r] = gi * 6 + q; rw[r * 2] = wl; rw[r * 2 + 1] = wh; }
        }
        __syncthreads();
        if (!commit) continue;
        if (C.tid < 128) rpos[C.tid] = atomicAdd((int*)&lcnt[rcls[C.tid]], 1);
        __syncthreads();
        if (C.tid < NCLS) lbase[C.tid] = lcnt[C.tid] > 0 ? (int)__hip_atomic_fetch_add(C.ctl() + CW_CNT + C.tid, (unsigned)lcnt[C.tid], __ATOMIC_RELAXED, __HIP_MEMORY_SCOPE_AGENT) : 0;
        __syncthreads();
        if (C.tid < 128) { const int c = rcls[C.tid], pos = lbase[c] + rpos[C.tid];
            if (pos < LISTCAP) { C.LIST()[c * LISTCAP + pos] = rb * 128 + C.tid; C.LW()[((size_t)c * LISTCAP + pos) * 2] = rw[C.tid * 2]; C.LW()[((size_t)c * LISTCAP + pos) * 2 + 1] = rw[C.tid * 2 + 1]; } }
    }
}

__device__ __forceinline__ void phase_ln2(const Ctx& C) {
    const int gw = C.bid * NWAVES + C.wave, NGW = C.G * NWAVES;
    f32x4 gg[4], bb[4];
#pragma unroll
    for (int j = 0; j < 4; ++j) { gg[j] = *(const f32x4*)(C.ln2_g() + 4 * C.lane + 256 * j); bb[j] = *(const f32x4*)(C.ln2_b() + 4 * C.lane + 256 * j); }
    for (int m = gw; m < NTOK; m += NGW) {
        const u32x2* xr = (const u32x2*)(C.R2() + (size_t)m * DM) + C.lane;
        f32x4 v[4]; float s = 0.f;
#pragma unroll
        for (int j = 0; j < 4; ++j) { const u32x2 w = xr[64 * j]; v[j] = (f32x4){bflo(w.x), bfhi(w.x), bflo(w.y), bfhi(w.y)}; s += (v[j].x + v[j].y) + (v[j].z + v[j].w); }
        const float mean = wave_sum(s) * (1.f / DM); float s2 = 0.f;
#pragma unroll
        for (int j = 0; j < 4; ++j) { v[j] = v[j] - mean; s2 += (v[j].x * v[j].x + v[j].y * v[j].y) + (v[j].z * v[j].z + v[j].w * v[j].w); }
        const float rstd = 1.f / sqrtf(wave_sum(s2) * (1.f / DM) + LN_EPS);
        f32x4* o = (f32x4*)(C.out() + (size_t)m * DM) + C.lane;
#pragma unroll
        for (int j = 0; j < 4; ++j) o[64 * j] = v[j] * rstd * gg[j] + bb[j];
    }
}

#define XB_TMO      128
#define XB_XCNT(j)  (256  + 64 * (j))
#define XB_XSUB(j)  (1280 + 64 * (j))
#define XB_XGEN(j)  (2304 + 64 * (j))
#define XB_TOP      3328
#define XB_TOPGEN   3392
#define XCD_BAR_WORDS 3456
#define XB_SPIN_CAP (1u << 18)
constexpr int CW_BAR = 4096;
constexpr int MISC_OFF = LDS_BYTES - 256;
__device__ __forceinline__ unsigned xb_ld(unsigned* p)              { return __hip_atomic_load(p, __ATOMIC_RELAXED, __HIP_MEMORY_SCOPE_AGENT); }
__device__ __forceinline__ unsigned xb_add(unsigned* p, unsigned v) { return __hip_atomic_fetch_add(p, v, __ATOMIC_RELAXED, __HIP_MEMORY_SCOPE_AGENT); }
__device__ __forceinline__ unsigned xb_xcc_id() { return (unsigned)__builtin_amdgcn_s_getreg((3 << 11) | 20) & 0xFu; }
#define XB_SPIN(cond, bar) do { unsigned _sp = 0; while (cond) { __builtin_amdgcn_s_sleep(1); \
    if ((++_sp & 255u) == 0u) { if (xb_ld(&(bar)[XB_TMO])) break; if (_sp > XB_SPIN_CAP) { atomicAdd(&(bar)[XB_TMO], 1u); break; } } } } while (0)
struct XcdBarrier { unsigned* bar; unsigned x; volatile LAS unsigned* st; };
__device__ __forceinline__ XcdBarrier xcd_barrier_post(unsigned* bar, volatile LAS unsigned* st) {
    XcdBarrier b; b.bar = bar; b.x = xb_xcc_id(); b.st = st;
    if (threadIdx.x == 0) (void)xb_add(&bar[XB_XCNT(b.x)], 1u);
    return b;
}
__device__ __forceinline__ void xcd_barrier_complete(unsigned* bar, unsigned x, unsigned& nloc, unsigned& nx) {
    const unsigned G = gridDim.x * gridDim.y * gridDim.z;
    unsigned sum, cnt, mine, sp = 0u;
    for (;;) {
        sum = 0u; cnt = 0u; mine = 0u;
#pragma unroll
        for (unsigned j = 0; j < 16; ++j) { const unsigned c = xb_ld(&bar[XB_XCNT(j)]); sum += c; cnt += (c > 0u) ? 1u : 0u; mine = (j == x) ? c : mine; }
        if (sum == G) break;
        __builtin_amdgcn_s_sleep(1);
        if ((++sp & 255u) == 0u) { if (xb_ld(&bar[XB_TMO])) break; if (sp > XB_SPIN_CAP) { atomicAdd(&bar[XB_TMO], 1u); break; } }
    }
    nloc = mine > 0u ? mine : 1u; nx = cnt > 0u ? cnt : 1u;
}
__device__ __forceinline__ void xcd_barrier(const XcdBarrier& b) {
    asm volatile("s_waitcnt vmcnt(0)" ::: "memory");
    __syncthreads();
    if (threadIdx.x == 0) {
        unsigned* bar = b.bar;
        __builtin_amdgcn_s_waitcnt(0);
        unsigned nloc = b.st[0], nx = b.st[1];
        if (nloc == 0u) { xcd_barrier_complete(bar, b.x, nloc, nx); b.st[0] = nloc; b.st[1] = nx; }
        const unsigned old = xb_add(&bar[XB_XSUB(b.x)], 1u);
        const unsigned gen = old / nloc;
        if (old + 1u == (gen + 1u) * nloc) {
            __builtin_amdgcn_fence(__ATOMIC_RELEASE, "agent");
            asm volatile("s_waitcnt vmcnt(0)" ::: "memory");
            const unsigned og = xb_add(&bar[XB_TOP], 1u);
            const unsigned tg = og / nx;
            if (og + 1u == (tg + 1u) * nx) xb_add(&bar[XB_TOPGEN], 1u);
            else XB_SPIN(xb_ld(&bar[XB_TOPGEN]) == tg, bar);
            __builtin_amdgcn_fence(__ATOMIC_ACQUIRE, "agent");
            xb_add(&bar[XB_XGEN(b.x)], 1u);
            asm volatile("s_waitcnt vmcnt(0)" ::: "memory");
        } else {
            XB_SPIN(xb_ld(&bar[XB_XGEN(b.x)]) == gen, bar);
            __builtin_amdgcn_fence(__ATOMIC_ACQUIRE, "agent");
            asm volatile("s_waitcnt vmcnt(0)" ::: "memory");
        }
    }
    __syncthreads();
}

constexpr int N_PHASES = 10;
#ifndef STAMP_SEL
#define STAMP_SEL -1
#endif
#ifndef STAMP_FROM
#define STAMP_FROM 0
#endif
#ifndef STAMP_UNIT
#define STAMP_UNIT 10.0f
#endif
#ifndef DUP_PHASE
#define DUP_PHASE -1
#endif
template <int LO, int HI> __global__ void __launch_bounds__(NTHREADS, 2) fwd_kernel(Args args) {
    extern __shared__ __attribute__((aligned(16))) unsigned char lds_raw[];
    Ctx C;
    C.lds = (LAS unsigned char*)lds_raw;
    C.tid = threadIdx.x; C.lane = C.tid & 63; C.wave = __builtin_amdgcn_readfirstlane(C.tid >> 6); C.G = gridDim.x; C.bid = blockIdx.x;
    C.a = &args; C.ws = args.ws;
    const LAS MoeTab* tb = (const LAS MoeTab*)(C.lds + MOETAB_OFF);
    XcdBarrier bar; bar.bar = C.ctl() + CW_BAR; bar.x = 0; bar.st = nullptr;
    if constexpr (HI - LO > 1) {
        volatile LAS unsigned* misc = (volatile LAS unsigned*)(C.lds + MISC_OFF);
        if (C.tid < 64) misc[C.tid] = 0u;
        __syncthreads();
        bar = xcd_barrier_post(C.ctl() + CW_BAR, misc + 8);
    }
#define IN(k) (LO <= (k) && (k) < HI)
    unsigned long long t_from = 0ull, t_sel = 0ull;
#define STAMP(k) do { if (STAMP_SEL >= 0) { if ((k) == STAMP_FROM) t_from = __builtin_amdgcn_s_memrealtime(); if ((k) == STAMP_SEL + 1) t_sel = __builtin_amdgcn_s_memrealtime(); } } while (0)
#define SEAM(k) do { if constexpr (IN(k) && IN((k) + 1)) xcd_barrier(bar); } while (0)
#define REP(k) for (int rep_ = 0; rep_ < ((k) == DUP_PHASE ? 2 : 1); ++rep_)
#define FRESH() do { int t_ = threadIdx.x; asm volatile("" : "+v"(t_)); C.tid = t_; C.lane = t_ & 63; } while (0)
    STAMP(0);
    FRESH();
    if constexpr (IN(0)) REP(0) { phase_prep(C); if (DUP_PHASE == 0) __syncthreads(); }
    SEAM(0);
    STAMP(1);
    FRESH();
    if constexpr (IN(1)) REP(1) { ProbDense P{C.XN(), C.WIN(), NTOK / 256, NPROJ / 256, DM, C.G, C.bid}; EpiStoreBf16 E{C.PROJ(), NPROJ}; pg8::gemm_phase(C.lds, P, E); }
    SEAM(1);
    STAMP(2);
    FRESH();
    if constexpr (IN(2)) { REP(21) phase_states_fast(C); __syncthreads(); REP(22) phase_pool_fast(C); }
    SEAM(2);
    STAMP(3);
    FRESH();
    if constexpr (IN(3)) REP(3) phase_scan(C);
    SEAM(3);
    STAMP(4);
    FRESH();
    if constexpr (IN(4)) REP(4) phase_y_fast(C);
    SEAM(4);
    STAMP(5);
    FRESH();
    if constexpr (IN(5)) REP(5) { ProbDense P{C.YMIX(), C.WOUT(), NTOK / 256, DM / 256, DM, C.G, C.bid}; EpiResBf16 E{C.XN(), C.R1()}; pg8::gemm_phase(C.lds, P, E); }
    SEAM(5);
    STAMP(6);
    FRESH();
    if constexpr (IN(6)) { if (DUP_PHASE == 6) { phase_ln1_router(C, false); __syncthreads(); } phase_ln1_router(C, true); }
    SEAM(6);
    STAMP(7);
    FRESH();
    if constexpr (IN(7)) { build_moetab(C); REP(7) { ProbMoe1 P{C.H1(), C.WGU(), C.LIST(), tb, C.G, C.bid}; EpiMoe1 E{C.HB(), C.LW(), tb}; pg8::gemm_phase(C.lds, P, E); } }
    SEAM(7);
    STAMP(8);
    FRESH();
    if constexpr (IN(8)) { build_moetab(C); REP(8) { ProbMoe2 P{C.HB(), C.WD(), tb, C.G, C.bid}; EpiMoe2 E{C.H1(), C.R2(), C.LIST(), tb}; pg8::gemm_phase(C.lds, P, E); } }
    SEAM(8);
    STAMP(9);
    FRESH();
    if constexpr (IN(9)) REP(9) phase_ln2(C);
    if (STAMP_SEL >= 0) { asm volatile("s_waitcnt vmcnt(0)" ::: "memory"); __syncthreads(); STAMP(10);
        if (blockIdx.x == 0 && threadIdx.x == 0) { asm volatile("s_waitcnt lgkmcnt(0)" ::: "memory"); C.out()[0] = (float)(t_sel - t_from) * (0.01f / STAMP_UNIT); } }
#undef IN
#undef SEAM
#undef REP
#undef FRESH
#undef STAMP
}

#ifndef ONE_LAUNCH
#define ONE_LAUNCH 1
#endif
template <int P, int Q> static void launch_phase(int grid, hipStream_t stream, const Args& a) {
    static bool attr = false;
    if (!attr) { (void)hipFuncSetAttribute((const void*)fwd_kernel<P, Q>, hipFuncAttributeMaxDynamicSharedMemorySize, LDS_BYTES); (void)hipGetLastError(); attr = true; }
    hipLaunchKernelGGL((fwd_kernel<P, Q>), dim3(grid), dim3(NTHREADS), LDS_BYTES, stream, a);
}

extern "C" void kernel_launch(void* const* d_in, const int* in_sizes, int n_in, void* d_out, int out_size, void* d_ws, size_t ws_size, hipStream_t stream) {
    static int grid = 0;
    if (grid == 0) {
        if (n_in != 25 || in_sizes[0] != NTOK * DM || out_size != NTOK * DM || ws_size < WS_END) { fprintf(stderr, "kernel_launch: unexpected shapes (n_in %d, in0 %d, out %d, ws %zu)\n", n_in, n_in > 0 ? in_sizes[0] : -1, out_size, ws_size); grid = -1; return; }
        int dev = 0, cus = 0;
        if (hipGetDevice(&dev) != hipSuccess || hipDeviceGetAttribute(&cus, hipDeviceAttributeMultiprocessorCount, dev) != hipSuccess) { grid = -1; return; }
        (void)hipGetLastError();
        grid = cus > 0 ? cus : 256;
    }
    if (grid < 0) return;
    (void)hipMemsetAsync((char*)d_ws + WS_CTL, 0, CTL_ZERO_BYTES, stream);
    Args a{};
    for (int i = 0; i < 25; ++i) a.in[i] = (const float*)d_in[i];
    a.out = (float*)d_out; a.ws = (unsigned char*)d_ws;
#if ONE_LAUNCH
    launch_phase<0, N_PHASES>(grid, stream, a);
#else
    launch_phase<0, 1>(grid, stream, a); launch_phase<1, 2>(grid, stream, a); launch_phase<2, 3>(grid, stream, a); launch_phase<3, 4>(grid, stream, a); launch_phase<4, 5>(grid, stream, a);
    launch_phase<5, 6>(grid, stream, a); launch_phase<6, 7>(grid, stream, a); launch_phase<7, 8>(grid, stream, a); launch_phase<8, 9>(grid, stream, a); launch_phase<9, 10>(grid, stream, a);
#endif
}
```

```cpp
#include <hip/hip_runtime.h>
#include <cstdio>
#include <cstdint>

#define GAS __attribute__((address_space(1)))
#define LAS __attribute__((address_space(3)))
typedef unsigned short bf16;
typedef float f32x4 __attribute__((ext_vector_type(4)));
typedef float f32x2 __attribute__((ext_vector_type(2)));
typedef unsigned u32x4 __attribute__((ext_vector_type(4)));
typedef unsigned u32x2 __attribute__((ext_vector_type(2)));

constexpr int NTOK = 32768, DM = 1024, SEQ = 2048, NBATCH = 16, NPROJ = 2048, DINP = 2056;
constexpr int NCHUNK = 16, CHUNK = 128, NHEAD = 8, HP = 64, NST = 128;
constexpr int NCLS = 24, LISTCAP = 32768, MAXT256 = 160;
constexpr float LN_EPS = 1e-5f, RMS_EPS = 1e-5f;
constexpr float ALPHA = 1.189207115002721f;

constexpr int PC_Z = 0, PC_X = 512, PC_B = 1024, PC_C = 1280, PC_U = 1536;

constexpr size_t MiB = 1u << 20;
constexpr size_t WS_CTL = 0, CTL_ZERO_BYTES = 1 * MiB;
constexpr size_t WS_WIN = 2 * MiB;
constexpr size_t WS_WOUT = 6 * MiB;
constexpr size_t WS_WPOOL = 8 * MiB;
constexpr size_t WS_WGU = 10 * MiB;
constexpr size_t WS_WD = 42 * MiB;
constexpr size_t WS_DTRAW = 58 * MiB;
constexpr size_t WS_DTV = 59 * MiB;
constexpr size_t WS_ACL = 60 * MiB;
constexpr size_t WS_CHD = 61 * MiB;
constexpr size_t WS_RWT = 61 * MiB + 65536;
constexpr size_t WS_LIST = 62 * MiB;
constexpr size_t WS_LW = 65 * MiB;
constexpr size_t WS_XN = 72 * MiB;
constexpr size_t WS_PROJ = 136 * MiB;
constexpr size_t WS_YMIX = 264 * MiB;
constexpr size_t WS_STATES = 328 * MiB;
constexpr size_t WS_PREV = 392 * MiB;
constexpr size_t WS_XBCC = 424 * MiB;
constexpr size_t WS_R1 = WS_PROJ;
constexpr size_t WS_H1 = WS_PROJ + 64 * MiB;
constexpr size_t WS_HB = WS_STATES;
constexpr size_t WS_R2 = WS_XN;
constexpr size_t WS_PWIN = WS_STATES;
constexpr size_t WS_YG = WS_STATES;
constexpr size_t WS_END = 488 * MiB;
constexpr int CW_CNT = 1024;

constexpr int LDS_BYTES = 147456;
constexpr int NTHREADS = 512, NWAVES = 8;

__device__ __forceinline__ unsigned f2bf(float f) { unsigned u = __builtin_bit_cast(unsigned, f); return (u + 0x7fffu + ((u >> 16) & 1u)) >> 16; }
__device__ __forceinline__ unsigned pk2(float lo, float hi) { unsigned r; asm("v_cvt_pk_bf16_f32 %0, %1, %2" : "=v"(r) : "v"(lo), "v"(hi)); return r; }
__device__ __forceinline__ float bf2f(bf16 h) { return __uint_as_float((unsigned)h << 16); }
__device__ __forceinline__ float bflo(unsigned w) { return __uint_as_float(w << 16); }
__device__ __forceinline__ float bfhi(unsigned w) { return __uint_as_float(w & 0xffff0000u); }
__device__ __forceinline__ float wave_sum(float v) {
#pragma unroll
    for (int o = 1; o < 64; o <<= 1) v += __shfl_xor(v, o);
    return v;
}
__device__ __forceinline__ float silu_f(float v) { return v * __builtin_amdgcn_rcpf(1.0f + __builtin_amdgcn_exp2f(-1.4426950408889634f * v)); }
__device__ __forceinline__ void unpack8(const u32x4 v, float (&f)[8]) {
    f[0] = bflo(v.x); f[1] = bfhi(v.x); f[2] = bflo(v.y); f[3] = bfhi(v.y); f[4] = bflo(v.z); f[5] = bfhi(v.z); f[6] = bflo(v.w); f[7] = bfhi(v.w);
}

struct Args { const float* in[25]; float* out; unsigned char* ws; int ph_lo, ph_hi; };

struct Ctx {
    const Args* a; unsigned char* ws; LAS unsigned char* lds;
    int tid, lane, wave, G, bid;
    __device__ __forceinline__ const float* x() const { return a->in[0]; }
    __device__ __forceinline__ const float* ln0_g() const { return a->in[1]; }
    __device__ __forceinline__ const float* ln0_b() const { return a->in[2]; }
    __device__ __forceinline__ const float* w_in() const { return a->in[3]; }
    __device__ __forceinline__ const float* conv_w() const { return a->in[4]; }
    __device__ __forceinline__ const float* conv_b() const { return a->in[5]; }
    __device__ __forceinline__ const float* dt_bias() const { return a->in[6]; }
    __device__ __forceinline__ const float* a_log() const { return a->in[7]; }
    __device__ __forceinline__ const float* d_skip() const { return a->in[8]; }
    __device__ __forceinline__ const float* ssm_norm_g() const { return a->in[9]; }
    __device__ __forceinline__ const float* w_pool() const { return a->in[10]; }
    __device__ __forceinline__ const float* b_pool() const { return a->in[11]; }
    __device__ __forceinline__ const float* pool_scale() const { return a->in[12]; }
    __device__ __forceinline__ const float* w_out() const { return a->in[13]; }
    __device__ __forceinline__ const float* ln1_g() const { return a->in[14]; }
    __device__ __forceinline__ const float* ln1_b() const { return a->in[15]; }
    __device__ __forceinline__ const float* w_rg() const { return a->in[16]; }
    __device__ __forceinline__ const float* b_rg() const { return a->in[17]; }
    __device__ __forceinline__ const float* w_re() const { return a->in[18]; }
    __device__ __forceinline__ const float* b_re() const { return a->in[19]; }
    __device__ __forceinline__ const float* w_gate() const { return a->in[20]; }
    __device__ __forceinline__ const float* w_up() const { return a->in[21]; }
    __device__ __forceinline__ const float* w_down() const { return a->in[22]; }
    __device__ __forceinline__ const float* ln2_g() const { return a->in[23]; }
    __device__ __forceinline__ const float* ln2_b() const { return a->in[24]; }
    __device__ __forceinline__ float* out() const { return a->out; }
    __device__ __forceinline__ unsigned* ctl() const { return (unsigned*)(ws + WS_CTL); }
    __device__ __forceinline__ bf16* WIN() const { return (bf16*)(ws + WS_WIN); }
    __device__ __forceinline__ bf16* WOUT() const { return (bf16*)(ws + WS_WOUT); }
    __device__ __forceinline__ bf16* WPOOL() const { return (bf16*)(ws + WS_WPOOL); }
    __device__ __forceinline__ bf16* WGU() const { return (bf16*)(ws + WS_WGU); }
    __device__ __forceinline__ bf16* WD() const { return (bf16*)(ws + WS_WD); }
    __device__ __forceinline__ bf16* XN() const { return (bf16*)(ws + WS_XN); }
    __device__ __forceinline__ bf16* PROJ() const { return (bf16*)(ws + WS_PROJ); }
    __device__ __forceinline__ bf16* YMIX() const { return (bf16*)(ws + WS_YMIX); }
    __device__ __forceinline__ bf16* PREV() const { return (bf16*)(ws + WS_PREV); }
    __device__ __forceinline__ bf16* XBCC() const { return (bf16*)(ws + WS_XBCC); }
    __device__ __forceinline__ bf16* R1() const { return (bf16*)(ws + WS_R1); }
    __device__ __forceinline__ bf16* H1() const { return (bf16*)(ws + WS_H1); }
    __device__ __forceinline__ bf16* HB() const { return (bf16*)(ws + WS_HB); }
    __device__ __forceinline__ bf16* R2() const { return (bf16*)(ws + WS_R2); }
    __device__ __forceinline__ bf16* PWIN() const { return (bf16*)(ws + WS_PWIN); }
    __device__ __forceinline__ float* DTRAW() const { return (float*)(ws + WS_DTRAW); }
    __device__ __forceinline__ float* DTV() const { return (float*)(ws + WS_DTV); }
    __device__ __forceinline__ float* ACL() const { return (float*)(ws + WS_ACL); }
    __device__ __forceinline__ float* CHD() const { return (float*)(ws + WS_CHD); }
    __device__ __forceinline__ float* STATES() const { return (float*)(ws + WS_STATES); }
    __device__ __forceinline__ float* LW() const { return (float*)(ws + WS_LW); }
    __device__ __forceinline__ float* YG() const { return (float*)(ws + WS_YG); }
    __device__ __forceinline__ bf16* RWT() const { return (bf16*)(ws + WS_RWT); }
    __device__ __forceinline__ int* LIST() const { return (int*)(ws + WS_LIST); }
};

struct TrItem { const float* src; bf16* dst; int ld_src, ld_dst; };
__device__ __forceinline__ void tr_load(const TrItem& t, int lane, f32x4 (&v)[8]) {
    const float* p = t.src + (size_t)(lane >> 3) * t.ld_src + 4 * (lane & 7);
#pragma unroll
    for (int i = 0; i < 8; ++i) v[i] = *(const f32x4*)(p + (size_t)(8 * i) * t.ld_src);
}
__device__ __forceinline__ void tr_store(const TrItem& t, int lane, const f32x4 (&v)[8], LAS float* scr) {
    const int r = lane >> 3, c4 = lane & 7;
#pragma unroll
    for (int i = 0; i < 8; ++i) { LAS float* d = scr + (8 * i + r) * 33 + 4 * c4; d[0] = v[i][0]; d[1] = v[i][1]; d[2] = v[i][2]; d[3] = v[i][3]; }
    asm volatile("s_waitcnt lgkmcnt(0)" ::: "memory");
    const int c = lane & 7;
#pragma unroll
    for (int j = 0; j < 4; ++j) { const int n = (lane >> 3) + 8 * j; const LAS float* s = scr + (8 * c) * 33 + n;
        u32x4 o; o.x = pk2(s[0 * 33], s[1 * 33]); o.y = pk2(s[2 * 33], s[3 * 33]); o.z = pk2(s[4 * 33], s[5 * 33]); o.w = pk2(s[6 * 33], s[7 * 33]);
        *(u32x4*)(t.dst + (size_t)n * t.ld_dst + 8 * c) = o; }
    asm volatile("s_waitcnt lgkmcnt(0)" ::: "memory");
}
constexpr int I_WIN = 16 * 64, I_WOUT = 16 * 32, I_WPOOL = 4 * 2 * 4, I_WGU = 16 * 16 * 32, I_WD = 16 * 8 * 32;
constexpr int TR_NITEMS = I_WIN + I_WOUT + I_WPOOL + I_WGU + I_WD;
__device__ __forceinline__ TrItem tr_decode(const Ctx& C, int it) {
    TrItem t; int r = it;
    if (r < I_WIN) { const int kb = r / 64, nb = r % 64, n0 = nb * 32, n0s = n0 + (n0 >= 1536 ? 8 : 0);
        t.src = C.w_in() + (size_t)(kb * 64) * DINP + n0s; t.ld_src = DINP; t.dst = C.WIN() + (size_t)n0 * 1024 + kb * 64; t.ld_dst = 1024; return t; }
    r -= I_WIN;
    if (r < I_WOUT) { const int kb = r / 32, nb = r % 32;
        t.src = C.w_out() + (size_t)(kb * 64) * 1024 + nb * 32; t.ld_src = 1024; t.dst = C.WOUT() + (size_t)(nb * 32) * 1024 + kb * 64; t.ld_dst = 1024; return t; }
    r -= I_WOUT;
    if (r < I_WPOOL) { const int g = r / 8, kb = (r % 8) / 4, nb = r % 4;
        t.src = C.w_pool() + (size_t)g * 16384 + (size_t)(kb * 64) * 128 + nb * 32; t.ld_src = 128; t.dst = C.WPOOL() + (size_t)g * 16384 + (size_t)(nb * 32) * 128 + kb * 64; t.ld_dst = 128; return t; }
    r -= I_WPOOL;
    if (r < I_WGU) { const int e = r / 512, q = r % 512, kb = q / 32, nb = q % 32;
        const int row0 = nb * 32, tt = row0 >> 8, half = (row0 >> 7) & 1, i0 = row0 & 127;
        t.src = (half ? C.w_up() : C.w_gate()) + (size_t)e * 1024 * 512 + (size_t)(kb * 64) * 512 + 128 * tt + i0; t.ld_src = 512;
        t.dst = C.WGU() + (size_t)e * 1048576 + (size_t)row0 * 1024 + kb * 64; t.ld_dst = 1024; return t; }
    r -= I_WGU;
    { const int e = r / 256, q = r % 256, kb = q / 32, nb = q % 32;
        t.src = C.w_down() + (size_t)e * 524288 + (size_t)(kb * 64) * 1024 + nb * 32; t.ld_src = 1024; t.dst = C.WD() + (size_t)e * 524288 + (size_t)(nb * 32) * 512 + kb * 64; t.ld_dst = 512; return t; }
}

__device__ __forceinline__ void phase_prep(const Ctx& C) {
    LAS float* scr = (LAS float*)(C.lds + C.wave * 8704);
    LAS float* wdt = (LAS float*)(C.lds + 8 * 8704);
    const int gw = C.bid * NWAVES + C.wave, NGW = C.G * NWAVES;
    for (int i = C.tid; i < 8 * 1024; i += NTHREADS) { const int k = i >> 3, n = i & 7; wdt[n * 1024 + k] = C.w_in()[(size_t)k * DINP + 1536 + n]; }
    { const int gt = C.bid * NTHREADS + C.tid;
        if (gt < 20 * 1024) { const int n = gt >> 10, k = gt & 1023; const float v = n < 4 ? C.w_rg()[k * 4 + n] : C.w_re()[k * 16 + (n - 4)];
            const unsigned hi = f2bf(v); const float lo = v - __uint_as_float(hi << 16); C.RWT()[gt] = (bf16)hi; C.RWT()[20 * 1024 + gt] = (bf16)f2bf(lo); } }
    {
        f32x4 va[8], vb[8]; TrItem ta, tb2; int it = gw;
        if (it < TR_NITEMS) { ta = tr_decode(C, it); tr_load(ta, C.lane, va); }
        while (it < TR_NITEMS) {
            const int n1 = it + NGW; if (n1 < TR_NITEMS) { tb2 = tr_decode(C, n1); tr_load(tb2, C.lane, vb); }
            tr_store(ta, C.lane, va, scr);
            const int n2 = n1 + NGW; if (n1 >= TR_NITEMS) break;
            if (n2 < TR_NITEMS) { ta = tr_decode(C, n2); tr_load(ta, C.lane, va); }
            tr_store(tb2, C.lane, vb, scr);
            it = n2;
        }
    }
    __syncthreads();
    f32x4 gg[4], bb[4];
#pragma unroll
    for (int j = 0; j < 4; ++j) { gg[j] = *(const f32x4*)(C.ln0_g() + 4 * C.lane + 256 * j); bb[j] = *(const f32x4*)(C.ln0_b() + 4 * C.lane + 256 * j); }
    for (int m0 = gw; m0 < NTOK; m0 += 4 * NGW) {
        f32x4 vv[4][4];
#pragma unroll
        for (int b = 0; b < 4; ++b) { const int m = m0 + b * NGW; if (m < NTOK) { const f32x4* xr = (const f32x4*)(C.x() + (size_t)m * DM) + C.lane;
#pragma unroll
                for (int j = 0; j < 4; ++j) vv[b][j] = xr[64 * j]; } }
#pragma unroll
        for (int b = 0; b < 4; ++b) { const int m = m0 + b * NGW; if (m >= NTOK) break;
            f32x4 v[4]; float s = 0.f;
#pragma unroll
            for (int j = 0; j < 4; ++j) { v[j] = vv[b][j]; s += (v[j].x + v[j].y) + (v[j].z + v[j].w); }
            const float mean = wave_sum(s) * (1.f / DM); float s2 = 0.f;
#pragma unroll
            for (int j = 0; j < 4; ++j) { v[j] = v[j] - mean; s2 += (v[j].x * v[j].x + v[j].y * v[j].y) + (v[j].z * v[j].z + v[j].w * v[j].w); }
            const float rstd = 1.f / sqrtf(wave_sum(s2) * (1.f / DM) + LN_EPS);
            unsigned long long* o8 = (unsigned long long*)(C.XN() + (size_t)m * DM) + C.lane;
#pragma unroll
            for (int j = 0; j < 4; ++j) { v[j] = v[j] * rstd * gg[j] + bb[j];
                o8[64 * j] = (unsigned long long)pk2(v[j].x, v[j].y) | ((unsigned long long)pk2(v[j].z, v[j].w) << 32); }
            float d[8]; const LAS float* wd = wdt + 4 * C.lane; asm volatile("" : "+v"(wd));
#pragma unroll
            for (int n = 0; n < 8; ++n) { float a = 0.f;
#pragma unroll
                for (int j = 0; j < 4; ++j) { const f32x4 w = *(const LAS f32x4*)(wd + n * 1024 + 256 * j); a += (v[j].x * w.x + v[j].y * w.y) + (v[j].z * w.z + v[j].w * w.w); }
                d[n] = wave_sum(a); }
            if (C.lane == 0) { *(f32x4*)(C.DTRAW() + (size_t)m * 8) = (f32x4){d[0], d[1], d[2], d[3]}; *(f32x4*)(C.DTRAW() + (size_t)m * 8 + 4) = (f32x4){d[4], d[5], d[6], d[7]}; }
        }
    }
}

struct MoeTab { int ntiles; int cnt[NCLS]; int cls[MAXT256]; int row0[MAXT256]; };
constexpr int MOETAB_OFF = 140 * 1024;
__device__ __forceinline__ void class_experts(int c, int& elo, int& ehi) {
    const int g = c / 6, q = c % 6; const int il = q < 3 ? 0 : (q < 5 ? 1 : 2); const int ih = q < 3 ? q + 1 : (q < 5 ? q - 1 : 3);
    elo = g * 4 + il; ehi = g * 4 + ih;
}
__device__ __forceinline__ void build_moetab(const Ctx& C) {
    LAS MoeTab* tb = (LAS MoeTab*)(C.lds + MOETAB_OFF);
    if (C.tid == 0) {
        int nt = 0;
        for (int c = 0; c < NCLS; ++c) { int n = (int)__hip_atomic_load(C.ctl() + CW_CNT + c, __ATOMIC_RELAXED, __HIP_MEMORY_SCOPE_AGENT); if (n > LISTCAP) n = LISTCAP; tb->cnt[c] = n;
            for (int r = 0; r < n; r += 256) { if (nt < MAXT256) { tb->cls[nt] = c; tb->row0[nt] = r; ++nt; } } }
        tb->ntiles = nt;
    }
    __syncthreads();
}

namespace pg8 {
typedef short bf16x8 __attribute__((ext_vector_type(8)));
constexpr int BM = 256, BK = 64, HALF = 128, HTB = HALF * BK * 2, STAGE_BYTES = 8 * HTB, NXCD = 8, WGM = 8;
__host__ __device__ __forceinline__ int lds_byte(int r, int c) { const int st = (r >> 4) * 2 + (c >> 5), rr = r & 15, cc = c & 31, ob = rr * 64 + cc * 2; return st * 1024 + (ob ^ (((ob >> 9) & 1) << 5)); }
__host__ __device__ __forceinline__ void stage_rc(int b, int& R, int& C) { const int st = b / 1024, sb = b % 1024, swz = sb ^ (((sb >> 9) & 1) << 5); R = (st >> 1) * 16 + swz / 64; C = (st & 1) * 32 + (swz % 64) / 2; }
__host__ __device__ __forceinline__ int perm32(int rho) { const int n = rho >> 4, i = rho & 15; return 8 * (i >> 2) + 4 * n + (i & 3); }
struct Unit { int pm, pn, xa, xb; };
__device__ __forceinline__ bool order_next(int i, int G, int c, int nM, int nN, Unit& u) {
    const int nwg = nM * nN; const long L = (long)i * G + c; if (L >= nwg) return false;
    int wgid = (int)L; { const int q = nwg / NXCD, r = nwg % NXCD, xcd = wgid % NXCD, off = wgid / NXCD; wgid = (xcd < r ? xcd * (q + 1) : r * (q + 1) + (xcd - r) * q) + off; }
    const int nig = WGM * nN, gid = wgid / nig, fm = gid * WGM, gsz = (nM - fm) < WGM ? (nM - fm) : WGM;
    u.pm = fm + ((wgid % nig) % gsz); u.pn = (wgid % nig) / gsz; return true;
}
__device__ __forceinline__ unsigned cvt_pk_bf16(float lo, float hi) { unsigned r; asm volatile("v_cvt_pk_bf16_f32 %0, %1, %2" : "=v"(r) : "v"(lo), "v"(hi)); return r; }

template <class Prob, class Epi>
__device__ __forceinline__ void gemm_phase(LAS unsigned char* lds, const Prob& P, const Epi& E) {
    constexpr bool GA = Prob::GATHER;
    int tid = threadIdx.x; asm volatile("" : "+v"(tid));
    const int wid = __builtin_amdgcn_readfirstlane(tid >> 6), lane = tid & 63, wr = wid >> 2, wc = wid & 3, fr = lane & 15, fq = lane >> 4;
    const int nt = P.ktiles();
    const unsigned ldb = P.ldb_bytes();
    unsigned voffB[2], voffA[2];
#pragma unroll
    for (int i = 0; i < 2; ++i) { int R, Cc; stage_rc(tid * 16 + i * 8192, R, Cc); const int Rb = (R & ~31) + perm32(R & 31); voffB[i] = (unsigned)Rb * ldb + (unsigned)Cc * 2u;
        voffA[i] = GA ? 0u : P.a_voff_dense(R, Cc); }
    const unsigned hstepB = 128u * ldb;
    const unsigned ldsw = (unsigned)wid * 1024u;
    const int aoff = lds_byte(wr * 64 + fr, fq * 8), boff = lds_byte(wc * 32 + fr, fq * 8);
#define PG8_SA(b, h) (((b) * 2 + (h)) * HTB)
#define PG8_SB(b, h) ((4 + (b) * 2 + (h)) * HTB)
#define PG8_STAGE(bufoff, gbase, voff) do { _Pragma("unroll") for (int _i = 0; _i < 2; ++_i) \
        __builtin_amdgcn_global_load_lds((const unsigned*)((const char*)(gbase) + (voff)[_i]), (LAS unsigned*)(lds + (bufoff) + ldsw + _i * 8192), 16, 0, 0); } while (0)
#define PG8_LDA(dst, b, h) do { _Pragma("unroll") for (int m = 0; m < 4; ++m) _Pragma("unroll") for (int k = 0; k < 2; ++k) dst[m][k] = *(const LAS bf16x8*)(lds + PG8_SA(b, h) + aoff + m * 2048 + k * 1024); } while (0)
#define PG8_LDB(dst, b, h) do { _Pragma("unroll") for (int n = 0; n < 2; ++n) _Pragma("unroll") for (int k = 0; k < 2; ++k) dst[n][k] = *(const LAS bf16x8*)(lds + PG8_SB(b, h) + boff + n * 2048 + k * 1024); } while (0)
#define PG8_MMA(ai, bj, At, Bt) do { __builtin_amdgcn_s_setprio(1); _Pragma("unroll") for (int m = 0; m < 4; ++m) _Pragma("unroll") for (int n = 0; n < 2; ++n) _Pragma("unroll") for (int k = 0; k < 2; ++k) \
        acc[ai][bj][m][n] = __builtin_amdgcn_mfma_f32_16x16x32_bf16(Bt[n][k], At[m][k], acc[ai][bj][m][n], 0, 0, 0); __builtin_amdgcn_s_setprio(0); } while (0)
#define PG8_WAIT_V(n) asm volatile("s_waitcnt vmcnt(" #n ")" ::: "memory")
#define PG8_WAIT_L(n) asm volatile("s_waitcnt lgkmcnt(" #n ")" ::: "memory")
#define PG8_BAR __builtin_amdgcn_s_barrier()
#define PG8_SCHED __builtin_amdgcn_sched_barrier(0)
    Unit cur, nxt; int ui = 0;
    if (!P.next(0, cur)) return;
    f32x4 acc[2][2][4][2];
#pragma unroll
    for (int a = 0; a < 2; ++a)
#pragma unroll
        for (int b = 0; b < 2; ++b)
#pragma unroll
            for (int m = 0; m < 4; ++m)
#pragma unroll
                for (int n = 0; n < 2; ++n) acc[a][b][m][n] = (f32x4){0.f, 0.f, 0.f, 0.f};
    bf16x8 At[4][2], B0[2][2], B1[2][2];
    unsigned vc0[2], vc1[2], vn0[2], vn1[2];
    const char* cA0; const char* cA1; const char* nA0; const char* nA1;
    if constexpr (GA) { cA0 = cA1 = nA0 = nA1 = P.a_base();
#pragma unroll
        for (int i = 0; i < 2; ++i) { int R, Cc; stage_rc(tid * 16 + i * 8192, R, Cc); vc0[i] = P.a_voff(cur, 0, R, Cc); vc1[i] = P.a_voff(cur, 1, R, Cc); vn0[i] = vc0[i]; vn1[i] = vc1[i]; }
    } else { cA0 = P.a_half(cur, 0); cA1 = P.a_half(cur, 1); nA0 = cA0; nA1 = cA1;
#pragma unroll
        for (int i = 0; i < 2; ++i) { vc0[i] = vc1[i] = vn0[i] = vn1[i] = voffA[i]; } }
    const size_t kstep = (size_t)(BK * 2);
    {
        const char* cB0 = P.b_tile(cur, 0); const char* cB1 = P.b_tile(cur, 1);
        PG8_STAGE(PG8_SB(0, 0), cB0, voffB); PG8_STAGE(PG8_SB(0, 1), cB0 + hstepB, voffB); PG8_STAGE(PG8_SA(0, 0), cA0, vc0); PG8_STAGE(PG8_SA(0, 1), cA1, vc1);
        if (wr == 1) PG8_BAR;
        PG8_WAIT_V(2); PG8_BAR;
        PG8_STAGE(PG8_SB(1, 0), cB1, voffB); PG8_STAGE(PG8_SA(1, 0), cA0 + kstep, vc0); PG8_STAGE(PG8_SB(1, 1), cB1 + hstepB, voffB);
        PG8_WAIT_V(6); PG8_BAR;
    }
    for (;;) {
        const bool has_next = P.next(ui + 1, nxt);
        if (!has_next) nxt = cur;
        if constexpr (!GA) { nA0 = P.a_half(nxt, 0); nA1 = P.a_half(nxt, 1); }
        for (int t = 0; t < nt; t += 2) {
            const bool last = (t == nt - 2);
            if constexpr (GA) { if (last) {
#pragma unroll
                for (int i = 0; i < 2; ++i) { int R, Cc; stage_rc(tid * 16 + i * 8192, R, Cc); vn0[i] = P.a_voff(nxt, 0, R, Cc); vn1[i] = P.a_voff(nxt, 1, R, Cc); } } }
            const char* a11 = cA1 + (size_t)(t + 1) * kstep;
            const char* a20 = last ? nA0 : cA0 + (size_t)(t + 2) * kstep; const char* a21 = last ? nA1 : cA1 + (size_t)(t + 2) * kstep;
            const char* a30 = a20 + kstep;
            const char* b2 = last ? P.b_tile(nxt, 0) : P.b_tile(cur, t + 2); const char* b3 = last ? P.b_tile(nxt, 1) : P.b_tile(cur, t + 3);
            PG8_LDB(B0, 0, 0); PG8_LDB(B1, 0, 1); PG8_SCHED; PG8_LDA(At, 0, 0); PG8_STAGE(PG8_SA(1, 1), a11, vc1);
            if constexpr (GA) { if (last) {
#pragma unroll
                for (int i = 0; i < 2; ++i) { vc0[i] = vn0[i]; vc1[i] = vn1[i]; } } }
            PG8_WAIT_V(8); PG8_WAIT_L(0); PG8_BAR; PG8_MMA(0, 0, At, B0); PG8_MMA(0, 1, At, B1); PG8_BAR; PG8_SCHED;
            PG8_LDA(At, 0, 1); PG8_STAGE(PG8_SB(0, 0), b2, voffB); PG8_STAGE(PG8_SB(0, 1), b2 + hstepB, voffB); PG8_STAGE(PG8_SA(0, 0), a20, vc0);
            PG8_WAIT_V(8); PG8_WAIT_L(0); PG8_BAR; PG8_MMA(1, 0, At, B0); PG8_MMA(1, 1, At, B1); PG8_BAR; PG8_SCHED;
            PG8_LDB(B0, 1, 0); PG8_LDB(B1, 1, 1); PG8_SCHED; PG8_LDA(At, 1, 0); PG8_STAGE(PG8_SA(0, 1), a21, vc1);
            PG8_WAIT_V(8); PG8_WAIT_L(0); PG8_BAR; PG8_MMA(0, 0, At, B0); PG8_MMA(0, 1, At, B1); PG8_BAR; PG8_SCHED;
            PG8_LDA(At, 1, 1); PG8_STAGE(PG8_SB(1, 0), b3, voffB); PG8_STAGE(PG8_SB(1, 1), b3 + hstepB, voffB); PG8_STAGE(PG8_SA(1, 0), a30, vc0);
            PG8_WAIT_V(8); PG8_WAIT_L(0); PG8_BAR; PG8_MMA(1, 0, At, B0); PG8_MMA(1, 1, At, B1); PG8_BAR; PG8_SCHED;
        }
        if (wr == 0) PG8_BAR;
        E(acc, cur, wr, wc, fr, fq);
        if (!has_next) break;
#pragma unroll
        for (int a = 0; a < 2; ++a)
#pragma unroll
            for (int b = 0; b < 2; ++b)
#pragma unroll
                for (int m = 0; m < 4; ++m)
#pragma unroll
                    for (int n = 0; n < 2; ++n) acc[a][b][m][n] = (f32x4){0.f, 0.f, 0.f, 0.f};
        cur = nxt; ++ui; cA0 = nA0; cA1 = nA1;
        if (wr == 1) PG8_BAR;
    }
    PG8_WAIT_V(0);
    PG8_BAR;
#undef PG8_SA
#undef PG8_SB
#undef PG8_STAGE
#undef PG8_LDA
#undef PG8_LDB
#undef PG8_MMA
#undef PG8_WAIT_V
#undef PG8_WAIT_L
#undef PG8_BAR
#undef PG8_SCHED
}
}

struct ProbDense {
    static constexpr bool GATHER = false;
    const bf16* A; const bf16* Bt; int nM, nN, K, G, c;
    __device__ __forceinline__ bool next(int i, pg8::Unit& u) const { return pg8::order_next(i, G, c, nM, nN, u); }
    __device__ __forceinline__ int ktiles() const { return K / 64; }
    __device__ __forceinline__ unsigned ldb_bytes() const { return (unsigned)K * 2u; }
    __device__ __forceinline__ unsigned a_voff_dense(int R, int Cc) const { return ((unsigned)R * (unsigned)K + (unsigned)Cc) * 2u; }
    __device__ __forceinline__ const char* a_half(const pg8::Unit& u, int h) const { return (const char*)A + (size_t)(u.pm * 256 + h * 128) * K * 2; }
    __device__ __forceinline__ const char* a_base() const { return (const char*)A; }
    __device__ __forceinline__ unsigned a_voff(const pg8::Unit&, int, int, int) const { return 0u; }
    __device__ __forceinline__ const char* b_tile(const pg8::Unit& u, int kt) const { return (const char*)Bt + ((size_t)u.pn * 256 * K + (size_t)kt * 64) * 2; }
};
struct EpiStoreBf16 {
    bf16* O; int ldc;
    __device__ __forceinline__ void operator()(const f32x4 (&acc)[2][2][4][2], const pg8::Unit& u, int wr, int wc, int fr, int fq) const {
        const int row0 = u.pm * 256 + wr * 64 + fr, col0 = u.pn * 256 + wc * 32 + 8 * fq;
#pragma unroll
        for (int ai = 0; ai < 2; ++ai)
#pragma unroll
            for (int m = 0; m < 4; ++m) { bf16* rowp = O + (size_t)(row0 + ai * 128 + m * 16) * ldc + col0;
#pragma unroll
                for (int bj = 0; bj < 2; ++bj) { const f32x4 v0 = acc[ai][bj][m][0], v1 = acc[ai][bj][m][1];
                    u32x4 w; w.x = pg8::cvt_pk_bf16(v0[0], v0[1]); w.y = pg8::cvt_pk_bf16(v0[2], v0[3]); w.z = pg8::cvt_pk_bf16(v1[0], v1[1]); w.w = pg8::cvt_pk_bf16(v1[2], v1[3]);
                    *(u32x4*)(rowp + bj * 128) = w; } }
    }
};
struct EpiResBf16 {
    const bf16* X; bf16* O;
    __device__ __forceinline__ void operator()(const f32x4 (&acc)[2][2][4][2], const pg8::Unit& u, int wr, int wc, int fr, int fq) const {
        const int row0 = u.pm * 256 + wr * 64 + fr, col0 = u.pn * 256 + wc * 32 + 8 * fq;
#pragma unroll
        for (int ai = 0; ai < 2; ++ai)
#pragma unroll
            for (int m = 0; m < 4; ++m) { const size_t off = (size_t)(row0 + ai * 128 + m * 16) * DM + col0;
#pragma unroll
                for (int bj = 0; bj < 2; ++bj) { const f32x4 v0 = acc[ai][bj][m][0], v1 = acc[ai][bj][m][1]; const u32x4 xv = *(const u32x4*)(X + off + bj * 128);
                    u32x4 w; w.x = pg8::cvt_pk_bf16(ALPHA * bflo(xv.x) + v0[0], ALPHA * bfhi(xv.x) + v0[1]); w.y = pg8::cvt_pk_bf16(ALPHA * bflo(xv.y) + v0[2], ALPHA * bfhi(xv.y) + v0[3]);
                    w.z = pg8::cvt_pk_bf16(ALPHA * bflo(xv.z) + v1[0], ALPHA * bfhi(xv.z) + v1[1]); w.w = pg8::cvt_pk_bf16(ALPHA * bflo(xv.w) + v1[2], ALPHA * bfhi(xv.w) + v1[3]);
                    *(u32x4*)(O + off + bj * 128) = w; } }
    }
};

struct ProbMoe1 {
    static constexpr bool GATHER = true;
    const bf16* H1; const bf16* WGU; const int* LIST; const LAS MoeTab* tb; int G, c;
    __device__ __forceinline__ bool next(int i, pg8::Unit& u) const { if (!pg8::order_next(i, G, c, tb->ntiles, 8, u)) return false;
        const int cl = tb->cls[u.pm]; int elo, ehi; class_experts(cl, elo, ehi); u.xa = elo | (ehi << 8) | (cl << 16); u.xb = tb->row0[u.pm]; return true; }
    __device__ __forceinline__ int ktiles() const { return 16; }
    __device__ __forceinline__ unsigned ldb_bytes() const { return 2048u; }
    __device__ __forceinline__ unsigned a_voff_dense(int, int) const { return 0u; }
    __device__ __forceinline__ const char* a_half(const pg8::Unit&, int) const { return (const char*)H1; }
    __device__ __forceinline__ const char* a_base() const { return (const char*)H1; }
    __device__ __forceinline__ unsigned a_voff(const pg8::Unit& u, int h, int R, int Cc) const { const int cl = u.xa >> 16; int rr = u.xb + h * 128 + R; if (rr >= tb->cnt[cl]) rr = u.xb;
        const unsigned tok = (unsigned)LIST[cl * LISTCAP + rr]; return (tok * 1024u + (unsigned)Cc) * 2u; }
    __device__ __forceinline__ const char* b_tile(const pg8::Unit& u, int kt) const { const int e = (u.pn < 4) ? (u.xa & 255) : ((u.xa >> 8) & 255);
        return (const char*)WGU + ((size_t)e * 1048576 + (size_t)(u.pn & 3) * 262144 + (size_t)kt * 64) * 2; }
};
struct EpiMoe1 {
    bf16* HB; const float* LW; const LAS MoeTab* tb;
    __device__ __forceinline__ void operator()(const f32x4 (&acc)[2][2][4][2], const pg8::Unit& u, int wr, int wc, int fr, int fq) const {
        const int cl = u.xa >> 16, cnt = tb->cnt[cl], slot = u.pn >> 2; const int col0 = slot * 512 + (u.pn & 3) * 128 + wc * 32 + 8 * fq;
#pragma unroll
        for (int ai = 0; ai < 2; ++ai)
#pragma unroll
            for (int m = 0; m < 4; ++m) { const int r = ai * 128 + wr * 64 + m * 16 + fr, rr = u.xb + r; const float w = rr < cnt ? LW[((size_t)cl * LISTCAP + rr) * 2 + slot] : 0.f;
                const f32x4 g0 = acc[ai][0][m][0], g1 = acc[ai][0][m][1], u0 = acc[ai][1][m][0], u1 = acc[ai][1][m][1];
                u32x4 o; o.x = pg8::cvt_pk_bf16(w * silu_f(g0[0]) * u0[0], w * silu_f(g0[1]) * u0[1]); o.y = pg8::cvt_pk_bf16(w * silu_f(g0[2]) * u0[2], w * silu_f(g0[3]) * u0[3]);
                o.z = pg8::cvt_pk_bf16(w * silu_f(g1[0]) * u1[0], w * silu_f(g1[1]) * u1[1]); o.w = pg8::cvt_pk_bf16(w * silu_f(g1[2]) * u1[2], w * silu_f(g1[3]) * u1[3]);
                *(u32x4*)(HB + (size_t)(u.pm * 256 + r) * DM + col0) = o; }
    }
};
struct ProbMoe2 {
    static constexpr bool GATHER = false;
    const bf16* HB; const bf16* WD; const LAS MoeTab* tb; int G, c;
    __device__ __forceinline__ bool next(int i, pg8::Unit& u) const { if (!pg8::order_next(i, G, c, tb->ntiles, 4, u)) return false;
        const int cl = tb->cls[u.pm]; int elo, ehi; class_experts(cl, elo, ehi); u.xa = elo | (ehi << 8) | (cl << 16); u.xb = tb->row0[u.pm]; return true; }
    __device__ __forceinline__ int ktiles() const { return 16; }
    __device__ __forceinline__ unsigned ldb_bytes() const { return 1024u; }
    __device__ __forceinline__ unsigned a_voff_dense(int R, int Cc) const { return ((unsigned)R * 1024u + (unsigned)Cc) * 2u; }
    __device__ __forceinline__ const char* a_half(const pg8::Unit& u, int h) const { return (const char*)HB + (size_t)(u.pm * 256 + h * 128) * 2048; }
    __device__ __forceinline__ const char* a_base() const { return (const char*)HB; }
    __device__ __forceinline__ unsigned a_voff(const pg8::Unit&, int, int, int) const { return 0u; }
    __device__ __forceinline__ const char* b_tile(const pg8::Unit& u, int kt) const { const int e = (kt < 8) ? (u.xa & 255) : ((u.xa >> 8) & 255);
        return (const char*)WD + ((size_t)e * 524288 + (size_t)u.pn * 131072 + (size_t)(kt & 7) * 64) * 2; }
};
struct EpiMoe2 {
    const bf16* H1; bf16* R2; const int* LIST; const LAS MoeTab* tb;
    __device__ __forceinline__ void operator()(const f32x4 (&acc)[2][2][4][2], const pg8::Unit& u, int wr, int wc, int fr, int fq) const {
        const int cl = u.xa >> 16, cnt = tb->cnt[cl]; const int col0 = u.pn * 256 + wc * 32 + 8 * fq;
#pragma unroll
        for (int ai = 0; ai < 2; ++ai)
#pragma unroll
            for (int m = 0; m < 4; ++m) { const int r = ai * 128 + wr * 64 + m * 16 + fr, rr = u.xb + r; if (rr >= cnt) continue;
                const size_t off = (size_t)LIST[cl * LISTCAP + rr] * DM + col0;
#pragma unroll
                for (int bj = 0; bj < 2; ++bj) { const f32x4 v0 = acc[ai][bj][m][0], v1 = acc[ai][bj][m][1]; const u32x4 xv = *(const u32x4*)(H1 + off + bj * 128);
                    u32x4 w; w.x = pg8::cvt_pk_bf16(ALPHA * bflo(xv.x) + v0[0], ALPHA * bfhi(xv.x) + v0[1]); w.y = pg8::cvt_pk_bf16(ALPHA * bflo(xv.y) + v0[2], ALPHA * bfhi(xv.y) + v0[3]);
                    w.z = pg8::cvt_pk_bf16(ALPHA * bflo(xv.z) + v1[0], ALPHA * bfhi(xv.z) + v1[1]); w.w = pg8::cvt_pk_bf16(ALPHA * bflo(xv.w) + v1[2], ALPHA * bfhi(xv.w) + v1[3]);
                    *(u32x4*)(R2 + off + bj * 128) = w; } }
    }
};

__device__ __forceinline__ void phase_scan(const Ctx& C) {
    const int gt = C.bid * NTHREADS + C.tid, NGT = C.G * NTHREADS;
    for (int task = gt; task < NBATCH * NHEAD * 2048; task += NGT) {
        const int e4 = task & 2047, bh = task >> 11, b = bh >> 3, h = bh & 7;
        f32x4 run = (f32x4){0.f, 0.f, 0.f, 0.f};
        f32x4 st[NCHUNK]; float dec[NCHUNK];
#pragma unroll
        for (int c = 0; c < NCHUNK; ++c) { const size_t item = (size_t)((b * NCHUNK + c) * 8 + h); st[c] = *(const f32x4*)(C.STATES() + item * 8192 + e4 * 4); dec[c] = C.CHD()[item]; }
#pragma unroll
        for (int c = 0; c < NCHUNK; ++c) { const size_t item = (size_t)((b * NCHUNK + c) * 8 + h);
            u32x2 o; o.x = pk2(run.x, run.y); o.y = pk2(run.z, run.w); *(u32x2*)(C.PREV() + item * 8192 + e4 * 4) = o;
            run = run * dec[c] + st[c]; }
    }
}
typedef short bf16x8v __attribute__((ext_vector_type(8)));
typedef short bf16x4v __attribute__((ext_vector_type(4)));
#define MFMA16(a, b, c) __builtin_amdgcn_mfma_f32_16x16x32_bf16((a), (b), (c), 0, 0, 0)
__device__ __forceinline__ int swz(int row, int q) { return row * 256 + ((q ^ (row & 15)) << 4); }
__device__ __forceinline__ int swz2(int row, int q) { return row * 256 + ((q ^ ((row ^ (row >> 4)) & 15)) << 4); }

struct ConvIn { u32x4 raw[11]; f32x4 w[4][2]; f32x4 b[2]; };
__device__ __forceinline__ void conv_load(const Ctx& C, ConvIn& ci, int tokb, int ch8, bool zero3) {
    const bf16* base = C.PROJ() + (size_t)tokb * NPROJ + PC_X + ch8;
#pragma unroll
    for (int r = 0; r < 11; ++r) { if (r < 3 && zero3) ci.raw[r] = (u32x4){0u, 0u, 0u, 0u}; else ci.raw[r] = *(const u32x4*)(base + (ptrdiff_t)(r - 3) * NPROJ); }
#pragma unroll
    for (int k = 0; k < 4; ++k) { ci.w[k][0] = *(const f32x4*)(C.conv_w() + k * 1024 + ch8); ci.w[k][1] = *(const f32x4*)(C.conv_w() + k * 1024 + ch8 + 4); }
    ci.b[0] = *(const f32x4*)(C.conv_b() + ch8); ci.b[1] = *(const f32x4*)(C.conv_b() + ch8 + 4);
}
template <int CC> __device__ __forceinline__ void conv_chan(const ConvIn& ci, float (&o)[8]) {
    float x[11];
#pragma unroll
    for (int r = 0; r < 11; ++r) { const unsigned wd = ci.raw[r][CC >> 1]; x[r] = (CC & 1) ? bfhi(wd) : bflo(wd); }
    const float w0 = ci.w[0][CC >> 2][CC & 3], w1 = ci.w[1][CC >> 2][CC & 3], w2 = ci.w[2][CC >> 2][CC & 3], w3 = ci.w[3][CC >> 2][CC & 3], bb = ci.b[CC >> 2][CC & 3];
#pragma unroll
    for (int t = 0; t < 8; ++t) o[t] = silu_f(bb + w0 * x[t] + w1 * x[t + 1] + w2 * x[t + 2] + w3 * x[t + 3]);
}
__device__ __forceinline__ void conv_store_nat(const ConvIn& ci, LAS unsigned char* tile, int tl0, int qc) {
    unsigned pw[8][4];
#define CS_PAIR(P) { float oa[8], ob[8]; conv_chan<2 * P>(ci, oa); conv_chan<2 * P + 1>(ci, ob); _Pragma("unroll") for (int t = 0; t < 8; ++t) pw[t][P] = pk2(oa[t], ob[t]); }
    CS_PAIR(0) CS_PAIR(1) CS_PAIR(2) CS_PAIR(3)
#undef CS_PAIR
#pragma unroll
    for (int t = 0; t < 8; ++t) { u32x4 o; o.x = pw[t][0]; o.y = pw[t][1]; o.z = pw[t][2]; o.w = pw[t][3]; *(LAS u32x4*)(tile + swz(tl0 + t, qc)) = o; }
}
template <bool SCALE> __device__ __forceinline__ void conv_store_tr(const ConvIn& ci, LAS unsigned char* tile, int row0, int qt, const float (&sc)[8]) {
#define CS_COL(CC) { float v[8]; conv_chan<CC>(ci, v); if (SCALE) { _Pragma("unroll") for (int t = 0; t < 8; ++t) v[t] *= sc[t]; } \
        u32x4 o; o.x = pk2(v[0], v[1]); o.y = pk2(v[2], v[3]); o.z = pk2(v[4], v[5]); o.w = pk2(v[6], v[7]); *(LAS u32x4*)(tile + swz2(row0 + CC, qt)) = o; }
    CS_COL(0) CS_COL(1) CS_COL(2) CS_COL(3) CS_COL(4) CS_COL(5) CS_COL(6) CS_COL(7)
#undef CS_COL
}
__device__ __forceinline__ float dt_scan(const Ctx& C, int tok0, int h, int lane, float& dt0, float& dt1, float& ac0, float& ac1) {
    const float bias = C.dt_bias()[h], A = -__expf(C.a_log()[h]);
    const float r0 = C.DTRAW()[(size_t)(tok0 + 2 * lane) * 8 + h] + bias, r1 = C.DTRAW()[(size_t)(tok0 + 2 * lane + 1) * 8 + h] + bias;
    dt0 = r0 > 20.f ? r0 : log1pf(__expf(r0)); dt1 = r1 > 20.f ? r1 : log1pf(__expf(r1));
    const float a0 = dt0 * A, a1 = dt1 * A; float x = a0 + a1;
#pragma unroll
    for (int o = 1; o < 64; o <<= 1) { const float v = __shfl_up(x, o); if (lane >= o) x += v; }
    ac1 = x; ac0 = x - a1;
    return __shfl(x, 63);
}

constexpr int SSD_XT = 0, SSD_BM = 65536, SSD_CM = 98304, SSD_TAB = 131072;

__device__ __forceinline__ void phase_states_fast(const Ctx& C) {
    LAS unsigned char* XT = C.lds + SSD_XT;
    LAS unsigned char* BT = C.lds + SSD_BM;
    LAS float* wtab = (LAS float*)(C.lds + SSD_TAB);
    const int lane_in = C.lane, w = C.wave;
    for (int item = C.bid; item < NBATCH * NCHUNK * 2; item += C.G) {
        const int g = item & 1, bc = item >> 1, tok0 = bc * CHUNK; const bool seq0 = (bc & (NCHUNK - 1)) == 0;
        int lane = lane_in; asm volatile("" : "+v"(lane));
        const int fr = lane & 15, fq = lane >> 4;
        __syncthreads();
        if (w < 4) { float d0, d1, a0, a1; const int h = g * 4 + w; const float tot = dt_scan(C, tok0, h, lane, d0, d1, a0, a1);
            wtab[w * 128 + 2 * lane] = d0 * __expf(tot - a0); wtab[w * 128 + 2 * lane + 1] = d1 * __expf(tot - a1);
            if (lane == 0) C.CHD()[bc * 8 + h] = __expf(tot); }
        __syncthreads();
        { const int cgp = lane & 31, tg = 2 * w + (lane >> 5); ConvIn ci; conv_load(C, ci, tok0 + tg * 8, g * 256 + cgp * 8, seq0 && tg == 0);
            float sc[8]; const int j = cgp >> 3;
#pragma unroll
            for (int i = 0; i < 8; ++i) sc[i] = wtab[j * 128 + tg * 8 + i];
            conv_store_tr<true>(ci, XT, cgp * 8, tg, sc); }
        if (w < 4) { const int cq = lane & 15, tg = 4 * w + (lane >> 4); ConvIn ci; conv_load(C, ci, tok0 + tg * 8, 512 + g * 128 + cq * 8, seq0 && tg == 0);
            float sc[8];
#pragma unroll
            for (int i = 0; i < 8; ++i) sc[i] = 1.f;
            conv_store_tr<false>(ci, BT, cq * 8, tg, sc); }
        __syncthreads();
        f32x4 acc[8][2];
#pragma unroll
        for (int a = 0; a < 8; ++a) { acc[a][0] = (f32x4){0.f, 0.f, 0.f, 0.f}; acc[a][1] = (f32x4){0.f, 0.f, 0.f, 0.f}; }
#pragma unroll
        for (int ks = 0; ks < 4; ++ks) {
            const bf16x8v b0 = *(const LAS bf16x8v*)(XT + swz2(32 * w + fr, 4 * ks + fq)), b1 = *(const LAS bf16x8v*)(XT + swz2(32 * w + 16 + fr, 4 * ks + fq));
#pragma unroll
            for (int a = 0; a < 8; ++a) { const bf16x8v af = *(const LAS bf16x8v*)(BT + swz2(16 * a + fr, 4 * ks + fq));
                acc[a][0] = MFMA16(af, b0, acc[a][0]); acc[a][1] = MFMA16(af, b1, acc[a][1]); }
        }
        float* st = C.STATES() + ((size_t)bc * 8 + g * 4) * 8192;
#pragma unroll
        for (int t = 0; t < 2; ++t) { const int ch = 32 * w + 16 * t + fr;
#pragma unroll
            for (int a = 0; a < 8; ++a) *(f32x4*)(st + (size_t)ch * 128 + 16 * a + 4 * fq) = acc[a][t]; }
    }
}

__device__ __forceinline__ void phase_y_fast(const Ctx& C) {
    LAS unsigned char* XT = C.lds + SSD_XT;
    LAS unsigned char* BM = C.lds + SSD_BM;
    LAS unsigned char* CM = C.lds + SSD_CM;
    LAS unsigned char* PV = C.lds + SSD_BM;
    LAS float* acl = (LAS float*)(C.lds + SSD_TAB);
    LAS float* dtl = acl + 512;
    const int lane_in = C.lane, w = C.wave;
    for (int item = C.bid; item < NBATCH * NCHUNK * 2; item += C.G) {
        const int g = item & 1, bc = item >> 1, tok0 = bc * CHUNK; const bool seq0 = (bc & (NCHUNK - 1)) == 0;
        int lane = lane_in; asm volatile("" : "+v"(lane));
        const int fr = lane & 15, fq = lane >> 4;
        u32x4 pv[8];
        { const u32x4* src = (const u32x4*)(C.PREV() + ((size_t)bc * 8 + g * 4) * 8192);
#pragma unroll
            for (int i = 0; i < 8; ++i) pv[i] = src[C.tid + NTHREADS * i]; }
        __syncthreads();
        if (w < 4) { float d0, d1, a0, a1; (void)dt_scan(C, tok0, g * 4 + w, lane, d0, d1, a0, a1);
            acl[w * 128 + 2 * lane] = a0; acl[w * 128 + 2 * lane + 1] = a1; dtl[w * 128 + 2 * lane] = d0; dtl[w * 128 + 2 * lane + 1] = d1; }
        { const int cgp = lane & 31, tg = 2 * w + (lane >> 5); ConvIn ci; float sc[8];
#pragma unroll
            for (int i = 0; i < 8; ++i) sc[i] = 1.f;
            conv_load(C, ci, tok0 + tg * 8, g * 256 + cgp * 8, seq0 && tg == 0); conv_store_tr<false>(ci, XT, cgp * 8, tg, sc); }
        { const int cq = lane & 15, tg = 4 * (w & 3) + (lane >> 4); ConvIn ci;
            conv_load(C, ci, tok0 + tg * 8, (w < 4 ? 512 : 768) + g * 128 + cq * 8, seq0 && tg == 0); conv_store_nat(ci, w < 4 ? BM : CM, tg * 8, cq); }
        __syncthreads();
        bf16x8v cf[4];
#pragma unroll
        for (int ks = 0; ks < 4; ++ks) cf[ks] = *(const LAS bf16x8v*)(CM + swz(16 * w + fr, 4 * ks + fq));
        f32x4 S[8];
#pragma unroll
        for (int st = 0; st < 8; ++st) { S[st] = (f32x4){0.f, 0.f, 0.f, 0.f};
            if (st <= w) {
#pragma unroll
                for (int ks = 0; ks < 4; ++ks) { const bf16x8v af = *(const LAS bf16x8v*)(BM + swz(16 * st + fr, 4 * ks + fq)); S[st] = MFMA16(af, cf[ks], S[st]); } } }
        __syncthreads();
#pragma unroll
        for (int i = 0; i < 8; ++i) { const int idx = C.tid + NTHREADS * i; *(LAS u32x4*)(PV + swz(idx >> 4, idx & 15)) = pv[i]; }
        __syncthreads();
        const int l = 16 * w + fr;
        f32x4 Y[4][4];
#pragma unroll
        for (int j = 0; j < 4; ++j) {
            const float al = acl[j * 128 + l], el = __expf(al), dsk = C.d_skip()[g * 4 + j];
#pragma unroll
            for (int pt = 0; pt < 4; ++pt) { f32x4 y = (f32x4){0.f, 0.f, 0.f, 0.f};
#pragma unroll
                for (int ks = 0; ks < 4; ++ks) { const bf16x8v af = *(const LAS bf16x8v*)(PV + swz(j * 64 + 16 * pt + fr, 4 * ks + fq)); y = MFMA16(af, cf[ks], y); }
                Y[j][pt] = y * el; }
#pragma unroll
            for (int blk = 0; blk < 4; ++blk) {
                if (2 * blk <= w) {
                    const int s0 = 32 * blk + 4 * fq;
                    const f32x4 as0 = *(const LAS f32x4*)(acl + j * 128 + s0), as1 = *(const LAS f32x4*)(acl + j * 128 + s0 + 16);
                    const f32x4 ds0 = *(const LAS f32x4*)(dtl + j * 128 + s0), ds1 = *(const LAS f32x4*)(dtl + j * 128 + s0 + 16);
                    float gv[8];
#pragma unroll
                    for (int i = 0; i < 4; ++i) { const int sa = s0 + i, sb = s0 + 16 + i;
                        float fa = sa <= l ? S[2 * blk][i] * __expf(al - as0[i]) * ds0[i] : 0.f; if (sa == l) fa += dsk;
                        float fb = sb <= l ? S[2 * blk + 1][i] * __expf(al - as1[i]) * ds1[i] : 0.f; if (sb == l) fb += dsk;
                        gv[i] = fa; gv[4 + i] = fb; }
                    u32x4 gp; gp.x = pk2(gv[0], gv[1]); gp.y = pk2(gv[2], gv[3]); gp.z = pk2(gv[4], gv[5]); gp.w = pk2(gv[6], gv[7]);
                    const bf16x8v gf = __builtin_bit_cast(bf16x8v, gp);
#pragma unroll
                    for (int pt = 0; pt < 4; ++pt) { const int row = j * 64 + 16 * pt + fr;
                        const u32x2 x0 = *(const LAS u32x2*)(XT + swz2(row, 4 * blk + (fq >> 1)) + (fq & 1) * 8), x1 = *(const LAS u32x2*)(XT + swz2(row, 4 * blk + 2 + (fq >> 1)) + (fq & 1) * 8);
                        u32x4 xa; xa.x = x0.x; xa.y = x0.y; xa.z = x1.x; xa.w = x1.y;
                        Y[j][pt] = MFMA16(__builtin_bit_cast(bf16x8v, xa), gf, Y[j][pt]); }
                }
            }
        }
        u32x2 zz[4][4];
        { const bf16* zrow = C.PROJ() + (size_t)(tok0 + l) * NPROJ + PC_Z + g * 256 + 4 * fq;
#pragma unroll
            for (int j = 0; j < 4; ++j)
#pragma unroll
                for (int pt = 0; pt < 4; ++pt) zz[j][pt] = *(const u32x2*)(zrow + j * 64 + 16 * pt); }
        float ss = 0.f;
#pragma unroll
        for (int j = 0; j < 4; ++j)
#pragma unroll
            for (int pt = 0; pt < 4; ++pt) { const u32x2 zv = zz[j][pt]; f32x4 y = Y[j][pt];
                y[0] *= silu_f(bflo(zv.x)); y[1] *= silu_f(bfhi(zv.x)); y[2] *= silu_f(bflo(zv.y)); y[3] *= silu_f(bfhi(zv.y));
                ss += (y[0] * y[0] + y[1] * y[1]) + (y[2] * y[2] + y[3] * y[3]); Y[j][pt] = y; }
        ss += __shfl_xor(ss, 16); ss += __shfl_xor(ss, 32);
        const float rinv = 1.0f / sqrtf(ss * (1.f / 256.f) + RMS_EPS);
        bf16* orow = C.YMIX() + (size_t)(tok0 + l) * DM + g * 256 + 4 * fq; const float* ng = C.ssm_norm_g() + g * 256 + 4 * fq;
        asm volatile("" : "+v"(ng));
#pragma unroll
        for (int j = 0; j < 4; ++j)
#pragma unroll
            for (int pt = 0; pt < 4; ++pt) { const f32x4 nv = *(const f32x4*)(ng + j * 64 + 16 * pt); const f32x4 y = Y[j][pt];
                u32x2 o; o.x = pk2(y[0] * rinv * nv[0], y[1] * rinv * nv[1]); o.y = pk2(y[2] * rinv * nv[2], y[3] * rinv * nv[3]);
                *(u32x2*)(orow + j * 64 + 16 * pt) = o; }
    }
}

template <int WIN> __device__ __forceinline__ void pool_window_task(const Ctx& C, LAS unsigned char* PM, int tok0, int g, int tid) {
    const int tg = tid >> 4, cq = tid & 15, tokb = tok0 + tg * 4, tpos = tokb & (SEQ - 1);
    const bf16* up = C.PROJ() + (size_t)tokb * NPROJ + PC_U + g * 128 + cq * 8;
    u32x4 raw[WIN + 3];
#pragma unroll
    for (int r = 0; r < WIN + 3; ++r) { const int d = r - (WIN - 1); if (tpos + d >= 0) raw[r] = *(const u32x4*)(up + (ptrdiff_t)d * NPROJ); else raw[r] = (u32x4){0u, 0u, 0u, 0u}; }
    float s[8];
#pragma unroll
    for (int i = 0; i < 8; ++i) s[i] = 0.f;
#pragma unroll
    for (int r = 0; r < WIN - 1; ++r) { float f[8]; unpack8(raw[r], f);
#pragma unroll
        for (int i = 0; i < 8; ++i) s[i] += f[i]; }
#pragma unroll
    for (int tt = 0; tt < 4; ++tt) { float f[8]; unpack8(raw[WIN - 1 + tt], f);
        const int t = tpos + tt; const float inv = 1.0f / (float)((t + 1) < WIN ? (t + 1) : WIN);
        float o[8];
#pragma unroll
        for (int i = 0; i < 8; ++i) { s[i] += f[i]; o[i] = s[i] * inv - f[i]; }
        u32x4 ov; ov.x = pk2(o[0], o[1]); ov.y = pk2(o[2], o[3]); ov.z = pk2(o[4], o[5]); ov.w = pk2(o[6], o[7]);
        *(LAS u32x4*)(PM + swz(tg * 4 + tt, cq)) = ov;
        float r8[8]; unpack8(raw[tt], r8);
#pragma unroll
        for (int i = 0; i < 8; ++i) s[i] -= r8[i]; }
}
__device__ __forceinline__ void phase_pool_fast(const Ctx& C) {
    LAS unsigned char* PM = C.lds;
    LAS unsigned char* WT = C.lds + 32768;
    const int lane = C.lane, w = C.wave, fr = lane & 15, fq = lane >> 4;
    const int g = C.bid & 3;
    { const u32x4* src = (const u32x4*)(C.WPOOL() + (size_t)g * 16384);
#pragma unroll
        for (int i = 0; i < 4; ++i) { const int idx = C.tid + NTHREADS * i; *(LAS u32x4*)(WT + swz(idx >> 4, idx & 15)) = src[idx]; } }
    for (int tile = C.bid >> 2; tile < NTOK / 128; tile += (C.G >> 2)) {
        const int tok0 = tile * 128;
        __syncthreads();
        if (g == 0) pool_window_task<2>(C, PM, tok0, 0, C.tid); else if (g == 1) pool_window_task<4>(C, PM, tok0, 1, C.tid);
        else if (g == 2) pool_window_task<8>(C, PM, tok0, 2, C.tid); else pool_window_task<16>(C, PM, tok0, 3, C.tid);
        __syncthreads();
        f32x4 acc[8];
#pragma unroll
        for (int a = 0; a < 8; ++a) acc[a] = (f32x4){0.f, 0.f, 0.f, 0.f};
#pragma unroll
        for (int ks = 0; ks < 4; ++ks) { const bf16x8v bfr = *(const LAS bf16x8v*)(PM + swz(16 * w + fr, 4 * ks + fq));
#pragma unroll
            for (int a = 0; a < 8; ++a) { const bf16x8v af = *(const LAS bf16x8v*)(WT + swz(16 * a + fr, 4 * ks + fq)); acc[a] = MFMA16(af, bfr, acc[a]); } }
        bf16* orow = C.YMIX() + (size_t)(tok0 + 16 * w + fr) * DM + 512 + g * 128 + 4 * fq; const float* bp = C.b_pool() + g * 128 + 4 * fq; const float* sp = C.pool_scale() + g * 128 + 4 * fq;
#pragma unroll
        for (int a = 0; a < 8; ++a) { const f32x4 b = *(const f32x4*)(bp + 16 * a), sc = *(const f32x4*)(sp + 16 * a); const f32x4 v = acc[a];
            u32x2 o; o.x = pk2((v[0] + b[0]) * sc[0], (v[1] + b[1]) * sc[1]); o.y = pk2((v[2] + b[2]) * sc[2], (v[3] + b[3]) * sc[3]);
            *(u32x2*)(orow + 16 * a) = o; }
    }
}

__device__ __forceinline__ void phase_ln1_router(const Ctx& C, bool commit = true) {
    LAS unsigned char* WH = C.lds;
    LAS unsigned char* WL = C.lds + 40960;
    LAS float* GT = (LAS float*)(C.lds + 81920);
    LAS float* BT = (LAS float*)(C.lds + 86016);
    LAS int* rcls = (LAS int*)(C.lds + 90112);
    LAS float* rw = (LAS float*)(C.lds + 90112 + 512);
    LAS int* rpos = (LAS int*)(C.lds + 90112 + 512 + 1024);
    LAS int* lcnt = (LAS int*)(C.lds + 90112 + 512 + 1024 + 512);
    LAS int* lbase = lcnt + 32;
    const int lane_in = C.lane, w = C.wave;
    for (int i = C.tid; i < 5120; i += NTHREADS) { const int half = i / 2560, q = i % 2560, n = q >> 7, c = q & 127;
        *(LAS u32x4*)((half ? WL : WH) + n * 2048 + (((c & ~15) | ((c ^ n) & 15)) << 4)) = *(const u32x4*)(C.RWT() + (size_t)i * 8); }
    for (int i = C.tid; i < 256; i += NTHREADS) { *(LAS f32x4*)(GT + 4 * i) = *(const f32x4*)(C.ln1_g() + 4 * i); *(LAS f32x4*)(BT + 4 * i) = *(const f32x4*)(C.ln1_b() + 4 * i); }
    float brg[4], bre[16];
#pragma unroll
    for (int i = 0; i < 4; ++i) brg[i] = C.b_rg()[i];
#pragma unroll
    for (int i = 0; i < 16; ++i) bre[i] = C.b_re()[i];
    for (int rb = C.bid; rb < NTOK / 128; rb += C.G) {
        __syncthreads();
        if (C.tid < 32) lcnt[C.tid] = 0;
        int lane = lane_in; asm volatile("" : "+v"(lane));
        const int r = lane & 15, fq = lane >> 4;
        const int rl = 16 * w + r, m = rb * 128 + rl;
        u32x4 raw[32];
        { const u32x4* src = (const u32x4*)(C.R1() + (size_t)m * DM) + fq;
#pragma unroll
            for (int ks = 0; ks < 32; ++ks) raw[ks] = src[4 * ks]; }
        float s = 0.f;
#pragma unroll
        for (int ks = 0; ks < 32; ++ks) { float f[8]; unpack8(raw[ks], f); s += ((f[0] + f[1]) + (f[2] + f[3])) + ((f[4] + f[5]) + (f[6] + f[7])); }
        s += __shfl_xor(s, 16); s += __shfl_xor(s, 32);
        const float mean = s * (1.f / DM); float s2 = 0.f;
#define RAW_OPAQUE() _Pragma("unroll") for (int ks = 0; ks < 32; ++ks) asm volatile("" : "+v"(raw[ks]))
        RAW_OPAQUE();
#pragma unroll
        for (int ks = 0; ks < 32; ++ks) { float f[8]; unpack8(raw[ks], f);
#pragma unroll
            for (int i = 0; i < 8; ++i) { const float d = f[i] - mean; s2 += d * d; } }
        s2 += __shfl_xor(s2, 16); s2 += __shfl_xor(s2, 32);
        RAW_OPAQUE();
#undef RAW_OPAQUE
        const float rstd = 1.f / sqrtf(s2 * (1.f / DM) + LN_EPS);
        f32x4 acc0 = (f32x4){0.f, 0.f, 0.f, 0.f}, acc1 = (f32x4){0.f, 0.f, 0.f, 0.f};
        u32x4* dst = (u32x4*)(C.H1() + (size_t)m * DM) + fq;
        const int n1 = (16 + r) < 20 ? (16 + r) : 19;
#pragma unroll
        for (int ks = 0; ks < 32; ++ks) {
            float f[8]; unpack8(raw[ks], f);
            const f32x4 g0 = *(const LAS f32x4*)(GT + 32 * ks + 8 * fq), g1 = *(const LAS f32x4*)(GT + 32 * ks + 8 * fq + 4), b0 = *(const LAS f32x4*)(BT + 32 * ks + 8 * fq), b1 = *(const LAS f32x4*)(BT + 32 * ks + 8 * fq + 4);
            float h[8];
            h[0] = (f[0] - mean) * rstd * g0[0] + b0[0]; h[1] = (f[1] - mean) * rstd * g0[1] + b0[1]; h[2] = (f[2] - mean) * rstd * g0[2] + b0[2]; h[3] = (f[3] - mean) * rstd * g0[3] + b0[3];
            h[4] = (f[4] - mean) * rstd * g1[0] + b1[0]; h[5] = (f[5] - mean) * rstd * g1[1] + b1[1]; h[6] = (f[6] - mean) * rstd * g1[2] + b1[2]; h[7] = (f[7] - mean) * rstd * g1[3] + b1[3];
            u32x4 hi; hi.x = pk2(h[0], h[1]); hi.y = pk2(h[2], h[3]); hi.z = pk2(h[4], h[5]); hi.w = pk2(h[6], h[7]);
            dst[4 * ks] = hi;
            u32x4 lo; lo.x = pk2(h[0] - bflo(hi.x), h[1] - bfhi(hi.x)); lo.y = pk2(h[2] - bflo(hi.y), h[3] - bfhi(hi.y)); lo.z = pk2(h[4] - bflo(hi.z), h[5] - bfhi(hi.z)); lo.w = pk2(h[6] - bflo(hi.w), h[7] - bfhi(hi.w));
            const bf16x8v hh = __builtin_bit_cast(bf16x8v, hi), hl = __builtin_bit_cast(bf16x8v, lo);
            const int c = 4 * ks + fq;
            const int o0 = r * 2048 + (((c & ~15) | ((c ^ r) & 15)) << 4), o1 = n1 * 2048 + (((c & ~15) | ((c ^ n1) & 15)) << 4);
            const bf16x8v wh0 = *(const LAS bf16x8v*)(WH + o0), wl0 = *(const LAS bf16x8v*)(WL + o0), wh1 = *(const LAS bf16x8v*)(WH + o1), wl1 = *(const LAS bf16x8v*)(WL + o1);
            acc0 = MFMA16(wh0, hh, acc0); acc0 = MFMA16(wl0, hh, acc0); acc0 = MFMA16(wh0, hl, acc0);
            acc1 = MFMA16(wh1, hh, acc1); acc1 = MFMA16(wl1, hh, acc1); acc1 = MFMA16(wh1, hl, acc1);
            if ((ks & 1) == 1) __builtin_amdgcn_sched_barrier(0);
        }
        float g0 = acc0[0] + brg[0], g1 = acc0[1] + brg[1], g2 = acc0[2] + brg[2], g3 = acc0[3] + brg[3];
        int gi = 0; float gm = g0; if (g1 > gm) { gm = g1; gi = 1; } if (g2 > gm) { gm = g2; gi = 2; } if (g3 > gm) { gm = g3; gi = 3; }
        float gwt = 1.0f / (__expf(g0 - gm) + __expf(g1 - gm) + __expf(g2 - gm) + __expf(g3 - gm));
        gi = __shfl(gi, r); gwt = __shfl(gwt, r);
        const int srcl = r + 16 * (gi == 3 ? 0 : gi + 1);
        float e[4];
#pragma unroll
        for (int i = 0; i < 4; ++i) { const float cand = fq == 0 ? acc1[i] : acc0[i]; const float v = __shfl(cand, srcl);
            const float bb = gi == 0 ? bre[i] : (gi == 1 ? bre[4 + i] : (gi == 2 ? bre[8 + i] : bre[12 + i])); e[i] = v + bb; }
        int i1 = 0; float v1 = e[0]; if (e[1] > v1) { v1 = e[1]; i1 = 1; } if (e[2] > v1) { v1 = e[2]; i1 = 2; } if (e[3] > v1) { v1 = e[3]; i1 = 3; }
        int i2 = -1; float v2 = -3.0e38f;
#pragma unroll
        for (int i = 0; i < 4; ++i) if (i != i1 && e[i] > v2) { v2 = e[i]; i2 = i; }
        const float ex = __expf(v2 - v1), p1 = 1.0f / (1.0f + ex), p2 = ex * p1;
        const int il = i1 < i2 ? i1 : i2, ih = i1 < i2 ? i2 : i1; const float wl = (i1 < i2 ? p1 : p2) * gwt, wh = (i1 < i2 ? p2 : p1) * gwt;
        const int q = il == 0 ? ih - 1 : (il == 1 ? ih + 1 : 5);
        if (fq == 0) { rcls[rl] = gi * 6 + q; rw[rl * 2] = wl; rw[rl * 2 + 1] = wh; }
        __syncthreads();
        if (!commit) continue;
        if (C.tid < 128) rpos[C.tid] = atomicAdd((int*)&lcnt[rcls[C.tid]], 1);
        __syncthreads();
        if (C.tid < NCLS) lbase[C.tid] = lcnt[C.tid] > 0 ? (int)__hip_atomic_fetch_add(C.ctl() + CW_CNT + C.tid, (unsigned)lcnt[C.tid], __ATOMIC_RELAXED, __HIP_MEMORY_SCOPE_AGENT) : 0;
        __syncthreads();
        if (C.tid < 128) { const int c = rcls[C.tid], pos = lbase[c] + rpos[C.tid];
            if (pos < LISTCAP) { C.LIST()[c * LISTCAP + pos] = rb * 128 + C.tid; C.LW()[((size_t)c * LISTCAP + pos) * 2] = rw[C.tid * 2]; C.LW()[((size_t)c * LISTCAP + pos) * 2 + 1] = rw[C.tid * 2 + 1]; } }
    }
}

__device__ __forceinline__ void phase_ln2(const Ctx& C) {
    const int gw = C.bid * NWAVES + C.wave, NGW = C.G * NWAVES;
    f32x4 gg[4], bb[4];
#pragma unroll
    for (int j = 0; j < 4; ++j) { gg[j] = *(const f32x4*)(C.ln2_g() + 4 * C.lane + 256 * j); bb[j] = *(const f32x4*)(C.ln2_b() + 4 * C.lane + 256 * j); }
    for (int m = gw; m < NTOK; m += NGW) {
        const u32x2* xr = (const u32x2*)(C.R2() + (size_t)m * DM) + C.lane;
        f32x4 v[4]; float s = 0.f;
#pragma unroll
        for (int j = 0; j < 4; ++j) { const u32x2 w = xr[64 * j]; v[j] = (f32x4){bflo(w.x), bfhi(w.x), bflo(w.y), bfhi(w.y)}; s += (v[j].x + v[j].y) + (v[j].z + v[j].w); }
        const float mean = wave_sum(s) * (1.f / DM); float s2 = 0.f;
#pragma unroll
        for (int j = 0; j < 4; ++j) { v[j] = v[j] - mean; s2 += (v[j].x * v[j].x + v[j].y * v[j].y) + (v[j].z * v[j].z + v[j].w * v[j].w); }
        const float rstd = 1.f / sqrtf(wave_sum(s2) * (1.f / DM) + LN_EPS);
        f32x4* o = (f32x4*)(C.out() + (size_t)m * DM) + C.lane;
#pragma unroll
        for (int j = 0; j < 4; ++j) o[64 * j] = v[j] * rstd * gg[j] + bb[j];
    }
}

#define XB_TMO      128
#define XB_XCNT(j)  (256  + 64 * (j))
#define XB_XSUB(j)  (1280 + 64 * (j))
#define XB_XGEN(j)  (2304 + 64 * (j))
#define XB_TOP      3328
#define XB_TOPGEN   3392
#define XCD_BAR_WORDS 3456
#define XB_SPIN_CAP (1u << 18)
constexpr int CW_BAR = 4096;
constexpr int MISC_OFF = LDS_BYTES - 256;
__device__ __forceinline__ unsigned xb_ld(unsigned* p)              { return __hip_atomic_load(p, __ATOMIC_RELAXED, __HIP_MEMORY_SCOPE_AGENT); }
__device__ __forceinline__ unsigned xb_add(unsigned* p, unsigned v) { return __hip_atomic_fetch_add(p, v, __ATOMIC_RELAXED, __HIP_MEMORY_SCOPE_AGENT); }
__device__ __forceinline__ unsigned xb_xcc_id() { return (unsigned)__builtin_amdgcn_s_getreg((3 << 11) | 20) & 0xFu; }
#define XB_SPIN(cond, bar) do { unsigned _sp = 0; while (cond) { __builtin_amdgcn_s_sleep(1); \
    if ((++_sp & 255u) == 0u) { if (xb_ld(&(bar)[XB_TMO])) break; if (_sp > XB_SPIN_CAP) { atomicAdd(&(bar)[XB_TMO], 1u); break; } } } } while (0)
struct XcdBarrier { unsigned* bar; unsigned x; volatile LAS unsigned* st; };
__device__ __forceinline__ XcdBarrier xcd_barrier_post(unsigned* bar, volatile LAS unsigned* st) {
    XcdBarrier b; b.bar = bar; b.x = xb_xcc_id(); b.st = st;
    if (threadIdx.x == 0) (void)xb_add(&bar[XB_XCNT(b.x)], 1u);
    return b;
}
__device__ __forceinline__ void xcd_barrier_complete(unsigned* bar, unsigned x, unsigned& nloc, unsigned& nx) {
    const unsigned G = gridDim.x * gridDim.y * gridDim.z;
    unsigned sum, cnt, mine, sp = 0u;
    for (;;) {
        sum = 0u; cnt = 0u; mine = 0u;
#pragma unroll
        for (unsigned j = 0; j < 16; ++j) { const unsigned c = xb_ld(&bar[XB_XCNT(j)]); sum += c; cnt += (c > 0u) ? 1u : 0u; mine = (j == x) ? c : mine; }
        if (sum == G) break;
        __builtin_amdgcn_s_sleep(1);
        if ((++sp & 255u) == 0u) { if (xb_ld(&bar[XB_TMO])) break; if (sp > XB_SPIN_CAP) { atomicAdd(&bar[XB_TMO], 1u); break; } }
    }
    nloc = mine > 0u ? mine : 1u; nx = cnt > 0u ? cnt : 1u;
}
__device__ __forceinline__ void xcd_barrier(const XcdBarrier& b) {
    asm volatile("s_waitcnt vmcnt(0)" ::: "memory");
    __syncthreads();
    if (threadIdx.x == 0) {
        unsigned* bar = b.bar;
        __builtin_amdgcn_s_waitcnt(0);
        unsigned nloc = b.st[0], nx = b.st[1];
        if (nloc == 0u) { xcd_barrier_complete(bar, b.x, nloc, nx); b.st[0] = nloc; b.st[1] = nx; }
        const unsigned old = xb_add(&bar[XB_XSUB(b.x)], 1u);
        const unsigned gen = old / nloc;
        if (old + 1u == (gen + 1u) * nloc) {
            __builtin_amdgcn_fence(__ATOMIC_RELEASE, "agent");
            asm volatile("s_waitcnt vmcnt(0)" ::: "memory");
            const unsigned og = xb_add(&bar[XB_TOP], 1u);
            const unsigned tg = og / nx;
            if (og + 1u == (tg + 1u) * nx) xb_add(&bar[XB_TOPGEN], 1u);
            else XB_SPIN(xb_ld(&bar[XB_TOPGEN]) == tg, bar);
            __builtin_amdgcn_fence(__ATOMIC_ACQUIRE, "agent");
            xb_add(&bar[XB_XGEN(b.x)], 1u);
            asm volatile("s_waitcnt vmcnt(0)" ::: "memory");
        } else {
            XB_SPIN(xb_ld(&bar[XB_XGEN(b.x)]) == gen, bar);
            __builtin_amdgcn_fence(__ATOMIC_ACQUIRE, "agent");
            asm volatile("s_waitcnt vmcnt(0)" ::: "memory");
        }
    }
    __syncthreads();
}

constexpr int N_PHASES = 10;
#ifndef STAMP_SEL
#define STAMP_SEL -1
#endif
#ifndef STAMP_FROM
#define STAMP_FROM 0
#endif
#ifndef STAMP_UNIT
#define STAMP_UNIT 10.0f
#endif
#ifndef DUP_PHASE
#define DUP_PHASE -1
#endif
template <int LO, int HI> __global__ void __launch_bounds__(NTHREADS, 2) fwd_kernel(Args args) {
    extern __shared__ __attribute__((aligned(16))) unsigned char lds_raw[];
    Ctx C;
    C.lds = (LAS unsigned char*)lds_raw;
    C.tid = threadIdx.x; C.lane = C.tid & 63; C.wave = __builtin_amdgcn_readfirstlane(C.tid >> 6); C.G = gridDim.x; C.bid = blockIdx.x;
    C.a = &args; C.ws = args.ws;
    const LAS MoeTab* tb = (const LAS MoeTab*)(C.lds + MOETAB_OFF);
    XcdBarrier bar; bar.bar = C.ctl() + CW_BAR; bar.x = 0; bar.st = nullptr;
    if constexpr (HI - LO > 1) {
        volatile LAS unsigned* misc = (volatile LAS unsigned*)(C.lds + MISC_OFF);
        if (C.tid < 64) misc[C.tid] = 0u;
        __syncthreads();
        bar = xcd_barrier_post(C.ctl() + CW_BAR, misc + 8);
    }
#define IN(k) (LO <= (k) && (k) < HI)
    unsigned long long t_from = 0ull, t_sel = 0ull;
#define STAMP(k) do { if (STAMP_SEL >= 0) { if ((k) == STAMP_FROM) t_from = __builtin_amdgcn_s_memrealtime(); if ((k) == STAMP_SEL + 1) t_sel = __builtin_amdgcn_s_memrealtime(); } } while (0)
#define SEAM(k) do { if constexpr (IN(k) && IN((k) + 1)) xcd_barrier(bar); } while (0)
#define REP(k) for (int rep_ = 0; rep_ < ((k) == DUP_PHASE ? 2 : 1); ++rep_)
#define FRESH() do { int t_ = threadIdx.x; asm volatile("" : "+v"(t_)); C.tid = t_; C.lane = t_ & 63; } while (0)
    STAMP(0);
    FRESH();
    if constexpr (IN(0)) REP(0) { phase_prep(C); if (DUP_PHASE == 0) __syncthreads(); }
    SEAM(0);
    STAMP(1);
    FRESH();
    if constexpr (IN(1)) REP(1) { ProbDense P{C.XN(), C.WIN(), NTOK / 256, NPROJ / 256, DM, C.G, C.bid}; EpiStoreBf16 E{C.PROJ(), NPROJ}; pg8::gemm_phase(C.lds, P, E); }
    SEAM(1);
    STAMP(2);
    FRESH();
    if constexpr (IN(2)) { REP(21) phase_states_fast(C); __syncthreads(); REP(22) phase_pool_fast(C); }
    SEAM(2);
    STAMP(3);
    FRESH();
    if constexpr (IN(3)) REP(3) phase_scan(C);
    SEAM(3);
    STAMP(4);
    FRESH();
    if constexpr (IN(4)) REP(4) phase_y_fast(C);
    SEAM(4);
    STAMP(5);
    FRESH();
    if constexpr (IN(5)) REP(5) { ProbDense P{C.YMIX(), C.WOUT(), NTOK / 256, DM / 256, DM, C.G, C.bid}; EpiResBf16 E{C.XN(), C.R1()}; pg8::gemm_phase(C.lds, P, E); }
    SEAM(5);
    STAMP(6);
    FRESH();
    if constexpr (IN(6)) { if (DUP_PHASE == 6) { phase_ln1_router(C, false); __syncthreads(); } phase_ln1_router(C, true); }
    SEAM(6);
    STAMP(7);
    FRESH();
    if constexpr (IN(7)) { build_moetab(C); REP(7) { ProbMoe1 P{C.H1(), C.WGU(), C.LIST(), tb, C.G, C.bid}; EpiMoe1 E{C.HB(), C.LW(), tb}; pg8::gemm_phase(C.lds, P, E); } }
    SEAM(7);
    STAMP(8);
    FRESH();
    if constexpr (IN(8)) { build_moetab(C); REP(8) { ProbMoe2 P{C.HB(), C.WD(), tb, C.G, C.bid}; EpiMoe2 E{C.H1(), C.R2(), C.LIST(), tb}; pg8::gemm_phase(C.lds, P, E); } }
    SEAM(8);
    STAMP(9);
    FRESH();
    if constexpr (IN(9)) REP(9) phase_ln2(C);
    if (STAMP_SEL >= 0) { asm volatile("s_waitcnt vmcnt(0)" ::: "memory"); __syncthreads(); STAMP(10);
        if (blockIdx.x == 0 && threadIdx.x == 0) { asm volatile("s_waitcnt lgkmcnt(0)" ::: "memory"); C.out()[0] = (float)(t_sel - t_from) * (0.01f / STAMP_UNIT); } }
#undef IN
#undef SEAM
#undef REP
#undef FRESH
#undef STAMP
}

#ifndef ONE_LAUNCH
#define ONE_LAUNCH 1
#endif
template <int P, int Q> static void launch_phase(int grid, hipStream_t stream, const Args& a) {
    static bool attr = false;
    if (!attr) { (void)hipFuncSetAttribute((const void*)fwd_kernel<P, Q>, hipFuncAttributeMaxDynamicSharedMemorySize, LDS_BYTES); (void)hipGetLastError(); attr = true; }
    hipLaunchKernelGGL((fwd_kernel<P, Q>), dim3(grid), dim3(NTHREADS), LDS_BYTES, stream, a);
}

extern "C" void kernel_launch(void* const* d_in, const int* in_sizes, int n_in, void* d_out, int out_size, void* d_ws, size_t ws_size, hipStream_t stream) {
    static int grid = 0;
    if (grid == 0) {
        if (n_in != 25 || in_sizes[0] != NTOK * DM || out_size != NTOK * DM || ws_size < WS_END) { fprintf(stderr, "kernel_launch: unexpected shapes (n_in %d, in0 %d, out %d, ws %zu)\n", n_in, n_in > 0 ? in_sizes[0] : -1, out_size, ws_size); grid = -1; return; }
        int dev = 0, cus = 0;
        if (hipGetDevice(&dev) != hipSuccess || hipDeviceGetAttribute(&cus, hipDeviceAttributeMultiprocessorCount, dev) != hipSuccess) { grid = -1; return; }
        (void)hipGetLastError();
        grid = cus > 0 ? cus : 256;
    }
    if (grid < 0) return;
    (void)hipMemsetAsync((char*)d_ws + WS_CTL, 0, CTL_ZERO_BYTES, stream);
    Args a{};
    for (int i = 0; i < 25; ++i) a.in[i] = (const float*)d_in[i];
    a.out = (float*)d_out; a.ws = (unsigned char*)d_ws;
#if ONE_LAUNCH
    launch_phase<0, N_PHASES>(grid, stream, a);
#else
    launch_phase<0, 1>(grid, stream, a); launch_phase<1, 2>(grid, stream, a); launch_phase<2, 3>(grid, stream, a); launch_phase<3, 4>(grid, stream, a); launch_phase<4, 5>(grid, stream, a);
    launch_phase<5, 6>(grid, stream, a); launch_phase<6, 7>(grid, stream, a); launch_phase<7, 8>(grid, stream, a); launch_phase<8, 9>(grid, stream, a); launch_phase<9, 10>(grid, stream, a);
#endif
}
```

```cpp
#include <hip/hip_runtime.h>
#include <cstdio>
#include <cstdint>

#define GAS __attribute__((address_space(1)))
#define LAS __attribute__((address_space(3)))
typedef unsigned short bf16;
typedef float f32x4 __attribute__((ext_vector_type(4)));
typedef float f32x2 __attribute__((ext_vector_type(2)));
typedef unsigned u32x4 __attribute__((ext_vector_type(4)));
typedef unsigned u32x2 __attribute__((ext_vector_type(2)));

constexpr int NTOK = 32768, DM = 1024, SEQ = 2048, NBATCH = 16, NPROJ = 2048, DINP = 2056;
constexpr int NCHUNK = 16, CHUNK = 128, NHEAD = 8, HP = 64, NST = 128;
constexpr int NCLS = 24, LISTCAP = 32768, MAXT256 = 160;
constexpr float LN_EPS = 1e-5f, RMS_EPS = 1e-5f;
constexpr float ALPHA = 1.189207115002721f;

constexpr int PC_Z = 0, PC_X = 512, PC_B = 1024, PC_C = 1280, PC_U = 1536;

constexpr size_t MiB = 1u << 20;
constexpr size_t WS_CTL = 0, CTL_ZERO_BYTES = 1 * MiB;
constexpr size_t WS_WIN = 2 * MiB;
constexpr size_t WS_WOUT = 6 * MiB;
constexpr size_t WS_WPOOL = 8 * MiB;
constexpr size_t WS_WGU = 10 * MiB;
constexpr size_t WS_WD = 42 * MiB;
constexpr size_t WS_DTRAW = 58 * MiB;
constexpr size_t WS_DTV = 59 * MiB;
constexpr size_t WS_ACL = 60 * MiB;
constexpr size_t WS_CHD = 61 * MiB;
constexpr size_t WS_RWT = 61 * MiB + 65536;
constexpr size_t WS_LIST = 62 * MiB;
constexpr size_t WS_LW = 65 * MiB;
constexpr size_t WS_XN = 72 * MiB;
constexpr size_t WS_PROJ = 136 * MiB;
constexpr size_t WS_YMIX = 264 * MiB;
constexpr size_t WS_STATES = 328 * MiB;
constexpr size_t WS_PREV = 392 * MiB;
constexpr size_t WS_XBCC = 424 * MiB;
constexpr size_t WS_R1 = WS_PROJ;
constexpr size_t WS_H1 = WS_PROJ + 64 * MiB;
constexpr size_t WS_HB = WS_STATES;
constexpr size_t WS_R2 = WS_XN;
constexpr size_t WS_PWIN = WS_STATES;
constexpr size_t WS_YG = WS_STATES;
constexpr size_t WS_END = 488 * MiB;
constexpr int CW_CNT = 1024;

constexpr int LDS_BYTES = 147456;
constexpr int NTHREADS = 512, NWAVES = 8;

__device__ __forceinline__ unsigned f2bf(float f) { unsigned u = __builtin_bit_cast(unsigned, f); return (u + 0x7fffu + ((u >> 16) & 1u)) >> 16; }
__device__ __forceinline__ unsigned pk2(float lo, float hi) { unsigned r; asm("v_cvt_pk_bf16_f32 %0, %1, %2" : "=v"(r) : "v"(lo), "v"(hi)); return r; }
__device__ __forceinline__ float bf2f(bf16 h) { return __uint_as_float((unsigned)h << 16); }
__device__ __forceinline__ float bflo(unsigned w) { return __uint_as_float(w << 16); }
__device__ __forceinline__ float bfhi(unsigned w) { return __uint_as_float(w & 0xffff0000u); }
__device__ __forceinline__ float wave_sum(float v) {
#pragma unroll
    for (int o = 1; o < 64; o <<= 1) v += __shfl_xor(v, o);
    return v;
}
__device__ __forceinline__ float silu_f(float v) { return v * __builtin_amdgcn_rcpf(1.0f + __builtin_amdgcn_exp2f(-1.4426950408889634f * v)); }
__device__ __forceinline__ void unpack8(const u32x4 v, float (&f)[8]) {
    f[0] = bflo(v.x); f[1] = bfhi(v.x); f[2] = bflo(v.y); f[3] = bfhi(v.y); f[4] = bflo(v.z); f[5] = bfhi(v.z); f[6] = bflo(v.w); f[7] = bfhi(v.w);
}

struct Args { const float* in[25]; float* out; unsigned char* ws; int ph_lo, ph_hi; };

struct Ctx {
    const Args* a; unsigned char* ws; LAS unsigned char* lds;
    int tid, lane, wave, G, bid;
    __device__ __forceinline__ const float* x() const { return a->in[0]; }
    __device__ __forceinline__ const float* ln0_g() const { return a->in[1]; }
    __device__ __forceinline__ const float* ln0_b() const { return a->in[2]; }
    __device__ __forceinline__ const float* w_in() const { return a->in[3]; }
    __device__ __forceinline__ const float* conv_w() const { return a->in[4]; }
    __device__ __forceinline__ const float* conv_b() const { return a->in[5]; }
    __device__ __forceinline__ const float* dt_bias() const { return a->in[6]; }
    __device__ __forceinline__ const float* a_log() const { return a->in[7]; }
    __device__ __forceinline__ const float* d_skip() const { return a->in[8]; }
    __device__ __forceinline__ const float* ssm_norm_g() const { return a->in[9]; }
    __device__ __forceinline__ const float* w_pool() const { return a->in[10]; }
    __device__ __forceinline__ const float* b_pool() const { return a->in[11]; }
    __device__ __forceinline__ const float* pool_scale() const { return a->in[12]; }
    __device__ __forceinline__ const float* w_out() const { return a->in[13]; }
    __device__ __forceinline__ const float* ln1_g() const { return a->in[14]; }
    __device__ __forceinline__ const float* ln1_b() const { return a->in[15]; }
    __device__ __forceinline__ const float* w_rg() const { return a->in[16]; }
    __device__ __forceinline__ const float* b_rg() const { return a->in[17]; }
    __device__ __forceinline__ const float* w_re() const { return a->in[18]; }
    __device__ __forceinline__ const float* b_re() const { return a->in[19]; }
    __device__ __forceinline__ const float* w_gate() const { return a->in[20]; }
    __device__ __forceinline__ const float* w_up() const { return a->in[21]; }
    __device__ __forceinline__ const float* w_down() const { return a->in[22]; }
    __device__ __forceinline__ const float* ln2_g() const { return a->in[23]; }
    __device__ __forceinline__ const float* ln2_b() const { return a->in[24]; }
    __device__ __forceinline__ float* out() const { return a->out; }
    __device__ __forceinline__ unsigned* ctl() const { return (unsigned*)(ws + WS_CTL); }
    __device__ __forceinline__ bf16* WIN() const { return (bf16*)(ws + WS_WIN); }
    __device__ __forceinline__ bf16* WOUT() const { return (bf16*)(ws + WS_WOUT); }
    __device__ __forceinline__ bf16* WPOOL() const { return (bf16*)(ws + WS_WPOOL); }
    __device__ __forceinline__ bf16* WGU() const { return (bf16*)(ws + WS_WGU); }
    __device__ __forceinline__ bf16* WD() const { return (bf16*)(ws + WS_WD); }
    __device__ __forceinline__ bf16* XN() const { return (bf16*)(ws + WS_XN); }
    __device__ __forceinline__ bf16* PROJ() const { return (bf16*)(ws + WS_PROJ); }
    __device__ __forceinline__ bf16* YMIX() const { return (bf16*)(ws + WS_YMIX); }
    __device__ __forceinline__ bf16* PREV() const { return (bf16*)(ws + WS_PREV); }
    __device__ __forceinline__ bf16* XBCC() const { return (bf16*)(ws + WS_XBCC); }
    __device__ __forceinline__ bf16* R1() const { return (bf16*)(ws + WS_R1); }
    __device__ __forceinline__ bf16* H1() const { return (bf16*)(ws + WS_H1); }
    __device__ __forceinline__ bf16* HB() const { return (bf16*)(ws + WS_HB); }
    __device__ __forceinline__ bf16* R2() const { return (bf16*)(ws + WS_R2); }
    __device__ __forceinline__ bf16* PWIN() const { return (bf16*)(ws + WS_PWIN); }
    __device__ __forceinline__ float* DTRAW() const { return (float*)(ws + WS_DTRAW); }
    __device__ __forceinline__ float* DTV() const { return (float*)(ws + WS_DTV); }
    __device__ __forceinline__ float* ACL() const { return (float*)(ws + WS_ACL); }
    __device__ __forceinline__ float* CHD() const { return (float*)(ws + WS_CHD); }
    __device__ __forceinline__ float* STATES() const { return (float*)(ws + WS_STATES); }
    __device__ __forceinline__ float* LW() const { return (float*)(ws + WS_LW); }
    __device__ __forceinline__ float* YG() const { return (float*)(ws + WS_YG); }
    __device__ __forceinline__ bf16* RWT() const { return (bf16*)(ws + WS_RWT); }
    __device__ __forceinline__ int* LIST() const { return (int*)(ws + WS_LIST); }
};

struct TrItem { const float* src; bf16* dst; int ld_src, ld_dst; };
__device__ __forceinline__ void tr_load(const TrItem& t, int lane, f32x4 (&v)[8]) {
    const float* p = t.src + (size_t)(lane >> 3) * t.ld_src + 4 * (lane & 7);
#pragma unroll
    for (int i = 0; i < 8; ++i) v[i] = *(const f32x4*)(p + (size_t)(8 * i) * t.ld_src);
}
__device__ __forceinline__ void tr_store(const TrItem& t, int lane, const f32x4 (&v)[8], LAS float* scr) {
    const int r = lane >> 3, c4 = lane & 7;
#pragma unroll
    for (int i = 0; i < 8; ++i) { LAS float* d = scr + (8 * i + r) * 33 + 4 * c4; d[0] = v[i][0]; d[1] = v[i][1]; d[2] = v[i][2]; d[3] = v[i][3]; }
    asm volatile("s_waitcnt lgkmcnt(0)" ::: "memory");
    const int c = lane & 7;
#pragma unroll
    for (int j = 0; j < 4; ++j) { const int n = (lane >> 3) + 8 * j; const LAS float* s = scr + (8 * c) * 33 + n;
        u32x4 o; o.x = pk2(s[0 * 33], s[1 * 33]); o.y = pk2(s[2 * 33], s[3 * 33]); o.z = pk2(s[4 * 33], s[5 * 33]); o.w = pk2(s[6 * 33], s[7 * 33]);
        *(u32x4*)(t.dst + (size_t)n * t.ld_dst + 8 * c) = o; }
    asm volatile("s_waitcnt lgkmcnt(0)" ::: "memory");
}
constexpr int I_WIN = 16 * 64, I_WOUT = 16 * 32, I_WPOOL = 4 * 2 * 4, I_WGU = 16 * 16 * 32, I_WD = 16 * 8 * 32;
constexpr int TR_NITEMS = I_WIN + I_WOUT + I_WPOOL + I_WGU + I_WD;
__device__ __forceinline__ TrItem tr_decode(const Ctx& C, int it) {
    TrItem t; int r = it;
    if (r < I_WIN) { const int kb = r / 64, nb = r % 64, n0 = nb * 32, n0s = n0 + (n0 >= 1536 ? 8 : 0);
        t.src = C.w_in() + (size_t)(kb * 64) * DINP + n0s; t.ld_src = DINP; t.dst = C.WIN() + (size_t)n0 * 1024 + kb * 64; t.ld_dst = 1024; return t; }
    r -= I_WIN;
    if (r < I_WOUT) { const int kb = r / 32, nb = r % 32;
        t.src = C.w_out() + (size_t)(kb * 64) * 1024 + nb * 32; t.ld_src = 1024; t.dst = C.WOUT() + (size_t)(nb * 32) * 1024 + kb * 64; t.ld_dst = 1024; return t; }
    r -= I_WOUT;
    if (r < I_WPOOL) { const int g = r / 8, kb = (r % 8) / 4, nb = r % 4;
        t.src = C.w_pool() + (size_t)g * 16384 + (size_t)(kb * 64) * 128 + nb * 32; t.ld_src = 128; t.dst = C.WPOOL() + (size_t)g * 16384 + (size_t)(nb * 32) * 128 + kb * 64; t.ld_dst = 128; return t; }
    r -= I_WPOOL;
    if (r < I_WGU) { const int e = r / 512, q = r % 512, kb = q / 32, nb = q % 32;
        const int row0 = nb * 32, tt = row0 >> 8, half = (row0 >> 7) & 1, i0 = row0 & 127;
        t.src = (half ? C.w_up() : C.w_gate()) + (size_t)e * 1024 * 512 + (size_t)(kb * 64) * 512 + 128 * tt + i0; t.ld_src = 512;
        t.dst = C.WGU() + (size_t)e * 1048576 + (size_t)row0 * 1024 + kb * 64; t.ld_dst = 1024; return t; }
    r -= I_WGU;
    { const int e = r / 256, q = r % 256, kb = q / 32, nb = q % 32;
        t.src = C.w_down() + (size_t)e * 524288 + (size_t)(kb * 64) * 1024 + nb * 32; t.ld_src = 1024; t.dst = C.WD() + (size_t)e * 524288 + (size_t)(nb * 32) * 512 + kb * 64; t.ld_dst = 512; return t; }
}

__device__ __forceinline__ void phase_prep(const Ctx& C) {
    LAS float* scr = (LAS float*)(C.lds + C.wave * 8704);
    LAS float* wdt = (LAS float*)(C.lds + 8 * 8704);
    const int gw = C.bid * NWAVES + C.wave, NGW = C.G * NWAVES;
    for (int i = C.tid; i < 8 * 1024; i += NTHREADS) { const int k = i >> 3, n = i & 7; wdt[n * 1024 + k] = C.w_in()[(size_t)k * DINP + 1536 + n]; }
    { const int gt = C.bid * NTHREADS + C.tid;
        if (gt < 20 * 1024) { const int n = gt >> 10, k = gt & 1023; const float v = n < 4 ? C.w_rg()[k * 4 + n] : C.w_re()[k * 16 + (n - 4)];
            const unsigned hi = f2bf(v); const float lo = v - __uint_as_float(hi << 16); C.RWT()[gt] = (bf16)hi; C.RWT()[20 * 1024 + gt] = (bf16)f2bf(lo); } }
    {
        f32x4 va[8], vb[8]; TrItem ta, tb2; int it = gw;
        if (it < TR_NITEMS) { ta = tr_decode(C, it); tr_load(ta, C.lane, va); }
        while (it < TR_NITEMS) {
            const int n1 = it + NGW; if (n1 < TR_NITEMS) { tb2 = tr_decode(C, n1); tr_load(tb2, C.lane, vb); }
            tr_store(ta, C.lane, va, scr);
            const int n2 = n1 + NGW; if (n1 >= TR_NITEMS) break;
            if (n2 < TR_NITEMS) { ta = tr_decode(C, n2); tr_load(ta, C.lane, va); }
            tr_store(tb2, C.lane, vb, scr);
            it = n2;
        }
    }
    __syncthreads();
    f32x4 gg[4], bb[4];
#pragma unroll
    for (int j = 0; j < 4; ++j) { gg[j] = *(const f32x4*)(C.ln0_g() + 4 * C.lane + 256 * j); bb[j] = *(const f32x4*)(C.ln0_b() + 4 * C.lane + 256 * j); }
    for (int m0 = gw; m0 < NTOK; m0 += 4 * NGW) {
        f32x4 vv[4][4];
#pragma unroll
        for (int b = 0; b < 4; ++b) { const int m = m0 + b * NGW; if (m < NTOK) { const f32x4* xr = (const f32x4*)(C.x() + (size_t)m * DM) + C.lane;
#pragma unroll
                for (int j = 0; j < 4; ++j) vv[b][j] = xr[64 * j]; } }
#pragma unroll
        for (int b = 0; b < 4; ++b) { const int m = m0 + b * NGW; if (m >= NTOK) break;
            f32x4 v[4]; float s = 0.f;
#pragma unroll
            for (int j = 0; j < 4; ++j) { v[j] = vv[b][j]; s += (v[j].x + v[j].y) + (v[j].z + v[j].w); }
            const float mean = wave_sum(s) * (1.f / DM); float s2 = 0.f;
#pragma unroll
            for (int j = 0; j < 4; ++j) { v[j] = v[j] - mean; s2 += (v[j].x * v[j].x + v[j].y * v[j].y) + (v[j].z * v[j].z + v[j].w * v[j].w); }
            const float rstd = 1.f / sqrtf(wave_sum(s2) * (1.f / DM) + LN_EPS);
            unsigned long long* o8 = (unsigned long long*)(C.XN() + (size_t)m * DM) + C.lane;
#pragma unroll
            for (int j = 0; j < 4; ++j) { v[j] = v[j] * rstd * gg[j] + bb[j];
                o8[64 * j] = (unsigned long long)pk2(v[j].x, v[j].y) | ((unsigned long long)pk2(v[j].z, v[j].w) << 32); }
            float d[8]; const LAS float* wd = wdt + 4 * C.lane; asm volatile("" : "+v"(wd));
#pragma unroll
            for (int n = 0; n < 8; ++n) { float a = 0.f;
#pragma unroll
                for (int j = 0; j < 4; ++j) { const f32x4 w = *(const LAS f32x4*)(wd + n * 1024 + 256 * j); a += (v[j].x * w.x + v[j].y * w.y) + (v[j].z * w.z + v[j].w * w.w); }
                d[n] = wave_sum(a); }
            if (C.lane == 0) { *(f32x4*)(C.DTRAW() + (size_t)m * 8) = (f32x4){d[0], d[1], d[2], d[3]}; *(f32x4*)(C.DTRAW() + (size_t)m * 8 + 4) = (f32x4){d[4], d[5], d[6], d[7]}; }
        }
    }
}

struct MoeTab { int ntiles; int cnt[NCLS]; int cls[MAXT256]; int row0[MAXT256]; };
constexpr int MOETAB_OFF = 140 * 1024;
__device__ __forceinline__ void class_experts(int c, int& elo, int& ehi) {
    const int g = c / 6, q = c % 6; const int il = q < 3 ? 0 : (q < 5 ? 1 : 2); const int ih = q < 3 ? q + 1 : (q < 5 ? q - 1 : 3);
    elo = g * 4 + il; ehi = g * 4 + ih;
}
__device__ __forceinline__ void build_moetab(const Ctx& C) {
    LAS MoeTab* tb = (LAS MoeTab*)(C.lds + MOETAB_OFF);
    if (C.tid == 0) {
        int nt = 0;
        for (int c = 0; c < NCLS; ++c) { int n = (int)__hip_atomic_load(C.ctl() + CW_CNT + c, __ATOMIC_RELAXED, __HIP_MEMORY_SCOPE_AGENT); if (n > LISTCAP) n = LISTCAP; tb->cnt[c] = n;
            for (int r = 0; r < n; r += 256) { if (nt < MAXT256) { tb->cls[nt] = c; tb->row0[nt] = r; ++nt; } } }
        tb->ntiles = nt;
    }
    __syncthreads();
}

namespace pg8 {
typedef short bf16x8 __attribute__((ext_vector_type(8)));
constexpr int BM = 256, BK = 64, HALF = 128, HTB = HALF * BK * 2, STAGE_BYTES = 8 * HTB, NXCD = 8, WGM = 8;
__host__ __device__ __forceinline__ int lds_byte(int r, int c) { const int st = (r >> 4) * 2 + (c >> 5), rr = r & 15, cc = c & 31, ob = rr * 64 + cc * 2; return st * 1024 + (ob ^ (((ob >> 9) & 1) << 5)); }
__host__ __device__ __forceinline__ void stage_rc(int b, int& R, int& C) { const int st = b / 1024, sb = b % 1024, swz = sb ^ (((sb >> 9) & 1) << 5); R = (st >> 1) * 16 + swz / 64; C = (st & 1) * 32 + (swz % 64) / 2; }
__host__ __device__ __forceinline__ int perm32(int rho) { const int n = rho >> 4, i = rho & 15; return 8 * (i >> 2) + 4 * n + (i & 3); }
struct Unit { int pm, pn, xa, xb; };
__device__ __forceinline__ bool order_next(int i, int G, int c, int nM, int nN, Unit& u) {
    const int nwg = nM * nN; const long L = (long)i * G + c; if (L >= nwg) return false;
    int wgid = (int)L; { const int q = nwg / NXCD, r = nwg % NXCD, xcd = wgid % NXCD, off = wgid / NXCD; wgid = (xcd < r ? xcd * (q + 1) : r * (q + 1) + (xcd - r) * q) + off; }
    const int nig = WGM * nN, gid = wgid / nig, fm = gid * WGM, gsz = (nM - fm) < WGM ? (nM - fm) : WGM;
    u.pm = fm + ((wgid % nig) % gsz); u.pn = (wgid % nig) / gsz; return true;
}
__device__ __forceinline__ unsigned cvt_pk_bf16(float lo, float hi) { unsigned r; asm volatile("v_cvt_pk_bf16_f32 %0, %1, %2" : "=v"(r) : "v"(lo), "v"(hi)); return r; }

template <class Prob, class Epi>
__device__ __forceinline__ void gemm_phase(LAS unsigned char* lds, const Prob& P, const Epi& E) {
    constexpr bool GA = Prob::GATHER;
    int tid = threadIdx.x; asm volatile("" : "+v"(tid));
    const int wid = __builtin_amdgcn_readfirstlane(tid >> 6), lane = tid & 63, wr = wid >> 2, wc = wid & 3, fr = lane & 15, fq = lane >> 4;
    const int nt = P.ktiles();
    Unit cur, nxt; int ui = 0;
    if (!P.next(0, cur)) return;
    unsigned ldb = P.ldb_bytes(cur);
    unsigned voffB[2], voffA[2];
#pragma unroll
    for (int i = 0; i < 2; ++i) { int R, Cc; stage_rc(tid * 16 + i * 8192, R, Cc); const int Rb = (R & ~31) + perm32(R & 31); voffB[i] = (unsigned)Rb * ldb + (unsigned)Cc * 2u;
        voffA[i] = GA ? 0u : P.a_voff_dense(R, Cc); }
    unsigned hstepB = 128u * ldb;
    const unsigned ldsw = (unsigned)wid * 1024u;
    const int aoff = lds_byte(wr * 64 + fr, fq * 8), boff = lds_byte(wc * 32 + fr, fq * 8);
#define PG8_SA(b, h) (((b) * 2 + (h)) * HTB)
#define PG8_SB(b, h) ((4 + (b) * 2 + (h)) * HTB)
#define PG8_STAGE(bufoff, gbase, voff) do { _Pragma("unroll") for (int _i = 0; _i < 2; ++_i) \
        __builtin_amdgcn_global_load_lds((const unsigned*)((const char*)(gbase) + (voff)[_i]), (LAS unsigned*)(lds + (bufoff) + ldsw + _i * 8192), 16, 0, 0); } while (0)
#define PG8_LDA(dst, b, h) do { _Pragma("unroll") for (int m = 0; m < 4; ++m) _Pragma("unroll") for (int k = 0; k < 2; ++k) dst[m][k] = *(const LAS bf16x8*)(lds + PG8_SA(b, h) + aoff + m * 2048 + k * 1024); } while (0)
#define PG8_LDB(dst, b, h) do { _Pragma("unroll") for (int n = 0; n < 2; ++n) _Pragma("unroll") for (int k = 0; k < 2; ++k) dst[n][k] = *(const LAS bf16x8*)(lds + PG8_SB(b, h) + boff + n * 2048 + k * 1024); } while (0)
#define PG8_MMA(ai, bj, At, Bt) do { __builtin_amdgcn_s_setprio(1); _Pragma("unroll") for (int m = 0; m < 4; ++m) _Pragma("unroll") for (int n = 0; n < 2; ++n) _Pragma("unroll") for (int k = 0; k < 2; ++k) \
        acc[ai][bj][m][n] = __builtin_amdgcn_mfma_f32_16x16x32_bf16(Bt[n][k], At[m][k], acc[ai][bj][m][n], 0, 0, 0); __builtin_amdgcn_s_setprio(0); } while (0)
#define PG8_WAIT_V(n) asm volatile("s_waitcnt vmcnt(" #n ")" ::: "memory")
#define PG8_WAIT_L(n) asm volatile("s_waitcnt lgkmcnt(" #n ")" ::: "memory")
#define PG8_BAR __builtin_amdgcn_s_barrier()
#define PG8_SCHED __builtin_amdgcn_sched_barrier(0)
    f32x4 acc[2][2][4][2];
#pragma unroll
    for (int a = 0; a < 2; ++a)
#pragma unroll
        for (int b = 0; b < 2; ++b)
#pragma unroll
            for (int m = 0; m < 4; ++m)
#pragma unroll
                for (int n = 0; n < 2; ++n) acc[a][b][m][n] = (f32x4){0.f, 0.f, 0.f, 0.f};
    bf16x8 At[4][2], B0[2][2], B1[2][2];
    unsigned vc0[2], vc1[2];
    const char* cA0; const char* cA1; const char* nA0; const char* nA1;
    P.a_ready(cur);
    if constexpr (GA) { cA0 = cA1 = nA0 = nA1 = P.a_base(cur);
        P.a_voff4(cur, tid, vc0, vc1);
    } else { cA0 = P.a_half(cur, 0); cA1 = P.a_half(cur, 1); nA0 = cA0; nA1 = cA1;
#pragma unroll
        for (int i = 0; i < 2; ++i) { vc0[i] = vc1[i] = voffA[i]; } }
    const size_t kstep = (size_t)(BK * 2);
    {
        const char* cB0 = P.b_tile(cur, 0); const char* cB1 = P.b_tile(cur, 1);
        PG8_STAGE(PG8_SB(0, 0), cB0, voffB); PG8_STAGE(PG8_SB(0, 1), cB0 + hstepB, voffB); PG8_STAGE(PG8_SA(0, 0), cA0, vc0); PG8_STAGE(PG8_SA(0, 1), cA1, vc1);
        if (wr == 1) PG8_BAR;
        PG8_WAIT_V(2); PG8_BAR;
        PG8_STAGE(PG8_SB(1, 0), cB1, voffB); PG8_STAGE(PG8_SA(1, 0), cA0 + kstep, vc0); PG8_STAGE(PG8_SB(1, 1), cB1 + hstepB, voffB);
        PG8_WAIT_V(6); PG8_BAR;
    }
    for (;;) {
        const bool has_next = P.next(ui + 1, nxt);
        if (!has_next) nxt = cur;
        if constexpr (!GA) { nA0 = P.a_half(nxt, 0); nA1 = P.a_half(nxt, 1); }
        for (int t = 0; t < nt; t += 2) {
            const bool last = (t == nt - 2);
            if (last) {
                if (has_next) P.a_ready(nxt);
                if constexpr (Prob::VAR_LDB) { ldb = P.ldb_bytes(nxt); hstepB = 128u * ldb; }
                if constexpr (GA) { nA0 = nA1 = P.a_base(nxt); }
#pragma unroll
                for (int i = 0; i < 2; ++i) { int R, Cc; stage_rc(tid * 16 + i * 8192, R, Cc);
                    if constexpr (Prob::VAR_LDB) { const int Rb = (R & ~31) + perm32(R & 31); voffB[i] = (unsigned)Rb * ldb + (unsigned)Cc * 2u; }
                }
            }
            const char* a11 = cA1 + (size_t)(t + 1) * kstep;
            const char* a20 = last ? nA0 : cA0 + (size_t)(t + 2) * kstep; const char* a21 = last ? nA1 : cA1 + (size_t)(t + 2) * kstep;
            const char* a30 = a20 + kstep;
            const char* b2 = last ? P.b_tile(nxt, 0) : P.b_tile(cur, t + 2); const char* b3 = last ? P.b_tile(nxt, 1) : P.b_tile(cur, t + 3);
            PG8_LDB(B0, 0, 0); PG8_LDB(B1, 0, 1); PG8_SCHED; PG8_LDA(At, 0, 0); PG8_STAGE(PG8_SA(1, 1), a11, vc1);
            if constexpr (GA) { if (last) {
                P.a_voff4(nxt, tid, vc0, vc1); } }
            PG8_WAIT_V(8); PG8_WAIT_L(0); PG8_BAR; PG8_MMA(0, 0, At, B0); PG8_MMA(0, 1, At, B1); PG8_BAR; PG8_SCHED;
            PG8_LDA(At, 0, 1); PG8_STAGE(PG8_SB(0, 0), b2, voffB); PG8_STAGE(PG8_SB(0, 1), b2 + hstepB, voffB); PG8_STAGE(PG8_SA(0, 0), a20, vc0);
            PG8_WAIT_V(8); PG8_WAIT_L(0); PG8_BAR; PG8_MMA(1, 0, At, B0); PG8_MMA(1, 1, At, B1); PG8_BAR; PG8_SCHED;
            PG8_LDB(B0, 1, 0); PG8_LDB(B1, 1, 1); PG8_SCHED; PG8_LDA(At, 1, 0); PG8_STAGE(PG8_SA(0, 1), a21, vc1);
            PG8_WAIT_V(8); PG8_WAIT_L(0); PG8_BAR; PG8_MMA(0, 0, At, B0); PG8_MMA(0, 1, At, B1); PG8_BAR; PG8_SCHED;
            PG8_LDA(At, 1, 1); PG8_STAGE(PG8_SB(1, 0), b3, voffB); PG8_STAGE(PG8_SB(1, 1), b3 + hstepB, voffB); PG8_STAGE(PG8_SA(1, 0), a30, vc0);
            PG8_WAIT_V(8); PG8_WAIT_L(0); PG8_BAR; PG8_MMA(1, 0, At, B0); PG8_MMA(1, 1, At, B1); PG8_BAR; PG8_SCHED;
        }
        if (wr == 0) PG8_BAR;
        E(acc, cur, wr, wc, fr, fq);
        P.done(cur, lane);
        if (!has_next) break;
#pragma unroll
        for (int a = 0; a < 2; ++a)
#pragma unroll
            for (int b = 0; b < 2; ++b)
#pragma unroll
                for (int m = 0; m < 4; ++m)
#pragma unroll
                    for (int n = 0; n < 2; ++n) acc[a][b][m][n] = (f32x4){0.f, 0.f, 0.f, 0.f};
        cur = nxt; ++ui; cA0 = nA0; cA1 = nA1;
        if (wr == 1) PG8_BAR;
    }
    PG8_WAIT_V(0);
    PG8_BAR;
#undef PG8_SA
#undef PG8_SB
#undef PG8_STAGE
#undef PG8_LDA
#undef PG8_LDB
#undef PG8_MMA
#undef PG8_WAIT_V
#undef PG8_WAIT_L
#undef PG8_BAR
#undef PG8_SCHED
}
}

struct ProbDense {
    static constexpr bool GATHER = false;
    const bf16* A; const bf16* Bt; int nM, nN, K, G, c;
    __device__ __forceinline__ bool next(int i, pg8::Unit& u) const { return pg8::order_next(i, G, c, nM, nN, u); }
    __device__ __forceinline__ int ktiles() const { return K / 64; }
    static constexpr bool VAR_LDB = false;
    __device__ __forceinline__ unsigned ldb_bytes(const pg8::Unit&) const { return (unsigned)K * 2u; }
    __device__ __forceinline__ void a_ready(const pg8::Unit&) const {}
    __device__ __forceinline__ void done(const pg8::Unit&, int) const {}
    __device__ __forceinline__ unsigned a_voff_dense(int R, int Cc) const { return ((unsigned)R * (unsigned)K + (unsigned)Cc) * 2u; }
    __device__ __forceinline__ const char* a_half(const pg8::Unit& u, int h) const { return (const char*)A + (size_t)(u.pm * 256 + h * 128) * K * 2; }
    __device__ __forceinline__ const char* a_base(const pg8::Unit&) const { return (const char*)A; }
    __device__ __forceinline__ void a_voff4(const pg8::Unit&, int, unsigned (&)[2], unsigned (&)[2]) const {}
    __device__ __forceinline__ const char* b_tile(const pg8::Unit& u, int kt) const { return (const char*)Bt + ((size_t)u.pn * 256 * K + (size_t)kt * 64) * 2; }
};
struct EpiStoreBf16 {
    bf16* O; int ldc;
    __device__ __forceinline__ void operator()(const f32x4 (&acc)[2][2][4][2], const pg8::Unit& u, int wr, int wc, int fr, int fq) const {
        const int row0 = u.pm * 256 + wr * 64 + fr, col0 = u.pn * 256 + wc * 32 + 8 * fq;
#pragma unroll
        for (int ai = 0; ai < 2; ++ai)
#pragma unroll
            for (int m = 0; m < 4; ++m) { bf16* rowp = O + (size_t)(row0 + ai * 128 + m * 16) * ldc + col0;
#pragma unroll
                for (int bj = 0; bj < 2; ++bj) { const f32x4 v0 = acc[ai][bj][m][0], v1 = acc[ai][bj][m][1];
                    u32x4 w; w.x = pg8::cvt_pk_bf16(v0[0], v0[1]); w.y = pg8::cvt_pk_bf16(v0[2], v0[3]); w.z = pg8::cvt_pk_bf16(v1[0], v1[1]); w.w = pg8::cvt_pk_bf16(v1[2], v1[3]);
                    *(u32x4*)(rowp + bj * 128) = w; } }
    }
};
struct EpiResBf16 {
    const bf16* X; bf16* O;
    __device__ __forceinline__ void operator()(const f32x4 (&acc)[2][2][4][2], const pg8::Unit& u, int wr, int wc, int fr, int fq) const {
        const int row0 = u.pm * 256 + wr * 64 + fr, col0 = u.pn * 256 + wc * 32 + 8 * fq;
#pragma unroll
        for (int ai = 0; ai < 2; ++ai) {
            u32x4 xv[4][2];
#pragma unroll
            for (int m = 0; m < 4; ++m)
#pragma unroll
                for (int bj = 0; bj < 2; ++bj) xv[m][bj] = *(const u32x4*)(X + (size_t)(row0 + ai * 128 + m * 16) * DM + col0 + bj * 128);
            __builtin_amdgcn_sched_barrier(0);
#pragma unroll
            for (int m = 0; m < 4; ++m) { const size_t off = (size_t)(row0 + ai * 128 + m * 16) * DM + col0;
#pragma unroll
                for (int bj = 0; bj < 2; ++bj) { const f32x4 v0 = acc[ai][bj][m][0], v1 = acc[ai][bj][m][1]; const u32x4 x4 = xv[m][bj];
                    u32x4 w; w.x = pg8::cvt_pk_bf16(ALPHA * bflo(x4.x) + v0[0], ALPHA * bfhi(x4.x) + v0[1]); w.y = pg8::cvt_pk_bf16(ALPHA * bflo(x4.y) + v0[2], ALPHA * bfhi(x4.y) + v0[3]);
                    w.z = pg8::cvt_pk_bf16(ALPHA * bflo(x4.z) + v1[0], ALPHA * bfhi(x4.z) + v1[1]); w.w = pg8::cvt_pk_bf16(ALPHA * bflo(x4.w) + v1[2], ALPHA * bfhi(x4.w) + v1[3]);
                    *(u32x4*)(O + off + bj * 128) = w; } }
            __builtin_amdgcn_sched_barrier(0);
        }
    }
};

constexpr int CW_RDY = 8192;
__device__ __forceinline__ void order_map(int L, int nM, int nN, pg8::Unit& u, int rot = 0) {
    const int nwg = nM * nN; int wgid = L; { const int q = nwg / pg8::NXCD, r = nwg % pg8::NXCD, xcd = (wgid + rot) % pg8::NXCD, off = wgid / pg8::NXCD; wgid = (xcd < r ? xcd * (q + 1) : r * (q + 1) + (xcd - r) * q) + off; }
    const int nig = pg8::WGM * nN, gid = wgid / nig, fm = gid * pg8::WGM, gsz = (nM - fm) < pg8::WGM ? (nM - fm) : pg8::WGM;
    u.pm = fm + ((wgid % nig) % gsz); u.pn = (wgid % nig) / gsz;
}
struct ProbMoe {
    static constexpr bool GATHER = true, VAR_LDB = true;
    const bf16* H1; const bf16* HB; const bf16* WGU; const bf16* WD; const int* LIST; unsigned* ctl; const LAS MoeTab* tb; int G, c, mode;
    __device__ __forceinline__ bool next(int i, pg8::Unit& u) const { const int nt_ = tb->ntiles, n1 = (mode == 2) ? 0 : nt_ * 8, n2 = (mode == 1) ? 0 : nt_ * 4; const long L = (long)i * G + c; if (L >= n1 + n2) return false;
        int type = 0; if (L < n1) order_map((int)L, nt_, 8, u); else { order_map((int)L - n1, nt_, 4, u, n1 & 7); type = 1; }
        const int cl = tb->cls[u.pm]; int elo, ehi; class_experts(cl, elo, ehi); u.xa = elo | (ehi << 8) | (cl << 16) | (type << 24); u.xb = tb->row0[u.pm]; return true; }
    __device__ __forceinline__ int ktiles() const { return 16; }
    __device__ __forceinline__ unsigned ldb_bytes(const pg8::Unit& u) const { return (u.xa >> 24) ? 1024u : 2048u; }
    __device__ __forceinline__ unsigned a_voff_dense(int, int) const { return 0u; }
    __device__ __forceinline__ const char* a_half(const pg8::Unit&, int) const { return (const char*)H1; }
    __device__ __forceinline__ const char* a_base(const pg8::Unit& u) const { return (u.xa >> 24) ? (const char*)HB : (const char*)H1; }
    __device__ __forceinline__ void a_voff4(const pg8::Unit& u, int tid, unsigned (&v0)[2], unsigned (&v1)[2]) const {
        int R[2], Cc[2];
#pragma unroll
        for (int i = 0; i < 2; ++i) pg8::stage_rc(tid * 16 + i * 8192, R[i], Cc[i]);
        if (u.xa >> 24) {
#pragma unroll
            for (int i = 0; i < 2; ++i) { v0[i] = ((unsigned)(u.pm * 256 + R[i]) * 1024u + (unsigned)Cc[i]) * 2u; v1[i] = v0[i] + 128u * 2048u; }
        } else {
            const int cl = (u.xa >> 16) & 255, cnt = tb->cnt[cl]; const int* lp = LIST + cl * LISTCAP;
            int ra[2], rb[2];
#pragma unroll
            for (int i = 0; i < 2; ++i) { ra[i] = u.xb + R[i]; if (ra[i] >= cnt) ra[i] = u.xb; rb[i] = u.xb + 128 + R[i]; if (rb[i] >= cnt) rb[i] = u.xb; }
            const unsigned t00 = (unsigned)lp[ra[0]], t01 = (unsigned)lp[ra[1]], t10 = (unsigned)lp[rb[0]], t11 = (unsigned)lp[rb[1]];
            v0[0] = (t00 * 1024u + (unsigned)Cc[0]) * 2u; v0[1] = (t01 * 1024u + (unsigned)Cc[1]) * 2u; v1[0] = (t10 * 1024u + (unsigned)Cc[0]) * 2u; v1[1] = (t11 * 1024u + (unsigned)Cc[1]) * 2u;
        }
    }
    __device__ __forceinline__ const char* b_tile(const pg8::Unit& u, int kt) const {
        if (u.xa >> 24) { const int e = (kt < 8) ? (u.xa & 255) : ((u.xa >> 8) & 255); return (const char*)WD + ((size_t)e * 524288 + (size_t)u.pn * 131072 + (size_t)(kt & 7) * 64) * 2; }
        const int e = (u.pn < 4) ? (u.xa & 255) : ((u.xa >> 8) & 255); return (const char*)WGU + ((size_t)e * 1048576 + (size_t)(u.pn & 3) * 262144 + (size_t)kt * 64) * 2; }
    __device__ __forceinline__ void a_ready(const pg8::Unit& u) const {
        if (!(u.xa >> 24) || mode != 0) return;
#if PROBE_MOE
        const unsigned long long tq0 = __builtin_amdgcn_s_memrealtime();
#endif
        if (threadIdx.x < 64) { unsigned* word = ctl + CW_RDY + 64 * u.pm; const unsigned long long t0 = __builtin_amdgcn_s_memrealtime();
            while ((unsigned)__builtin_amdgcn_readfirstlane(__hip_atomic_load(word, __ATOMIC_RELAXED, __HIP_MEMORY_SCOPE_AGENT)) < 64u) {
                if (__builtin_amdgcn_s_memrealtime() - t0 > 2000000ull) break;
                __builtin_amdgcn_s_sleep(2); }
        }
        asm volatile("" ::: "memory"); __builtin_amdgcn_s_barrier(); asm volatile("" ::: "memory");
#if PROBE_MOE
        if (threadIdx.x == 0) { volatile LAS unsigned* pm_ = (volatile LAS unsigned*)((LAS unsigned char*)tb - MOETAB_OFF + MISC_OFF); pm_[17] += (unsigned)(__builtin_amdgcn_s_memrealtime() - tq0); }
#endif
    }
    __device__ __forceinline__ void done(const pg8::Unit& u, int lane) const {
        if ((u.xa >> 24) || mode != 0) return;
#if PROBE_MOE
        const unsigned long long tp0 = __builtin_amdgcn_s_memrealtime();
#endif
        asm volatile("s_waitcnt vmcnt(0)" ::: "memory");
#if PROBE_MOE
        if (threadIdx.x == 0) { volatile LAS unsigned* pm_ = (volatile LAS unsigned*)((LAS unsigned char*)tb - MOETAB_OFF + MISC_OFF); pm_[16] += (unsigned)(__builtin_amdgcn_s_memrealtime() - tp0); }
#endif
        if (lane == 0) __hip_atomic_fetch_add(ctl + CW_RDY + 64 * u.pm, 1u, __ATOMIC_RELAXED, __HIP_MEMORY_SCOPE_AGENT);
    }
};
struct EpiMoe {
    bf16* HB; const bf16* H1; bf16* R2; const float* LW; const int* LIST; const LAS MoeTab* tb;
    __device__ __forceinline__ void operator()(const f32x4 (&acc)[2][2][4][2], const pg8::Unit& u, int wr, int wc, int fr, int fq) const {
        const int cl = (u.xa >> 16) & 255, cnt = tb->cnt[cl];
        if (!(u.xa >> 24)) {
            const int slot = u.pn >> 2; const int col0 = slot * 512 + (u.pn & 3) * 128 + wc * 32 + 8 * fq;
            __amdgpu_buffer_rsrc_t rs = __builtin_amdgcn_make_buffer_rsrc(HB, 0, 0x7ffffffc, 0x00020000);
            float wv8[8];
#pragma unroll
            for (int q = 0; q < 8; ++q) { const int r = (q >> 2) * 128 + wr * 64 + (q & 3) * 16 + fr, rr = u.xb + r; const int rc = rr < cnt ? rr : u.xb;
                wv8[q] = LW[((size_t)cl * LISTCAP + rc) * 2 + slot]; }
            __builtin_amdgcn_sched_barrier(0);
#pragma unroll
            for (int q = 0; q < 8; ++q) { const int rr = u.xb + (q >> 2) * 128 + wr * 64 + (q & 3) * 16 + fr; if (rr >= cnt) wv8[q] = 0.f; }
#pragma unroll
            for (int ai = 0; ai < 2; ++ai)
#pragma unroll
                for (int m = 0; m < 4; ++m) { const int r = ai * 128 + wr * 64 + m * 16 + fr; const float w = wv8[ai * 4 + m];
                    const f32x4 g0 = acc[ai][0][m][0], g1 = acc[ai][0][m][1], u0 = acc[ai][1][m][0], u1 = acc[ai][1][m][1];
                    u32x4 o; o.x = pg8::cvt_pk_bf16(w * silu_f(g0[0]) * u0[0], w * silu_f(g0[1]) * u0[1]); o.y = pg8::cvt_pk_bf16(w * silu_f(g0[2]) * u0[2], w * silu_f(g0[3]) * u0[3]);
                    o.z = pg8::cvt_pk_bf16(w * silu_f(g1[0]) * u1[0], w * silu_f(g1[1]) * u1[1]); o.w = pg8::cvt_pk_bf16(w * silu_f(g1[2]) * u1[2], w * silu_f(g1[3]) * u1[3]);
                    __builtin_amdgcn_raw_buffer_store_b128(o, rs, (int)(((unsigned)(u.pm * 256 + r) * (unsigned)DM + (unsigned)col0) * 2u), 0, 16); }
        } else {
            const int col0 = u.pn * 256 + wc * 32 + 8 * fq;
            int tok8[8];
#pragma unroll
            for (int q = 0; q < 8; ++q) { const int rr = u.xb + (q >> 2) * 128 + wr * 64 + (q & 3) * 16 + fr; tok8[q] = LIST[cl * LISTCAP + (rr < cnt ? rr : u.xb)]; }
            __builtin_amdgcn_sched_barrier(0);
#pragma unroll
            for (int ai = 0; ai < 2; ++ai) {
                u32x4 xv[4][2];
#pragma unroll
                for (int m = 0; m < 4; ++m)
#pragma unroll
                    for (int bj = 0; bj < 2; ++bj) xv[m][bj] = *(const u32x4*)(H1 + (size_t)tok8[ai * 4 + m] * DM + col0 + bj * 128);
                __builtin_amdgcn_sched_barrier(0);
#pragma unroll
                for (int m = 0; m < 4; ++m) { const int rr = u.xb + ai * 128 + wr * 64 + m * 16 + fr; if (rr >= cnt) continue;
                    const size_t off = (size_t)tok8[ai * 4 + m] * DM + col0;
#pragma unroll
                    for (int bj = 0; bj < 2; ++bj) { const f32x4 v0 = acc[ai][bj][m][0], v1 = acc[ai][bj][m][1]; const u32x4 x4 = xv[m][bj];
                        u32x4 wv; wv.x = pg8::cvt_pk_bf16(ALPHA * bflo(x4.x) + v0[0], ALPHA * bfhi(x4.x) + v0[1]); wv.y = pg8::cvt_pk_bf16(ALPHA * bflo(x4.y) + v0[2], ALPHA * bfhi(x4.y) + v0[3]);
                        wv.z = pg8::cvt_pk_bf16(ALPHA * bflo(x4.z) + v1[0], ALPHA * bfhi(x4.z) + v1[1]); wv.w = pg8::cvt_pk_bf16(ALPHA * bflo(x4.w) + v1[2], ALPHA * bfhi(x4.w) + v1[3]);
                        *(u32x4*)(R2 + off + bj * 128) = wv; } }
                __builtin_amdgcn_sched_barrier(0);
            }
        }
    }
};

__device__ __forceinline__ void phase_scan(const Ctx& C) {
    const int gt = C.bid * NTHREADS + C.tid, NGT = C.G * NTHREADS;
    for (int task = gt; task < NBATCH * NHEAD * 2048; task += NGT) {
        const int e4 = task & 2047, bh = task >> 11, b = bh >> 3, h = bh & 7;
        f32x4 run = (f32x4){0.f, 0.f, 0.f, 0.f};
        f32x4 st[NCHUNK]; float dec[NCHUNK];
#pragma unroll
        for (int c = 0; c < NCHUNK; ++c) { const size_t item = (size_t)((b * NCHUNK + c) * 8 + h); st[c] = *(const f32x4*)(C.STATES() + item * 8192 + e4 * 4); dec[c] = C.CHD()[item]; }
#pragma unroll
        for (int c = 0; c < NCHUNK; ++c) { const size_t item = (size_t)((b * NCHUNK + c) * 8 + h);
            u32x2 o; o.x = pk2(run.x, run.y); o.y = pk2(run.z, run.w); *(u32x2*)(C.PREV() + item * 8192 + e4 * 4) = o;
            run = run * dec[c] + st[c]; }
    }
}
typedef short bf16x8v __attribute__((ext_vector_type(8)));
typedef short bf16x4v __attribute__((ext_vector_type(4)));
#define MFMA16(a, b, c) __builtin_amdgcn_mfma_f32_16x16x32_bf16((a), (b), (c), 0, 0, 0)
__device__ __forceinline__ int swz(int row, int q) { return row * 256 + ((q ^ (row & 15)) << 4); }
__device__ __forceinline__ int swz2(int row, int q) { return row * 256 + ((q ^ ((row ^ (row >> 4)) & 15)) << 4); }

struct ConvIn { u32x4 raw[11]; f32x4 w[4][2]; f32x4 b[2]; };
__device__ __forceinline__ void conv_load(const Ctx& C, ConvIn& ci, int tokb, int ch8, bool zero3) {
    const bf16* base = C.PROJ() + (size_t)tokb * NPROJ + PC_X + ch8;
#pragma unroll
    for (int r = 0; r < 11; ++r) { if (r < 3 && zero3) ci.raw[r] = (u32x4){0u, 0u, 0u, 0u}; else ci.raw[r] = *(const u32x4*)(base + (ptrdiff_t)(r - 3) * NPROJ); }
#pragma unroll
    for (int k = 0; k < 4; ++k) { ci.w[k][0] = *(const f32x4*)(C.conv_w() + k * 1024 + ch8); ci.w[k][1] = *(const f32x4*)(C.conv_w() + k * 1024 + ch8 + 4); }
    ci.b[0] = *(const f32x4*)(C.conv_b() + ch8); ci.b[1] = *(const f32x4*)(C.conv_b() + ch8 + 4);
}
template <int CC> __device__ __forceinline__ void conv_chan(const ConvIn& ci, float (&o)[8]) {
    float x[11];
#pragma unroll
    for (int r = 0; r < 11; ++r) { const unsigned wd = ci.raw[r][CC >> 1]; x[r] = (CC & 1) ? bfhi(wd) : bflo(wd); }
    const float w0 = ci.w[0][CC >> 2][CC & 3], w1 = ci.w[1][CC >> 2][CC & 3], w2 = ci.w[2][CC >> 2][CC & 3], w3 = ci.w[3][CC >> 2][CC & 3], bb = ci.b[CC >> 2][CC & 3];
#pragma unroll
    for (int t = 0; t < 8; ++t) o[t] = silu_f(bb + w0 * x[t] + w1 * x[t + 1] + w2 * x[t + 2] + w3 * x[t + 3]);
}
__device__ __forceinline__ void conv_store_nat(const ConvIn& ci, LAS unsigned char* tile, int tl0, int qc) {
    unsigned pw[8][4];
#define CS_PAIR(P) { float oa[8], ob[8]; conv_chan<2 * P>(ci, oa); conv_chan<2 * P + 1>(ci, ob); _Pragma("unroll") for (int t = 0; t < 8; ++t) pw[t][P] = pk2(oa[t], ob[t]); }
    CS_PAIR(0) CS_PAIR(1) CS_PAIR(2) CS_PAIR(3)
#undef CS_PAIR
#pragma unroll
    for (int t = 0; t < 8; ++t) { u32x4 o; o.x = pw[t][0]; o.y = pw[t][1]; o.z = pw[t][2]; o.w = pw[t][3]; *(LAS u32x4*)(tile + swz(tl0 + t, qc)) = o; }
}
template <bool SCALE> __device__ __forceinline__ void conv_store_tr(const ConvIn& ci, LAS unsigned char* tile, int row0, int qt, const float (&sc)[8]) {
#define CS_COL(CC) { float v[8]; conv_chan<CC>(ci, v); if (SCALE) { _Pragma("unroll") for (int t = 0; t < 8; ++t) v[t] *= sc[t]; } \
        u32x4 o; o.x = pk2(v[0], v[1]); o.y = pk2(v[2], v[3]); o.z = pk2(v[4], v[5]); o.w = pk2(v[6], v[7]); *(LAS u32x4*)(tile + swz2(row0 + CC, qt)) = o; }
    CS_COL(0) CS_COL(1) CS_COL(2) CS_COL(3) CS_COL(4) CS_COL(5) CS_COL(6) CS_COL(7)
#undef CS_COL
}
__device__ __forceinline__ float dt_scan(const Ctx& C, int tok0, int h, int lane, float& dt0, float& dt1, float& ac0, float& ac1) {
    const float bias = C.dt_bias()[h], A = -__expf(C.a_log()[h]);
    const float r0 = C.DTRAW()[(size_t)(tok0 + 2 * lane) * 8 + h] + bias, r1 = C.DTRAW()[(size_t)(tok0 + 2 * lane + 1) * 8 + h] + bias;
    dt0 = r0 > 20.f ? r0 : log1pf(__expf(r0)); dt1 = r1 > 20.f ? r1 : log1pf(__expf(r1));
    const float a0 = dt0 * A, a1 = dt1 * A; float x = a0 + a1;
#pragma unroll
    for (int o = 1; o < 64; o <<= 1) { const float v = __shfl_up(x, o); if (lane >= o) x += v; }
    ac1 = x; ac0 = x - a1;
    return __shfl(x, 63);
}

constexpr int SSD_XT = 0, SSD_BM = 65536, SSD_CM = 98304, SSD_TAB = 131072;

__device__ __forceinline__ void phase_states_fast(const Ctx& C) {
    LAS unsigned char* XT = C.lds + SSD_XT;
    LAS unsigned char* BT = C.lds + SSD_BM;
    LAS float* wtab = (LAS float*)(C.lds + SSD_TAB);
    const int lane_in = C.lane, w = C.wave;
    for (int item = C.bid; item < NBATCH * NCHUNK * 2; item += C.G) {
        const int g = item & 1, bc = item >> 1, tok0 = bc * CHUNK; const bool seq0 = (bc & (NCHUNK - 1)) == 0;
        int lane = lane_in; asm volatile("" : "+v"(lane));
        const int fr = lane & 15, fq = lane >> 4;
        __syncthreads();
        if (w < 4) { float d0, d1, a0, a1; const int h = g * 4 + w; const float tot = dt_scan(C, tok0, h, lane, d0, d1, a0, a1);
            wtab[w * 128 + 2 * lane] = d0 * __expf(tot - a0); wtab[w * 128 + 2 * lane + 1] = d1 * __expf(tot - a1);
            if (lane == 0) C.CHD()[bc * 8 + h] = __expf(tot); }
        __syncthreads();
        { const int cgp = lane & 31, tg = 2 * w + (lane >> 5); ConvIn ci; conv_load(C, ci, tok0 + tg * 8, g * 256 + cgp * 8, seq0 && tg == 0);
            float sc[8]; const int j = cgp >> 3;
#pragma unroll
            for (int i = 0; i < 8; ++i) sc[i] = wtab[j * 128 + tg * 8 + i];
            conv_store_tr<true>(ci, XT, cgp * 8, tg, sc); }
        if (w < 4) { const int cq = lane & 15, tg = 4 * w + (lane >> 4); ConvIn ci; conv_load(C, ci, tok0 + tg * 8, 512 + g * 128 + cq * 8, seq0 && tg == 0);
            float sc[8];
#pragma unroll
            for (int i = 0; i < 8; ++i) sc[i] = 1.f;
            conv_store_tr<false>(ci, BT, cq * 8, tg, sc); }
        __syncthreads();
        f32x4 acc[8][2];
#pragma unroll
        for (int a = 0; a < 8; ++a) { acc[a][0] = (f32x4){0.f, 0.f, 0.f, 0.f}; acc[a][1] = (f32x4){0.f, 0.f, 0.f, 0.f}; }
#pragma unroll
        for (int ks = 0; ks < 4; ++ks) {
            const bf16x8v b0 = *(const LAS bf16x8v*)(XT + swz2(32 * w + fr, 4 * ks + fq)), b1 = *(const LAS bf16x8v*)(XT + swz2(32 * w + 16 + fr, 4 * ks + fq));
#pragma unroll
            for (int a = 0; a < 8; ++a) { const bf16x8v af = *(const LAS bf16x8v*)(BT + swz2(16 * a + fr, 4 * ks + fq));
                acc[a][0] = MFMA16(af, b0, acc[a][0]); acc[a][1] = MFMA16(af, b1, acc[a][1]); }
        }
        float* st = C.STATES() + ((size_t)bc * 8 + g * 4) * 8192;
#pragma unroll
        for (int t = 0; t < 2; ++t) { const int ch = 32 * w + 16 * t + fr;
#pragma unroll
            for (int a = 0; a < 8; ++a) *(f32x4*)(st + (size_t)ch * 128 + 16 * a + 4 * fq) = acc[a][t]; }
    }
}

__device__ __forceinline__ void phase_y_fast(const Ctx& C) {
    LAS unsigned char* XT = C.lds + SSD_XT;
    LAS unsigned char* BM = C.lds + SSD_BM;
    LAS unsigned char* CM = C.lds + SSD_CM;
    LAS unsigned char* PV = C.lds + SSD_BM;
    LAS float* acl = (LAS float*)(C.lds + SSD_TAB);
    LAS float* dtl = acl + 512;
    const int lane_in = C.lane, w = C.wave;
    for (int item = C.bid; item < NBATCH * NCHUNK * 2; item += C.G) {
        const int g = item & 1, bc = item >> 1, tok0 = bc * CHUNK; const bool seq0 = (bc & (NCHUNK - 1)) == 0;
        int lane = lane_in; asm volatile("" : "+v"(lane));
        const int fr = lane & 15, fq = lane >> 4;
        u32x4 pv[8];
        { const u32x4* src = (const u32x4*)(C.PREV() + ((size_t)bc * 8 + g * 4) * 8192);
#pragma unroll
            for (int i = 0; i < 8; ++i) pv[i] = src[C.tid + NTHREADS * i]; }
        __syncthreads();
        if (w < 4) { float d0, d1, a0, a1; (void)dt_scan(C, tok0, g * 4 + w, lane, d0, d1, a0, a1);
            acl[w * 128 + 2 * lane] = a0; acl[w * 128 + 2 * lane + 1] = a1; dtl[w * 128 + 2 * lane] = d0; dtl[w * 128 + 2 * lane + 1] = d1; }
        { const int cgp = lane & 31, tg = 2 * w + (lane >> 5); ConvIn ci; float sc[8];
#pragma unroll
            for (int i = 0; i < 8; ++i) sc[i] = 1.f;
            conv_load(C, ci, tok0 + tg * 8, g * 256 + cgp * 8, seq0 && tg == 0); conv_store_tr<false>(ci, XT, cgp * 8, tg, sc); }
        { const int cq = lane & 15, tg = 4 * (w & 3) + (lane >> 4); ConvIn ci;
            conv_load(C, ci, tok0 + tg * 8, (w < 4 ? 512 : 768) + g * 128 + cq * 8, seq0 && tg == 0); conv_store_nat(ci, w < 4 ? BM : CM, tg * 8, cq); }
        __syncthreads();
        bf16x8v cf[4];
#pragma unroll
        for (int ks = 0; ks < 4; ++ks) cf[ks] = *(const LAS bf16x8v*)(CM + swz(16 * w + fr, 4 * ks + fq));
        f32x4 S[8];
#pragma unroll
        for (int st = 0; st < 8; ++st) { S[st] = (f32x4){0.f, 0.f, 0.f, 0.f};
            if (st <= w) {
#pragma unroll
                for (int ks = 0; ks < 4; ++ks) { const bf16x8v af = *(const LAS bf16x8v*)(BM + swz(16 * st + fr, 4 * ks + fq)); S[st] = MFMA16(af, cf[ks], S[st]); } } }
        __syncthreads();
#pragma unroll
        for (int i = 0; i < 8; ++i) { const int idx = C.tid + NTHREADS * i; *(LAS u32x4*)(PV + swz(idx >> 4, idx & 15)) = pv[i]; }
        __syncthreads();
        const int l = 16 * w + fr;
        f32x4 Y[4][4];
#pragma unroll
        for (int j = 0; j < 4; ++j) {
            const float al = acl[j * 128 + l], el = __expf(al), dsk = C.d_skip()[g * 4 + j];
#pragma unroll
            for (int pt = 0; pt < 4; ++pt) { f32x4 y = (f32x4){0.f, 0.f, 0.f, 0.f};
#pragma unroll
                for (int ks = 0; ks < 4; ++ks) { const bf16x8v af = *(const LAS bf16x8v*)(PV + swz(j * 64 + 16 * pt + fr, 4 * ks + fq)); y = MFMA16(af, cf[ks], y); }
                Y[j][pt] = y * el; }
#pragma unroll
            for (int blk = 0; blk < 4; ++blk) {
                if (2 * blk <= w) {
                    const int s0 = 32 * blk + 4 * fq;
                    const f32x4 as0 = *(const LAS f32x4*)(acl + j * 128 + s0), as1 = *(const LAS f32x4*)(acl + j * 128 + s0 + 16);
                    const f32x4 ds0 = *(const LAS f32x4*)(dtl + j * 128 + s0), ds1 = *(const LAS f32x4*)(dtl + j * 128 + s0 + 16);
                    float gv[8];
#pragma unroll
                    for (int i = 0; i < 4; ++i) { const int sa = s0 + i, sb = s0 + 16 + i;
                        float fa = sa <= l ? S[2 * blk][i] * __expf(al - as0[i]) * ds0[i] : 0.f; if (sa == l) fa += dsk;
                        float fb = sb <= l ? S[2 * blk + 1][i] * __expf(al - as1[i]) * ds1[i] : 0.f; if (sb == l) fb += dsk;
                        gv[i] = fa; gv[4 + i] = fb; }
                    u32x4 gp; gp.x = pk2(gv[0], gv[1]); gp.y = pk2(gv[2], gv[3]); gp.z = pk2(gv[4], gv[5]); gp.w = pk2(gv[6], gv[7]);
                    const bf16x8v gf = __builtin_bit_cast(bf16x8v, gp);
#pragma unroll
                    for (int pt = 0; pt < 4; ++pt) { const int row = j * 64 + 16 * pt + fr;
                        const u32x2 x0 = *(const LAS u32x2*)(XT + swz2(row, 4 * blk + (fq >> 1)) + (fq & 1) * 8), x1 = *(const LAS u32x2*)(XT + swz2(row, 4 * blk + 2 + (fq >> 1)) + (fq & 1) * 8);
                        u32x4 xa; xa.x = x0.x; xa.y = x0.y; xa.z = x1.x; xa.w = x1.y;
                        Y[j][pt] = MFMA16(__builtin_bit_cast(bf16x8v, xa), gf, Y[j][pt]); }
                }
            }
        }
        u32x2 zz[4][4];
        { const bf16* zrow = C.PROJ() + (size_t)(tok0 + l) * NPROJ + PC_Z + g * 256 + 4 * fq;
#pragma unroll
            for (int j = 0; j < 4; ++j)
#pragma unroll
                for (int pt = 0; pt < 4; ++pt) zz[j][pt] = *(const u32x2*)(zrow + j * 64 + 16 * pt); }
        float ss = 0.f;
#pragma unroll
        for (int j = 0; j < 4; ++j)
#pragma unroll
            for (int pt = 0; pt < 4; ++pt) { const u32x2 zv = zz[j][pt]; f32x4 y = Y[j][pt];
                y[0] *= silu_f(bflo(zv.x)); y[1] *= silu_f(bfhi(zv.x)); y[2] *= silu_f(bflo(zv.y)); y[3] *= silu_f(bfhi(zv.y));
                ss += (y[0] * y[0] + y[1] * y[1]) + (y[2] * y[2] + y[3] * y[3]); Y[j][pt] = y; }
        ss += __shfl_xor(ss, 16); ss += __shfl_xor(ss, 32);
        const float rinv = 1.0f / sqrtf(ss * (1.f / 256.f) + RMS_EPS);
        bf16* orow = C.YMIX() + (size_t)(tok0 + l) * DM + g * 256 + 4 * fq; const float* ng = C.ssm_norm_g() + g * 256 + 4 * fq;
        asm volatile("" : "+v"(ng));
#pragma unroll
        for (int j = 0; j < 4; ++j)
#pragma unroll
            for (int pt = 0; pt < 4; ++pt) { const f32x4 nv = *(const f32x4*)(ng + j * 64 + 16 * pt); const f32x4 y = Y[j][pt];
                u32x2 o; o.x = pk2(y[0] * rinv * nv[0], y[1] * rinv * nv[1]); o.y = pk2(y[2] * rinv * nv[2], y[3] * rinv * nv[3]);
                *(u32x2*)(orow + j * 64 + 16 * pt) = o; }
    }
}

template <int WIN> __device__ __forceinline__ void pool_window_task(const Ctx& C, LAS unsigned char* PM, int tok0, int g, int tid) {
    const int tg = tid >> 4, cq = tid & 15, tokb = tok0 + tg * 4, tpos = tokb & (SEQ - 1);
    const bf16* up = C.PROJ() + (size_t)tokb * NPROJ + PC_U + g * 128 + cq * 8;
    u32x4 raw[WIN + 3];
#pragma unroll
    for (int r = 0; r < WIN + 3; ++r) { const int d = r - (WIN - 1); if (tpos + d >= 0) raw[r] = *(const u32x4*)(up + (ptrdiff_t)d * NPROJ); else raw[r] = (u32x4){0u, 0u, 0u, 0u}; }
    float s[8];
#pragma unroll
    for (int i = 0; i < 8; ++i) s[i] = 0.f;
#pragma unroll
    for (int r = 0; r < WIN - 1; ++r) { float f[8]; unpack8(raw[r], f);
#pragma unroll
        for (int i = 0; i < 8; ++i) s[i] += f[i]; }
#pragma unroll
    for (int tt = 0; tt < 4; ++tt) { float f[8]; unpack8(raw[WIN - 1 + tt], f);
        const int t = tpos + tt; const float inv = 1.0f / (float)((t + 1) < WIN ? (t + 1) : WIN);
        float o[8];
#pragma unroll
        for (int i = 0; i < 8; ++i) { s[i] += f[i]; o[i] = s[i] * inv - f[i]; }
        u32x4 ov; ov.x = pk2(o[0], o[1]); ov.y = pk2(o[2], o[3]); ov.z = pk2(o[4], o[5]); ov.w = pk2(o[6], o[7]);
        *(LAS u32x4*)(PM + swz(tg * 4 + tt, cq)) = ov;
        float r8[8]; unpack8(raw[tt], r8);
#pragma unroll
        for (int i = 0; i < 8; ++i) s[i] -= r8[i]; }
}
__device__ __forceinline__ void phase_pool_fast(const Ctx& C) {
    LAS unsigned char* PM = C.lds;
    LAS unsigned char* WT = C.lds + 32768;
    const int lane = C.lane, w = C.wave, fr = lane & 15, fq = lane >> 4;
    const int g = C.bid & 3;
    { const u32x4* src = (const u32x4*)(C.WPOOL() + (size_t)g * 16384);
#pragma unroll
        for (int i = 0; i < 4; ++i) { const int idx = C.tid + NTHREADS * i; *(LAS u32x4*)(WT + swz(idx >> 4, idx & 15)) = src[idx]; } }
    for (int tile = C.bid >> 2; tile < NTOK / 128; tile += (C.G >> 2)) {
        const int tok0 = tile * 128;
        __syncthreads();
        if (g == 0) pool_window_task<2>(C, PM, tok0, 0, C.tid); else if (g == 1) pool_window_task<4>(C, PM, tok0, 1, C.tid);
        else if (g == 2) pool_window_task<8>(C, PM, tok0, 2, C.tid); else pool_window_task<16>(C, PM, tok0, 3, C.tid);
        __syncthreads();
        f32x4 acc[8];
#pragma unroll
        for (int a = 0; a < 8; ++a) acc[a] = (f32x4){0.f, 0.f, 0.f, 0.f};
#pragma unroll
        for (int ks = 0; ks < 4; ++ks) { const bf16x8v bfr = *(const LAS bf16x8v*)(PM + swz(16 * w + fr, 4 * ks + fq));
#pragma unroll
            for (int a = 0; a < 8; ++a) { const bf16x8v af = *(const LAS bf16x8v*)(WT + swz(16 * a + fr, 4 * ks + fq)); acc[a] = MFMA16(af, bfr, acc[a]); } }
        bf16* orow = C.YMIX() + (size_t)(tok0 + 16 * w + fr) * DM + 512 + g * 128 + 4 * fq; const float* bp = C.b_pool() + g * 128 + 4 * fq; const float* sp = C.pool_scale() + g * 128 + 4 * fq;
#pragma unroll
        for (int a = 0; a < 8; ++a) { const f32x4 b = *(const f32x4*)(bp + 16 * a), sc = *(const f32x4*)(sp + 16 * a); const f32x4 v = acc[a];
            u32x2 o; o.x = pk2((v[0] + b[0]) * sc[0], (v[1] + b[1]) * sc[1]); o.y = pk2((v[2] + b[2]) * sc[2], (v[3] + b[3]) * sc[3]);
            *(u32x2*)(orow + 16 * a) = o; }
    }
}

__device__ __forceinline__ void phase_ln1_router(const Ctx& C, bool commit = true) {
    LAS unsigned char* WH = C.lds;
    LAS unsigned char* WL = C.lds + 40960;
    LAS float* GT = (LAS float*)(C.lds + 81920);
    LAS float* BT = (LAS float*)(C.lds + 86016);
    LAS int* rcls = (LAS int*)(C.lds + 90112);
    LAS float* rw = (LAS float*)(C.lds + 90112 + 512);
    LAS int* rpos = (LAS int*)(C.lds + 90112 + 512 + 1024);
    LAS int* lcnt = (LAS int*)(C.lds + 90112 + 512 + 1024 + 512);
    LAS int* lbase = lcnt + 32;
    const int lane_in = C.lane, w = C.wave;
    for (int i = C.tid; i < 5120; i += NTHREADS) { const int half = i / 2560, q = i % 2560, n = q >> 7, c = q & 127;
        *(LAS u32x4*)((half ? WL : WH) + n * 2048 + (((c & ~15) | ((c ^ n) & 15)) << 4)) = *(const u32x4*)(C.RWT() + (size_t)i * 8); }
    for (int i = C.tid; i < 256; i += NTHREADS) { *(LAS f32x4*)(GT + 4 * i) = *(const f32x4*)(C.ln1_g() + 4 * i); *(LAS f32x4*)(BT + 4 * i) = *(const f32x4*)(C.ln1_b() + 4 * i); }
    float brg[4], bre[16];
#pragma unroll
    for (int i = 0; i < 4; ++i) brg[i] = C.b_rg()[i];
#pragma unroll
    for (int i = 0; i < 16; ++i) bre[i] = C.b_re()[i];
    for (int rb = C.bid; rb < NTOK / 128; rb += C.G) {
        __syncthreads();
        if (C.tid < 32) lcnt[C.tid] = 0;
        int lane = lane_in; asm volatile("" : "+v"(lane));
        const int r = lane & 15, fq = lane >> 4;
        const int rl = 16 * w + r, m = rb * 128 + rl;
        u32x4 raw[32];
        { const u32x4* src = (const u32x4*)(C.R1() + (size_t)m * DM) + fq;
#pragma unroll
            for (int ks = 0; ks < 32; ++ks) raw[ks] = src[4 * ks]; }
        float s = 0.f;
#pragma unroll
        for (int ks = 0; ks < 32; ++ks) { float f[8]; unpack8(raw[ks], f); s += ((f[0] + f[1]) + (f[2] + f[3])) + ((f[4] + f[5]) + (f[6] + f[7])); }
        s += __shfl_xor(s, 16); s += __shfl_xor(s, 32);
        const float mean = s * (1.f / DM); float s2 = 0.f;
#define RAW_OPAQUE() _Pragma("unroll") for (int ks = 0; ks < 32; ++ks) asm volatile("" : "+v"(raw[ks]))
        RAW_OPAQUE();
#pragma unroll
        for (int ks = 0; ks < 32; ++ks) { float f[8]; unpack8(raw[ks], f);
#pragma unroll
            for (int i = 0; i < 8; ++i) { const float d = f[i] - mean; s2 += d * d; } }
        s2 += __shfl_xor(s2, 16); s2 += __shfl_xor(s2, 32);
        RAW_OPAQUE();
#undef RAW_OPAQUE
        const float rstd = 1.f / sqrtf(s2 * (1.f / DM) + LN_EPS);
        f32x4 acc0 = (f32x4){0.f, 0.f, 0.f, 0.f}, acc1 = (f32x4){0.f, 0.f, 0.f, 0.f};
        u32x4* dst = (u32x4*)(C.H1() + (size_t)m * DM) + fq;
        const int n1 = (16 + r) < 20 ? (16 + r) : 19;
#pragma unroll
        for (int ks = 0; ks < 32; ++ks) {
            float f[8]; unpack8(raw[ks], f);
            const f32x4 g0 = *(const LAS f32x4*)(GT + 32 * ks + 8 * fq), g1 = *(const LAS f32x4*)(GT + 32 * ks + 8 * fq + 4), b0 = *(const LAS f32x4*)(BT + 32 * ks + 8 * fq), b1 = *(const LAS f32x4*)(BT + 32 * ks + 8 * fq + 4);
            float h[8];
            h[0] = (f[0] - mean) * rstd * g0[0] + b0[0]; h[1] = (f[1] - mean) * rstd * g0[1] + b0[1]; h[2] = (f[2] - mean) * rstd * g0[2] + b0[2]; h[3] = (f[3] - mean) * rstd * g0[3] + b0[3];
            h[4] = (f[4] - mean) * rstd * g1[0] + b1[0]; h[5] = (f[5] - mean) * rstd * g1[1] + b1[1]; h[6] = (f[6] - mean) * rstd * g1[2] + b1[2]; h[7] = (f[7] - mean) * rstd * g1[3] + b1[3];
            u32x4 hi; hi.x = pk2(h[0], h[1]); hi.y = pk2(h[2], h[3]); hi.z = pk2(h[4], h[5]); hi.w = pk2(h[6], h[7]);
            dst[4 * ks] = hi;
            u32x4 lo; lo.x = pk2(h[0] - bflo(hi.x), h[1] - bfhi(hi.x)); lo.y = pk2(h[2] - bflo(hi.y), h[3] - bfhi(hi.y)); lo.z = pk2(h[4] - bflo(hi.z), h[5] - bfhi(hi.z)); lo.w = pk2(h[6] - bflo(hi.w), h[7] - bfhi(hi.w));
            const bf16x8v hh = __builtin_bit_cast(bf16x8v, hi), hl = __builtin_bit_cast(bf16x8v, lo);
            const int c = 4 * ks + fq;
            const int o0 = r * 2048 + (((c & ~15) | ((c ^ r) & 15)) << 4), o1 = n1 * 2048 + (((c & ~15) | ((c ^ n1) & 15)) << 4);
            const bf16x8v wh0 = *(const LAS bf16x8v*)(WH + o0), wl0 = *(const LAS bf16x8v*)(WL + o0), wh1 = *(const LAS bf16x8v*)(WH + o1), wl1 = *(const LAS bf16x8v*)(WL + o1);
            acc0 = MFMA16(wh0, hh, acc0); acc0 = MFMA16(wl0, hh, acc0); acc0 = MFMA16(wh0, hl, acc0);
            acc1 = MFMA16(wh1, hh, acc1); acc1 = MFMA16(wl1, hh, acc1); acc1 = MFMA16(wh1, hl, acc1);
            if ((ks & 1) == 1) __builtin_amdgcn_sched_barrier(0);
        }
        float g0 = acc0[0] + brg[0], g1 = acc0[1] + brg[1], g2 = acc0[2] + brg[2], g3 = acc0[3] + brg[3];
        int gi = 0; float gm = g0; if (g1 > gm) { gm = g1; gi = 1; } if (g2 > gm) { gm = g2; gi = 2; } if (g3 > gm) { gm = g3; gi = 3; }
        float gwt = 1.0f / (__expf(g0 - gm) + __expf(g1 - gm) + __expf(g2 - gm) + __expf(g3 - gm));
        gi = __shfl(gi, r); gwt = __shfl(gwt, r);
        const int srcl = r + 16 * (gi == 3 ? 0 : gi + 1);
        float e[4];
#pragma unroll
        for (int i = 0; i < 4; ++i) { const float cand = fq == 0 ? acc1[i] : acc0[i]; const float v = __shfl(cand, srcl);
            const float bb = gi == 0 ? bre[i] : (gi == 1 ? bre[4 + i] : (gi == 2 ? bre[8 + i] : bre[12 + i])); e[i] = v + bb; }
        int i1 = 0; float v1 = e[0]; if (e[1] > v1) { v1 = e[1]; i1 = 1; } if (e[2] > v1) { v1 = e[2]; i1 = 2; } if (e[3] > v1) { v1 = e[3]; i1 = 3; }
        int i2 = -1; float v2 = -3.0e38f;
#pragma unroll
        for (int i = 0; i < 4; ++i) if (i != i1 && e[i] > v2) { v2 = e[i]; i2 = i; }
        const float ex = __expf(v2 - v1), p1 = 1.0f / (1.0f + ex), p2 = ex * p1;
        const int il = i1 < i2 ? i1 : i2, ih = i1 < i2 ? i2 : i1; const float wl = (i1 < i2 ? p1 : p2) * gwt, wh = (i1 < i2 ? p2 : p1) * gwt;
        const int q = il == 0 ? ih - 1 : (il == 1 ? ih + 1 : 5);
        if (fq == 0) { rcls[rl] = gi * 6 + q; rw[rl * 2] = wl; rw[rl * 2 + 1] = wh; }
        __syncthreads();
        if (!commit) continue;
        if (C.tid < 128) rpos[C.tid] = atomicAdd((int*)&lcnt[rcls[C.tid]], 1);
        __syncthreads();
        if (C.tid < NCLS) lbase[C.tid] = lcnt[C.tid] > 0 ? (int)__hip_atomic_fetch_add(C.ctl() + CW_CNT + C.tid, (unsigned)lcnt[C.tid], __ATOMIC_RELAXED, __HIP_MEMORY_SCOPE_AGENT) : 0;
        __syncthreads();
        if (C.tid < 128) { const int c = rcls[C.tid], pos = lbase[c] + rpos[C.tid];
            if (pos < LISTCAP) { C.LIST()[c * LISTCAP + pos] = rb * 128 + C.tid; C.LW()[((size_t)c * LISTCAP + pos) * 2] = rw[C.tid * 2]; C.LW()[((size_t)c * LISTCAP + pos) * 2 + 1] = rw[C.tid * 2 + 1]; } }
    }
}

__device__ __forceinline__ void phase_ln2(const Ctx& C) {
    const int gw = C.bid * NWAVES + C.wave, NGW = C.G * NWAVES;
    f32x4 gg[4], bb[4];
#pragma unroll
    for (int j = 0; j < 4; ++j) { gg[j] = *(const f32x4*)(C.ln2_g() + 4 * C.lane + 256 * j); bb[j] = *(const f32x4*)(C.ln2_b() + 4 * C.lane + 256 * j); }
    for (int m = gw; m < NTOK; m += NGW) {
        const u32x2* xr = (const u32x2*)(C.R2() + (size_t)m * DM) + C.lane;
        f32x4 v[4]; float s = 0.f;
#pragma unroll
        for (int j = 0; j < 4; ++j) { const u32x2 w = xr[64 * j]; v[j] = (f32x4){bflo(w.x), bfhi(w.x), bflo(w.y), bfhi(w.y)}; s += (v[j].x + v[j].y) + (v[j].z + v[j].w); }
        const float mean = wave_sum(s) * (1.f / DM); float s2 = 0.f;
#pragma unroll
        for (int j = 0; j < 4; ++j) { v[j] = v[j] - mean; s2 += (v[j].x * v[j].x + v[j].y * v[j].y) + (v[j].z * v[j].z + v[j].w * v[j].w); }
        const float rstd = 1.f / sqrtf(wave_sum(s2) * (1.f / DM) + LN_EPS);
        f32x4* o = (f32x4*)(C.out() + (size_t)m * DM) + C.lane;
#pragma unroll
        for (int j = 0; j < 4; ++j) o[64 * j] = v[j] * rstd * gg[j] + bb[j];
    }
}

#define XB_TMO      128
#define XB_XCNT(j)  (256  + 64 * (j))
#define XB_XSUB(j)  (1280 + 64 * (j))
#define XB_XGEN(j)  (2304 + 64 * (j))
#define XB_TOP      3328
#define XB_TOPGEN   3392
#define XCD_BAR_WORDS 3456
#define XB_SPIN_CAP (1u << 18)
constexpr int CW_BAR = 4096;
constexpr int MISC_OFF = LDS_BYTES - 256;
__device__ __forceinline__ unsigned xb_ld(unsigned* p)              { return __hip_atomic_load(p, __ATOMIC_RELAXED, __HIP_MEMORY_SCOPE_AGENT); }
__device__ __forceinline__ unsigned xb_add(unsigned* p, unsigned v) { return __hip_atomic_fetch_add(p, v, __ATOMIC_RELAXED, __HIP_MEMORY_SCOPE_AGENT); }
__device__ __forceinline__ unsigned xb_xcc_id() { return (unsigned)__builtin_amdgcn_s_getreg((3 << 11) | 20) & 0xFu; }
#define XB_SPIN(cond, bar) do { unsigned _sp = 0; while (cond) { __builtin_amdgcn_s_sleep(1); \
    if ((++_sp & 255u) == 0u) { if (xb_ld(&(bar)[XB_TMO])) break; if (_sp > XB_SPIN_CAP) { atomicAdd(&(bar)[XB_TMO], 1u); break; } } } } while (0)
struct XcdBarrier { unsigned* bar; unsigned x; volatile LAS unsigned* st; };
__device__ __forceinline__ XcdBarrier xcd_barrier_post(unsigned* bar, volatile LAS unsigned* st) {
    XcdBarrier b; b.bar = bar; b.x = xb_xcc_id(); b.st = st;
    if (threadIdx.x == 0) (void)xb_add(&bar[XB_XCNT(b.x)], 1u);
    return b;
}
__device__ __forceinline__ void xcd_barrier_complete(unsigned* bar, unsigned x, unsigned& nloc, unsigned& nx) {
    const unsigned G = gridDim.x * gridDim.y * gridDim.z;
    unsigned sum, cnt, mine, sp = 0u;
    for (;;) {
        sum = 0u; cnt = 0u; mine = 0u;
#pragma unroll
        for (unsigned j = 0; j < 16; ++j) { const unsigned c = xb_ld(&bar[XB_XCNT(j)]); sum += c; cnt += (c > 0u) ? 1u : 0u; mine = (j == x) ? c : mine; }
        if (sum == G) break;
        __builtin_amdgcn_s_sleep(1);
        if ((++sp & 255u) == 0u) { if (xb_ld(&bar[XB_TMO])) break; if (sp > XB_SPIN_CAP) { atomicAdd(&bar[XB_TMO], 1u); break; } }
    }
    nloc = mine > 0u ? mine : 1u; nx = cnt > 0u ? cnt : 1u;
}
__device__ __forceinline__ void xcd_barrier(const XcdBarrier& b) {
    asm volatile("s_waitcnt vmcnt(0)" ::: "memory");
    __syncthreads();
    if (threadIdx.x == 0) {
        unsigned* bar = b.bar;
        __builtin_amdgcn_s_waitcnt(0);
        unsigned nloc = b.st[0], nx = b.st[1];
        if (nloc == 0u) { xcd_barrier_complete(bar, b.x, nloc, nx); b.st[0] = nloc; b.st[1] = nx; }
        const unsigned old = xb_add(&bar[XB_XSUB(b.x)], 1u);
        const unsigned gen = old / nloc;
        if (old + 1u == (gen + 1u) * nloc) {
            __builtin_amdgcn_fence(__ATOMIC_RELEASE, "agent");
            asm volatile("s_waitcnt vmcnt(0)" ::: "memory");
            const unsigned og = xb_add(&bar[XB_TOP], 1u);
            const unsigned tg = og / nx;
            if (og + 1u == (tg + 1u) * nx) xb_add(&bar[XB_TOPGEN], 1u);
            else XB_SPIN(xb_ld(&bar[XB_TOPGEN]) == tg, bar);
            __builtin_amdgcn_fence(__ATOMIC_ACQUIRE, "agent");
            xb_add(&bar[XB_XGEN(b.x)], 1u);
            asm volatile("s_waitcnt vmcnt(0)" ::: "memory");
        } else {
            XB_SPIN(xb_ld(&bar[XB_XGEN(b.x)]) == gen, bar);
            __builtin_amdgcn_fence(__ATOMIC_ACQUIRE, "agent");
            asm volatile("s_waitcnt vmcnt(0)" ::: "memory");
        }
    }
    __syncthreads();
}

constexpr int N_PHASES = 9;
#ifndef STAMP_SEL
#define STAMP_SEL -1
#endif
#ifndef STAMP_FROM
#define STAMP_FROM 0
#endif
#ifndef STAMP_UNIT
#define STAMP_UNIT 10.0f
#endif
#ifndef SEP_MOE
#define SEP_MOE 1
#endif
#ifndef PROBE_MOE
#define PROBE_MOE 0
#endif
#ifndef DUP_PHASE
#define DUP_PHASE -1
#endif
template <int LO, int HI> __global__ void __launch_bounds__(NTHREADS, 2) fwd_kernel(Args args) {
    extern __shared__ __attribute__((aligned(16))) unsigned char lds_raw[];
    Ctx C;
    C.lds = (LAS unsigned char*)lds_raw;
    C.tid = threadIdx.x; C.lane = C.tid & 63; C.wave = __builtin_amdgcn_readfirstlane(C.tid >> 6); C.G = gridDim.x; C.bid = blockIdx.x;
    C.a = &args; C.ws = args.ws;
    const LAS MoeTab* tb = (const LAS MoeTab*)(C.lds + MOETAB_OFF);
    XcdBarrier bar; bar.bar = C.ctl() + CW_BAR; bar.x = 0; bar.st = nullptr;
    if constexpr (HI - LO > 1) {
        volatile LAS unsigned* misc = (volatile LAS unsigned*)(C.lds + MISC_OFF);
        if (C.tid < 64) misc[C.tid] = 0u;
        __syncthreads();
        bar = xcd_barrier_post(C.ctl() + CW_BAR, misc + 8);
    }
#define IN(k) (LO <= (k) && (k) < HI)
    unsigned long long t_from = 0ull, t_sel = 0ull;
#define STAMP(k) do { if (STAMP_SEL >= 0) { if ((k) == STAMP_FROM) t_from = __builtin_amdgcn_s_memrealtime(); if ((k) == STAMP_SEL + 1) t_sel = __builtin_amdgcn_s_memrealtime(); } } while (0)
#define SEAM(k) do { if constexpr (IN(k) && IN((k) + 1)) xcd_barrier(bar); } while (0)
#define REP(k) for (int rep_ = 0; rep_ < ((k) == DUP_PHASE ? 2 : 1); ++rep_)
#define FRESH() do { int t_ = threadIdx.x; asm volatile("" : "+v"(t_)); C.tid = t_; C.lane = t_ & 63; } while (0)
    STAMP(0);
    FRESH();
    if constexpr (IN(0)) REP(0) { phase_prep(C); if (DUP_PHASE == 0) __syncthreads(); }
    SEAM(0);
    STAMP(1);
    FRESH();
    if constexpr (IN(1)) REP(1) { ProbDense P{C.XN(), C.WIN(), NTOK / 256, NPROJ / 256, DM, C.G, C.bid}; EpiStoreBf16 E{C.PROJ(), NPROJ}; pg8::gemm_phase(C.lds, P, E); }
    SEAM(1);
    STAMP(2);
    FRESH();
    if constexpr (IN(2)) { REP(21) phase_states_fast(C); __syncthreads(); REP(22) phase_pool_fast(C); }
    SEAM(2);
    STAMP(3);
    FRESH();
    if constexpr (IN(3)) REP(3) phase_scan(C);
    SEAM(3);
    STAMP(4);
    FRESH();
    if constexpr (IN(4)) REP(4) phase_y_fast(C);
    SEAM(4);
    STAMP(5);
    FRESH();
    if constexpr (IN(5)) REP(5) { ProbDense P{C.YMIX(), C.WOUT(), NTOK / 256, DM / 256, DM, C.G, C.bid}; EpiResBf16 E{C.XN(), C.R1()}; pg8::gemm_phase(C.lds, P, E); }
    SEAM(5);
    STAMP(6);
    FRESH();
    if constexpr (IN(6)) { if (DUP_PHASE == 6) { phase_ln1_router(C, false); __syncthreads(); } phase_ln1_router(C, true); }
    SEAM(6);
    STAMP(7);
    FRESH();
#if SEP_MOE
    if constexpr (IN(7)) { build_moetab(C); { ProbMoe P{C.H1(), C.HB(), C.WGU(), C.WD(), C.LIST(), C.ctl(), tb, C.G, C.bid, 1}; EpiMoe E{C.HB(), C.H1(), C.R2(), C.LW(), C.LIST(), tb}; pg8::gemm_phase(C.lds, P, E); }
        xcd_barrier(bar); FRESH();
        { ProbMoe P{C.H1(), C.HB(), C.WGU(), C.WD(), C.LIST(), C.ctl(), tb, C.G, C.bid, 2}; EpiMoe E{C.HB(), C.H1(), C.R2(), C.LW(), C.LIST(), tb}; pg8::gemm_phase(C.lds, P, E); } }
#else
    if constexpr (IN(7)) { build_moetab(C); ProbMoe P{C.H1(), C.HB(), C.WGU(), C.WD(), C.LIST(), C.ctl(), tb, C.G, C.bid, 0}; EpiMoe E{C.HB(), C.H1(), C.R2(), C.LW(), C.LIST(), tb}; pg8::gemm_phase(C.lds, P, E); }
#endif
    SEAM(7);
    STAMP(8);
    FRESH();
    if constexpr (IN(8)) REP(8) phase_ln2(C);
    if (STAMP_SEL >= 0) { asm volatile("s_waitcnt vmcnt(0)" ::: "memory"); __syncthreads(); STAMP(9);
        if (blockIdx.x == 0 && threadIdx.x == 0) { asm volatile("s_waitcnt lgkmcnt(0)" ::: "memory");
            float val = (float)(t_sel - t_from); if (PROBE_MOE) val = (float)((volatile LAS unsigned*)(C.lds + MISC_OFF))[15 + PROBE_MOE];
            C.out()[0] = val * (0.01f / STAMP_UNIT); } }
#undef IN
#undef SEAM
#undef REP
#undef FRESH
#undef STAMP
}

#ifndef ONE_LAUNCH
#define ONE_LAUNCH 1
#endif
template <int P, int Q> static void launch_phase(int grid, hipStream_t stream, const Args& a) {
    static bool attr = false;
    if (!attr) { (void)hipFuncSetAttribute((const void*)fwd_kernel<P, Q>, hipFuncAttributeMaxDynamicSharedMemorySize, LDS_BYTES); (void)hipGetLastError(); attr = true; }
    hipLaunchKernelGGL((fwd_kernel<P, Q>), dim3(grid), dim3(NTHREADS), LDS_BYTES, stream, a);
}

extern "C" void kernel_launch(void* const* d_in, const int* in_sizes, int n_in, void* d_out, int out_size, void* d_ws, size_t ws_size, hipStream_t stream) {
    static int grid = 0;
    if (grid == 0) {
        if (n_in != 25 || in_sizes[0] != NTOK * DM || out_size != NTOK * DM || ws_size < WS_END) { fprintf(stderr, "kernel_launch: unexpected shapes (n_in %d, in0 %d, out %d, ws %zu)\n", n_in, n_in > 0 ? in_sizes[0] : -1, out_size, ws_size); grid = -1; return; }
        int dev = 0, cus = 0;
        if (hipGetDevice(&dev) != hipSuccess || hipDeviceGetAttribute(&cus, hipDeviceAttributeMultiprocessorCount, dev) != hipSuccess) { grid = -1; return; }
        (void)hipGetLastError();
        grid = cus > 0 ? cus : 256;
    }
    if (grid < 0) return;
    (void)hipMemsetAsync((char*)d_ws + WS_CTL, 0, CTL_ZERO_BYTES, stream);
    Args a{};
    for (int i = 0; i < 25; ++i) a.in[i] = (const float*)d_in[i];
    a.out = (float*)d_out; a.ws = (unsigned char*)d_ws;
#if ONE_LAUNCH
    launch_phase<0, N_PHASES>(grid, stream, a);
#else
    launch_phase<0, 1>(grid, stream, a); launch_phase<1, 2>(grid, stream, a); launch_phase<2, 3>(grid, stream, a); launch_phase<3, 4>(grid, stream, a); launch_phase<4, 5>(grid, stream, a);
    launch_phase<5, 6>(grid, stream, a); launch_phase<6, 7>(grid, stream, a); launch_phase<7, 8>(grid, stream, a); launch_phase<8, 9>(grid, stream, a);
#endif
}
```
